# Optimizing an MI355X kernel written in HIP

```python
import math
import jax, jax.numpy as jnp
from jax import lax
import numpy as np


D_MODEL = 2048
BATCH = 1
SEQ = 8192
DEPTH = 1

MEM_LEN = 256
EPS = 1e-6
NEG_INF = -1e30
ROPE_THETA = 500000.0
Q_BLOCK = 128
DA_HEADS = 8
DA_DK = 64
DA_DV = 2 * DA_DK
NSA_HEADS = 16
NSA_GROUPS = 4
NSA_HPG = NSA_HEADS // NSA_GROUPS
NSA_DK = 64
CMP_LEN = 32
CMP_STRIDE = 16
CMP_HIDDEN = 128
SEL_LEN = 64
SEL_TOPK = 16
WINDOW = 512
FORCE_BONUS = 100.0
ROPE_DIM = DA_DK // 4
X_HEADS = 4
X_DH = 128
PEER_HEADS = 8
PEER_NKEYS = 128
PEER_EXPERTS = PEER_NKEYS * PEER_NKEYS
PEER_DQ = 256
PEER_TOPK = 16
PEER_CHUNK = 128
SPLIT_SIZES = (DA_HEADS * 2 * DA_DK, DA_HEADS * 2 * DA_DK, DA_HEADS * DA_DV,
               NSA_HEADS * NSA_DK, 6 * NSA_GROUPS * NSA_DK, NSA_HEADS * 3, 2 * D_MODEL)
IN_COLS = sum(SPLIT_SIZES)
SPLIT_POINTS = [int(o) for o in np.cumsum(SPLIT_SIZES)[:-1]]

kernel_name = 'hybrid_diffattn_nsa_peer_block'


def rms_norm(x, g):
    xf = x.astype(jnp.float32)
    y = xf * lax.rsqrt(jnp.mean(xf * xf, axis=-1, keepdims=True) + EPS)
    return (y * g.astype(jnp.float32)).astype(x.dtype)


def rope_tables(positions, dtype):
    inv = ROPE_THETA ** (-jnp.arange(0, ROPE_DIM, 2, dtype=jnp.float32) / ROPE_DIM)
    ang = positions.astype(jnp.float32)[..., None] * inv
    return jnp.cos(ang).astype(dtype), jnp.sin(ang).astype(dtype)


def partial_rope(x, cos, sin):
    half = ROPE_DIM // 2
    shp = cos.shape[:2] + (1,) * (x.ndim - 3) + (half,)
    c = cos.reshape(shp)
    s = sin.reshape(shp)
    x1 = x[..., :half]
    x2 = x[..., half:ROPE_DIM]
    return jnp.concatenate([x1 * c - x2 * s, x2 * c + x1 * s, x[..., ROPE_DIM:]], axis=-1)


def masked_softmax(s, mask):
    s32 = jnp.where(mask, s.astype(jnp.float32), NEG_INF)
    return jax.nn.softmax(s32, axis=-1) * mask


def diff_attention(q, k, v, lam, lambda_init, subln_g):
    B, S = q.shape[:2]
    scale = DA_DK ** -0.5
    kpos = jnp.arange(S)

    def block(c):
        q0 = c * Q_BLOCK
        qb = lax.dynamic_slice_in_dim(q, q0, Q_BLOCK, axis=1)
        t = q0 + jnp.arange(Q_BLOCK)
        s = jnp.einsum('bqhmd,bkhmd->bhmqk', qb, k) * scale
        mask = kpos[None, :] <= t[:, None]
        p = masked_softmax(s, mask)
        a = p[:, :, 0] - lam * p[:, :, 1]
        return jnp.einsum('bhqk,bkhd->bqhd', a.astype(v.dtype), v)

    o = lax.map(block, jnp.arange(S // Q_BLOCK))
    o = jnp.moveaxis(o, 0, 1).reshape(B, S, DA_HEADS, DA_DV)
    o = rms_norm(o, subln_g) * (1.0 - lambda_init)
    return o.reshape(B, S, DA_HEADS * DA_DV)


def compress(xs, pos_emb, w1, w2):
    S = xs.shape[1]
    n_cmp = (S - CMP_LEN) // CMP_STRIDE + 1
    idx = jnp.arange(n_cmp)[:, None] * CMP_STRIDE + jnp.arange(CMP_LEN)[None, :]
    blk = xs[:, idx] + pos_emb[None, None, :, None, :]
    hid = jax.nn.gelu(jnp.einsum('bnlgd,ldh->bngh', blk, w1.reshape(CMP_LEN, NSA_DK, CMP_HIDDEN)), approximate=False)
    return jnp.einsum('bngh,hd->bngd', hid, w2)


def nsa_attention(q, kv, gate_logits, cos, sin, cmp_pos, ck1, ck2, cv1, cv2):
    B, S = q.shape[:2]
    G = NSA_GROUPS
    q = partial_rope(q, cos, sin).reshape(B, S, G, NSA_HPG, NSA_DK)
    k_cmp = partial_rope(kv[:, :, 0], cos, sin)
    v_cmp = kv[:, :, 1]
    k_sel = partial_rope(kv[:, :, 2], cos, sin)
    v_sel = kv[:, :, 3]
    k_win = partial_rope(kv[:, :, 4], cos, sin)
    v_win = kv[:, :, 5]
    gates = jax.nn.sigmoid(gate_logits)

    n_cmp = (S - CMP_LEN) // CMP_STRIDE + 1
    n_sel = S // SEL_LEN
    topk = min(SEL_TOPK, n_sel)
    per_sel = SEL_LEN // CMP_STRIDE
    pad = n_sel * per_sel - n_cmp
    kc = compress(k_cmp, cmp_pos, ck1, ck2)
    vc = compress(v_cmp, cmp_pos, cv1, cv2)
    cmp_end = jnp.arange(n_cmp) * CMP_STRIDE + CMP_LEN - 1
    blk_ids = jnp.arange(n_sel)
    sel_start = blk_ids * SEL_LEN

    def to_blocks(a):
        return a.reshape(B, n_sel, SEL_LEN, G, NSA_DK).transpose(0, 3, 1, 2, 4)

    ks_blk = to_blocks(k_sel)
    vs_blk = to_blocks(v_sel)
    kw_pad = jnp.pad(k_win, ((0, 0), (WINDOW, 0), (0, 0), (0, 0)))
    vw_pad = jnp.pad(v_win, ((0, 0), (WINDOW, 0), (0, 0), (0, 0)))
    b_idx = jnp.arange(B)[:, None, None, None]
    g_idx = jnp.arange(G)[None, None, :, None]
    scale = NSA_DK ** -0.5

    def block(c):
        q0 = c * Q_BLOCK
        t = q0 + jnp.arange(Q_BLOCK)
        qb = lax.dynamic_slice_in_dim(q, q0, Q_BLOCK, axis=1)
        gb = lax.dynamic_slice_in_dim(gates, q0, Q_BLOCK, axis=1)
        s_c = jnp.einsum('bqghd,bngd->bqghn', qb, kc) * scale
        m_c = (cmp_end[None, :] <= t[:, None])[None, :, None, None, :]
        p_c = masked_softmax(s_c, m_c)
        o_c = jnp.einsum('bqghn,bngd->bqghd', p_c.astype(qb.dtype), vc)
        imp = jnp.pad(p_c.sum(axis=3), ((0, 0), (0, 0), (0, 0), (0, pad)))
        imp = imp.reshape(B, Q_BLOCK, G, n_sel, per_sel).sum(-1)
        elig = sel_start[None, :] <= t[:, None]
        cur = (t // SEL_LEN)[:, None]
        forced = (blk_ids[None, :] == 0) | (blk_ids[None, :] == cur) | (blk_ids[None, :] == cur - 1)
        bonus = jnp.where(forced, FORCE_BONUS, 0.0)
        score = jnp.where(elig[None, :, None, :], imp + bonus[None, :, None, :], -1.0)
        _, idx = lax.top_k(score, topk)
        valid = jnp.take_along_axis(jnp.broadcast_to(elig[None, :, None, :], score.shape), idx, axis=-1)
        k_g = ks_blk[b_idx, g_idx, idx].reshape(B, Q_BLOCK, G, topk * SEL_LEN, NSA_DK)
        v_g = vs_blk[b_idx, g_idx, idx].reshape(B, Q_BLOCK, G, topk * SEL_LEN, NSA_DK)
        tok = idx[..., None] * SEL_LEN + jnp.arange(SEL_LEN)
        m_s = ((tok <= t[None, :, None, None, None]) & valid[..., None]).reshape(B, Q_BLOCK, G, 1, topk * SEL_LEN)
        s_s = jnp.einsum('bqghd,bqgkd->bqghk', qb, k_g) * scale
        o_s = jnp.einsum('bqghk,bqgkd->bqghd', masked_softmax(s_s, m_s).astype(qb.dtype), v_g)
        kw = lax.dynamic_slice_in_dim(kw_pad, q0, Q_BLOCK + WINDOW, axis=1)
        vw = lax.dynamic_slice_in_dim(vw_pad, q0, Q_BLOCK + WINDOW, axis=1)
        kpos = q0 - WINDOW + jnp.arange(Q_BLOCK + WINDOW)
        dist = t[:, None] - kpos[None, :]
        m_w = ((dist >= 0) & (dist < WINDOW) & (kpos[None, :] >= 0))[None, :, None, None, :]
        s_w = jnp.einsum('bqghd,bkgd->bqghk', qb, kw) * scale
        o_w = jnp.einsum('bqghk,bkgd->bqghd', masked_softmax(s_w, m_w).astype(qb.dtype), vw)
        o = gb[..., 0:1] * o_c + gb[..., 1:2] * o_s + gb[..., 2:3] * o_w
        return o.reshape(B, Q_BLOCK, NSA_HEADS * NSA_DK)

    o = lax.map(block, jnp.arange(S // Q_BLOCK))
    return jnp.moveaxis(o, 0, 1).reshape(B, S, NSA_HEADS * NSA_DK)


def memory_cross_attention(hn, memn, wq, wkv, wo):
    B, S, _ = hn.shape
    M = memn.shape[1]
    q = (hn @ wq).reshape(B, S, X_HEADS, X_DH)
    kv = (memn @ wkv).reshape(B, M, 2, X_HEADS, X_DH)
    s = jnp.einsum('bshd,bmhd->bhsm', q, kv[:, :, 0]) * (X_DH ** -0.5)
    p = jax.nn.softmax(s.astype(jnp.float32), axis=-1).astype(hn.dtype)
    o = jnp.einsum('bhsm,bmhd->bshd', p, kv[:, :, 1])
    return o.reshape(B, S, X_HEADS * X_DH) @ wo


def peer_ffn(xn, wq, keys1, keys2, U, V):
    B, S, D = xn.shape
    C = PEER_CHUNK
    K = PEER_TOPK
    half = PEER_DQ // 2

    def chunk(c):
        xc = lax.dynamic_slice_in_dim(xn, c * C, C, axis=1)
        q = (xc @ wq).reshape(B, C, PEER_HEADS, PEER_DQ)
        s1 = jnp.einsum('bchd,nd->bchn', q[..., :half], keys1).astype(jnp.float32)
        s2 = jnp.einsum('bchd,nd->bchn', q[..., half:], keys2).astype(jnp.float32)
        v1, i1 = lax.top_k(s1, K)
        v2, i2 = lax.top_k(s2, K)
        cand = (v1[..., :, None] + v2[..., None, :]).reshape(B, C, PEER_HEADS, K * K)
        sc, ci = lax.top_k(cand, K)
        e = jnp.take_along_axis(i1, ci // K, axis=-1) * PEER_NKEYS + jnp.take_along_axis(i2, ci % K, axis=-1)
        g = jax.nn.softmax(sc, axis=-1).astype(xc.dtype)
        a = jax.nn.gelu(jnp.einsum('bchkd,bcd->bchk', U[e], xc), approximate=False)
        return jnp.einsum('bchk,bchkd->bcd', g * a, V[e])

    o = lax.map(chunk, jnp.arange(S // C))
    return jnp.moveaxis(o, 0, 1).reshape(B, S, D)


def setup_inputs(seed: int = 0) -> dict:
    key = jax.random.key(seed)
    ks = iter(jax.random.split(key, 40))

    def nrm(shape, scale):
        return jax.random.normal(next(ks), shape, jnp.float32) * scale

    def gain(shape):
        return 1.0 + nrm(shape, 0.02)

    L = DEPTH
    D = D_MODEL
    x = nrm((BATCH, SEQ, D), 1.0)
    mem = nrm((BATCH, MEM_LEN, D), 1.0)
    off = jax.random.randint(next(ks), (BATCH,), 0, 1024)
    positions = (jnp.arange(SEQ, dtype=jnp.int32)[None, :] + off[:, None]).astype(jnp.int32)
    return {
        'x': x,
        'mem': mem,
        'positions': positions,
        'norm_mix_g': gain((L, D)),
        'w_in': nrm((L, D, IN_COLS), D ** -0.5),
        'da_lambda_q1': nrm((L, DA_DK), 0.1),
        'da_lambda_k1': nrm((L, DA_DK), 0.1),
        'da_lambda_q2': nrm((L, DA_DK), 0.1),
        'da_lambda_k2': nrm((L, DA_DK), 0.1),
        'da_subln_g': gain((L, DA_DV)),
        'nsa_cmp_pos': nrm((L, CMP_LEN, NSA_DK), 0.02),
        'nsa_cmpk_w1': nrm((L, CMP_LEN * NSA_DK, CMP_HIDDEN), (CMP_LEN * NSA_DK) ** -0.5),
        'nsa_cmpk_w2': nrm((L, CMP_HIDDEN, NSA_DK), CMP_HIDDEN ** -0.5),
        'nsa_cmpv_w1': nrm((L, CMP_LEN * NSA_DK, CMP_HIDDEN), (CMP_LEN * NSA_DK) ** -0.5),
        'nsa_cmpv_w2': nrm((L, CMP_HIDDEN, NSA_DK), CMP_HIDDEN ** -0.5),
        'w_branch_da': nrm((L, DA_HEADS * DA_DV, D), (DA_HEADS * DA_DV) ** -0.5),
        'w_branch_nsa': nrm((L, NSA_HEADS * NSA_DK, D), (NSA_HEADS * NSA_DK) ** -0.5),
        'w_out': nrm((L, D, D), D ** -0.5),
        'norm_x_g': gain((L, D)),
        'norm_mem_g': gain((L, D)),
        'w_xq': nrm((L, D, X_HEADS * X_DH), D ** -0.5),
        'w_xkv': nrm((L, D, 2 * X_HEADS * X_DH), D ** -0.5),
        'w_xo': nrm((L, X_HEADS * X_DH, D), (X_HEADS * X_DH) ** -0.5),
        'norm_ffn_g': gain((L, D)),
        'peer_wq': nrm((L, D, PEER_HEADS * PEER_DQ), D ** -0.5),
        'peer_keys1': nrm((L, PEER_NKEYS, PEER_DQ // 2), (PEER_DQ // 2) ** -0.5),
        'peer_keys2': nrm((L, PEER_NKEYS, PEER_DQ // 2), (PEER_DQ // 2) ** -0.5),
        'peer_u': nrm((L, PEER_EXPERTS, D), D ** -0.5),
        'peer_v': nrm((L, PEER_EXPERTS, D), 0.5),
        'norm_final_g': gain((D,)),
    }


def reference(x, mem, positions, norm_mix_g, w_in, da_lambda_q1, da_lambda_k1, da_lambda_q2, da_lambda_k2,
              da_subln_g, nsa_cmp_pos, nsa_cmpk_w1, nsa_cmpk_w2, nsa_cmpv_w1, nsa_cmpv_w2, w_branch_da,
              w_branch_nsa, w_out, norm_x_g, norm_mem_g, w_xq, w_xkv, w_xo, norm_ffn_g, peer_wq, peer_keys1,
              peer_keys2, peer_u, peer_v, norm_final_g):
    B, S, _ = x.shape
    cos, sin = rope_tables(positions, x.dtype)
    h = x
    for l in range(DEPTH):
        xn = rms_norm(h, norm_mix_g[l])
        z = xn @ w_in[l]
        zq, zk, zv, nq, nkv, ng, bg = jnp.split(z, SPLIT_POINTS, axis=-1)
        dq = partial_rope(zq.reshape(B, S, DA_HEADS, 2, DA_DK), cos, sin)
        dk = partial_rope(zk.reshape(B, S, DA_HEADS, 2, DA_DK), cos, sin)
        dv = zv.reshape(B, S, DA_HEADS, DA_DV)
        lambda_init = 0.8 - 0.6 * math.exp(-0.3 * l)
        lam = (jnp.exp(jnp.sum((da_lambda_q1[l] * da_lambda_k1[l]).astype(jnp.float32)))
               - jnp.exp(jnp.sum((da_lambda_q2[l] * da_lambda_k2[l]).astype(jnp.float32))) + lambda_init)
        o_da = diff_attention(dq, dk, dv, lam, lambda_init, da_subln_g[l])
        o_nsa = nsa_attention(nq.reshape(B, S, NSA_HEADS, NSA_DK),
                              nkv.reshape(B, S, 6, NSA_GROUPS, NSA_DK),
                              ng.reshape(B, S, NSA_GROUPS, NSA_HPG, 3), cos, sin,
                              nsa_cmp_pos[l], nsa_cmpk_w1[l], nsa_cmpk_w2[l], nsa_cmpv_w1[l], nsa_cmpv_w2[l])
        gates = jax.nn.sigmoid(bg.reshape(B, S, 2, D_MODEL))
        mix = gates[:, :, 0] * (o_da @ w_branch_da[l]) + gates[:, :, 1] * (o_nsa @ w_branch_nsa[l])
        h = h + mix @ w_out[l]
        h = h + memory_cross_attention(rms_norm(h, norm_x_g[l]), rms_norm(mem, norm_mem_g[l]),
                                       w_xq[l], w_xkv[l], w_xo[l])
        h = h + peer_ffn(rms_norm(h, norm_ffn_g[l]), peer_wq[l], peer_keys1[l], peer_keys2[l],
                         peer_u[l], peer_v[l])
    return rms_norm(h, norm_final_g)
```

```cpp
#include <hip/hip_runtime.h>
#include <cstdio>
#include <cstdint>
#include <cmath>
#include <cstring>
namespace pg8 {
#define PG8_LAS __attribute__((address_space(3)))
typedef unsigned short bf16_t;
typedef short bf16x8 __attribute__((ext_vector_type(8)));
typedef float f32x4 __attribute__((ext_vector_type(4)));
typedef unsigned u32x4 __attribute__((ext_vector_type(4)));
constexpr int BM = 256, BK = 64, HALF = 128, HTB = HALF * BK * 2  , STAGE_BYTES = 8 * HTB, NXCD = 8, WGM = 8;

__host__ __device__ __forceinline__ int lds_byte(int r, int c) { const int st = (r >> 4) * 2 + (c >> 5), rr = r & 15, cc = c & 31, ob = rr * 64 + cc * 2; return st * 1024 + (ob ^ (((ob >> 9) & 1) << 5)); }
__host__ __device__ __forceinline__ void stage_rc(int b, int& R, int& C) { const int st = b / 1024, sb = b % 1024, swz = sb ^ (((sb >> 9) & 1) << 5); R = (st >> 1) * 16 + swz / 64; C = (st & 1) * 32 + (swz % 64) / 2; }
__host__ __device__ __forceinline__ int perm32(int rho) { const int n = rho >> 4, i = rho & 15; return 8 * (i >> 2) + 4 * n + (i & 3); }

struct Unit { int pm, pn; };
struct Gemm { const bf16_t* A; const bf16_t* Bt; int M, N, K; };

struct StaticOrder {
    int nM, nN, nwg, G, c;
    __host__ __device__ __forceinline__ void init(int M, int N, int G_, int c_) { nM = M / BM; nN = N / BM; nwg = nM * nN; G = G_; c = c_; }
    __host__ __device__ __forceinline__ bool next(int i, Unit& u) const {
        const long L = (long)i * G + c; if (L >= nwg) return false;
        int wgid = (int)L; { const int q = nwg / NXCD, r = nwg % NXCD, xcd = wgid % NXCD, off = wgid / NXCD; wgid = (xcd < r ? xcd * (q + 1) : r * (q + 1) + (xcd - r) * q) + off; }
        const int nig = WGM * nN, gid = wgid / nig, fm = gid * WGM, gsz = (nM - fm) < WGM ? (nM - fm) : WGM;
        u.pm = fm + ((wgid % nig) % gsz); u.pn = (wgid % nig) / gsz; return true;
    }
    __device__ __forceinline__ void a_ready(const Unit&) const {}
    __device__ __forceinline__ void done(const Unit&) const {}
};

__device__ __forceinline__ unsigned cvt_pk_bf16(float lo, float hi) { unsigned r; asm volatile("v_cvt_pk_bf16_f32 %0, %1, %2" : "=v"(r) : "v"(lo), "v"(hi)); return r; }
typedef float f32x2 __attribute__((ext_vector_type(2)));
__device__ __forceinline__ f32x2 gelu_pk(f32x2 v) {
    const f32x2 av = __builtin_elementwise_abs(v), d = av * 0.2316418882f + 1.0f;
    f32x2 t; t.x = __builtin_amdgcn_rcpf(d.x); t.y = __builtin_amdgcn_rcpf(d.y);
    f32x2 q = t * 0.5307027145f + (-0.7265760135f); q = q * t + 0.7107068705f; q = q * t + (-0.142248368f); q = q * t + 0.127414796f; q = q * t;
    const f32x2 s = (v * v) * (-0.72134752044f);
    f32x2 e; e.x = __builtin_amdgcn_exp2f(s.x); e.y = __builtin_amdgcn_exp2f(s.y);
    const f32x2 m = v * (q * e), r = v - m;
    f32x2 o; o.x = v.x < 0.f ? m.x : r.x; o.y = v.y < 0.f ? m.y : r.y; return o;
}

template <class Epi, class Sched, bool ALIGN_EPI = false, bool SP2 = false>
__device__ __forceinline__ void gemm_phase(PG8_LAS unsigned char* lds, const Gemm g, const Sched& S, const Epi& E) {
    const int tid = threadIdx.x, wid = __builtin_amdgcn_readfirstlane(tid >> 6), lane = tid & 63, wr = wid >> 2, wc = wid & 3, fr = lane & 15, fq = lane >> 4;
    const int K = g.K, nt = K / BK;
    unsigned voffA[2], voffB[2];
#pragma unroll
    for (int i = 0; i < 2; ++i) { int R, C; stage_rc(tid * 16 + i * 8192, R, C); const int Rb = Epi::PERM ? ((R & ~31) + perm32(R & 31)) : R;
        voffA[i] = (unsigned)(R * K + C) * 2u; voffB[i] = (unsigned)(Rb * K + C) * 2u; }
    const size_t kstep = (size_t)(BK * 2);
    const size_t hstep = (size_t)HALF * K * 2;
    const size_t tstep = 2 * hstep;
    const unsigned ldsw = (unsigned)wid * 1024u;
    const int aoff = lds_byte(wr * 64 + fr, fq * 8), boff = lds_byte(wc * 32 + fr, fq * 8);
#define PG8_SA(b, h) (((b) * 2 + (h)) * HTB)
#define PG8_SB(b, h) ((4 + (b) * 2 + (h)) * HTB)
#define PG8_STAGE(bufoff, gbase, voff) do { _Pragma("unroll") for (int _i = 0; _i < 2; ++_i) \
        __builtin_amdgcn_global_load_lds((const unsigned*)((const char*)(gbase) + (voff)[_i]), (PG8_LAS unsigned*)(lds + (bufoff) + ldsw + _i * 8192), 16, 0, 0); } while (0)
#define PG8_LDA(dst, b, h) do { _Pragma("unroll") for (int m = 0; m < 4; ++m) _Pragma("unroll") for (int k = 0; k < 2; ++k) dst[m][k] = *(const PG8_LAS bf16x8*)(lds + PG8_SA(b, h) + aoff + m * 2048 + k * 1024); } while (0)
#define PG8_LDB(dst, b, h) do { _Pragma("unroll") for (int n = 0; n < 2; ++n) _Pragma("unroll") for (int k = 0; k < 2; ++k) dst[n][k] = *(const PG8_LAS bf16x8*)(lds + PG8_SB(b, h) + boff + n * 2048 + k * 1024); } while (0)
#define PG8_MMA(ai, bj, At, Bt) do { __builtin_amdgcn_s_setprio(1); _Pragma("unroll") for (int m = 0; m < 4; ++m) _Pragma("unroll") for (int n = 0; n < 2; ++n) _Pragma("unroll") for (int k = 0; k < 2; ++k) \
        acc[ai][bj][m][n] = __builtin_amdgcn_mfma_f32_16x16x32_bf16(Bt[n][k], At[m][k], acc[ai][bj][m][n], 0, 0, 0); __builtin_amdgcn_s_setprio(0); } while (0)
#define PG8_WAIT_V(n) asm volatile("s_waitcnt vmcnt(" #n ")" ::: "memory")
#define PG8_WAIT_L(n) asm volatile("s_waitcnt lgkmcnt(" #n ")" ::: "memory")
#define PG8_BAR __builtin_amdgcn_s_barrier()
#define PG8_SCHED __builtin_amdgcn_sched_barrier(0)
    Unit cur, nxt; int ui = 0;
    if (!S.next(0, cur)) return;
    f32x4 acc[2][2][4][2];
#pragma unroll
    for (int a = 0; a < 2; ++a)
#pragma unroll
        for (int b = 0; b < 2; ++b)
#pragma unroll
            for (int m = 0; m < 4; ++m)
#pragma unroll
                for (int n = 0; n < 2; ++n) acc[a][b][m][n] = (f32x4){0.f, 0.f, 0.f, 0.f};
    bf16x8 At[4][2], B0[2][2], B1[2][2];
    const char* cA = (const char*)g.A + (size_t)cur.pm * tstep; const char* cB = (const char*)g.Bt + (size_t)cur.pn * tstep;
    S.a_ready(cur);
    if constexpr (SP2) {
        PG8_STAGE(PG8_SB(0, 0), cB, voffB); PG8_STAGE(PG8_SB(0, 1), cB + hstep, voffB); PG8_STAGE(PG8_SA(0, 0), cA, voffA); PG8_STAGE(PG8_SA(0, 1), cA + hstep, voffA);
        if (wr == 1) PG8_BAR;
        PG8_WAIT_V(2); PG8_BAR;
        PG8_STAGE(PG8_SB(1, 0), cB + kstep, voffB); PG8_STAGE(PG8_SA(1, 0), cA + kstep, voffA); PG8_STAGE(PG8_SB(1, 1), cB + hstep + kstep, voffB);
        PG8_WAIT_V(6); PG8_BAR;
    } else {
        PG8_STAGE(PG8_SB(0, 0), cB, voffB); PG8_STAGE(PG8_SA(0, 0), cA, voffA); PG8_STAGE(PG8_SB(0, 1), cB + hstep, voffB); PG8_STAGE(PG8_SA(0, 1), cA + hstep, voffA);
        if (wr == 1) PG8_BAR;
        PG8_WAIT_V(4); PG8_BAR;
        PG8_STAGE(PG8_SB(1, 0), cB + kstep, voffB); PG8_STAGE(PG8_SA(1, 0), cA + kstep, voffA); PG8_STAGE(PG8_SB(1, 1), cB + hstep + kstep, voffB);
        PG8_WAIT_V(6); PG8_BAR;
    }
    for (;;) {
        const bool has_next = S.next(ui + 1, nxt);
        const char* nA = has_next ? (const char*)g.A + (size_t)nxt.pm * tstep : cA; const char* nB = has_next ? (const char*)g.Bt + (size_t)nxt.pn * tstep : cB;
        for (int t = 0; t < nt; t += 2) {
            const bool last = (t == nt - 2);
            const char* a1 = cA + (size_t)(t + 1) * kstep;
            const char* a2 = last ? nA : cA + (size_t)(t + 2) * kstep; const char* b2 = last ? nB : cB + (size_t)(t + 2) * kstep;
            const char* a3 = a2 + kstep; const char* b3 = b2 + kstep;
            if (last && has_next) S.a_ready(nxt);
            if constexpr (SP2) {
            PG8_LDB(B0, 0, 0); PG8_LDB(B1, 0, 1); PG8_SCHED; PG8_LDA(At, 0, 0); PG8_STAGE(PG8_SA(1, 1), a1 + hstep, voffA);
            PG8_WAIT_V(8); PG8_WAIT_L(0); PG8_BAR; PG8_MMA(0, 0, At, B0); PG8_MMA(0, 1, At, B1); PG8_BAR; PG8_SCHED;
            PG8_LDA(At, 0, 1); PG8_STAGE(PG8_SB(0, 0), b2, voffB); PG8_STAGE(PG8_SB(0, 1), b2 + hstep, voffB); PG8_STAGE(PG8_SA(0, 0), a2, voffA);
            PG8_WAIT_V(8); PG8_WAIT_L(0); PG8_BAR; PG8_MMA(1, 0, At, B0); PG8_MMA(1, 1, At, B1); PG8_BAR; PG8_SCHED;
            PG8_LDB(B0, 1, 0); PG8_LDB(B1, 1, 1); PG8_SCHED; PG8_LDA(At, 1, 0); PG8_STAGE(PG8_SA(0, 1), a2 + hstep, voffA);
            PG8_WAIT_V(8); PG8_WAIT_L(0); PG8_BAR; PG8_MMA(0, 0, At, B0); PG8_MMA(0, 1, At, B1); PG8_BAR; PG8_SCHED;
            PG8_LDA(At, 1, 1); PG8_STAGE(PG8_SB(1, 0), b3, voffB); PG8_STAGE(PG8_SB(1, 1), b3 + hstep, voffB); PG8_STAGE(PG8_SA(1, 0), a3, voffA);
            PG8_WAIT_V(8); PG8_WAIT_L(0); PG8_BAR; PG8_MMA(1, 0, At, B0); PG8_MMA(1, 1, At, B1); PG8_BAR; PG8_SCHED;
            } else {
            PG8_LDB(B0, 0, 0); PG8_SCHED; PG8_LDA(At, 0, 0); PG8_STAGE(PG8_SA(1, 1), a1 + hstep, voffA);
            PG8_WAIT_L(8); PG8_BAR; PG8_WAIT_L(0); PG8_MMA(0, 0, At, B0); PG8_BAR; PG8_SCHED;
            PG8_LDB(B1, 0, 1); PG8_STAGE(PG8_SB(0, 0), b2, voffB);
            PG8_BAR; PG8_WAIT_L(0); PG8_MMA(0, 1, At, B1); PG8_BAR;
            PG8_LDA(At, 0, 1); PG8_STAGE(PG8_SA(0, 0), a2, voffA);
            PG8_BAR; PG8_WAIT_L(0); PG8_MMA(1, 0, At, B0); PG8_BAR; PG8_SCHED;
            PG8_STAGE(PG8_SB(0, 1), b2 + hstep, voffB);
            PG8_WAIT_V(6); PG8_BAR; PG8_MMA(1, 1, At, B1); PG8_BAR;
            PG8_LDB(B0, 1, 0); PG8_SCHED; PG8_LDA(At, 1, 0); PG8_STAGE(PG8_SA(0, 1), a2 + hstep, voffA);
            PG8_WAIT_L(8); PG8_BAR; PG8_WAIT_L(0); PG8_MMA(0, 0, At, B0); PG8_BAR; PG8_SCHED;
            PG8_LDB(B1, 1, 1); PG8_STAGE(PG8_SB(1, 0), b3, voffB);
            PG8_BAR; PG8_WAIT_L(0); PG8_MMA(0, 1, At, B1); PG8_BAR;
            PG8_LDA(At, 1, 1); PG8_STAGE(PG8_SA(1, 0), a3, voffA);
            PG8_BAR; PG8_WAIT_L(0); PG8_MMA(1, 0, At, B0); PG8_BAR; PG8_SCHED;
            PG8_STAGE(PG8_SB(1, 1), b3 + hstep, voffB);
            PG8_WAIT_V(6); PG8_BAR; PG8_MMA(1, 1, At, B1); PG8_BAR;
            }
        }
        if constexpr (ALIGN_EPI) { if (wr == 0) PG8_BAR; }
        if constexpr (!Epi::AFTER_DRAIN) { E(acc, cur, wr, wc, fr, fq); S.done(cur); }
        if (!has_next) break;
#pragma unroll
        for (int a = 0; a < 2; ++a)
#pragma unroll
            for (int b = 0; b < 2; ++b)
#pragma unroll
                for (int m = 0; m < 4; ++m)
#pragma unroll
                    for (int n = 0; n < 2; ++n) acc[a][b][m][n] = (f32x4){0.f, 0.f, 0.f, 0.f};
        cur = nxt; cA = nA; cB = nB; ++ui;
        if constexpr (ALIGN_EPI) { if (wr == 1) PG8_BAR; }
    }
    PG8_WAIT_V(0);
    if constexpr (!ALIGN_EPI) { if (wr == 0) PG8_BAR; }
    PG8_BAR;
    if constexpr (Epi::AFTER_DRAIN) { E.fused(acc, cur, wr, wc, fr, fq, lds, wid, lane); S.done(cur); }
#undef PG8_SA
#undef PG8_SB
#undef PG8_STAGE
#undef PG8_LDA
#undef PG8_LDB
#undef PG8_MMA
#undef PG8_WAIT_V
#undef PG8_WAIT_L
#undef PG8_BAR
#undef PG8_SCHED
}
}
typedef unsigned short bf16;
typedef float f32x4 __attribute__((ext_vector_type(4)));
typedef unsigned u32x4 __attribute__((ext_vector_type(4)));
typedef unsigned u32x2 __attribute__((ext_vector_type(2)));
#define LAS __attribute__((address_space(3)))
constexpr int S_ = 8192, DM = 2048, MEML = 256;
constexpr int NZ = 9984;
constexpr float EPS = 1e-6f;
constexpr float LOG2E = 1.4426950408889634f;
constexpr float QSCALE = 0.125f * LOG2E;
constexpr float XSCALE = 0.08838834764831845f * LOG2E;
constexpr float LAMBDA_INIT = 0.2f;

constexpr size_t MiB = 1u << 20;
constexpr size_t WS_CTL = 0;
constexpr size_t WS_COS = 1 * MiB, WS_SIN = WS_COS + 256 * 1024, WS_SCAL = WS_SIN + 256 * 1024, WS_CPOS = WS_SCAL + 1024, WS_R1 = WS_SCAL + 4096, WS_R2 = WS_R1 + 32768;
constexpr size_t WS_SS1 = 2 * MiB, WS_SS2 = WS_SS1 + 256 * 1024, WS_KC = WS_SS2 + 256 * 1024, WS_VC = WS_KC + 256 * 1024;
constexpr size_t WS_KVM = 3 * MiB, WS_MEMN = WS_KVM + 512 * 1024;
constexpr size_t WS_NG = 5 * MiB, WS_KEYB = 7 * MiB, WS_USC = WS_KEYB + 128 * 1024, WS_VSC = WS_USC + 64 * 1024;
constexpr size_t WS_W1T = 8 * MiB, WS_WBDA = 47 * MiB, WS_WBNSA = 51 * MiB, WS_WOUT = 55 * MiB, WS_WXQ = 63 * MiB, WS_WXKV = 65 * MiB, WS_WXO = 69 * MiB, WS_WPQ = 71 * MiB, WS_W1C = 79 * MiB;
constexpr size_t WS_XN = 80 * MiB, WS_ODA = 80 * MiB, WS_ONSA = 96 * MiB;
constexpr size_t WS_Z = 112 * MiB, WS_UQ = 112 * MiB, WS_VQ = 144 * MiB, WS_MIX = 240 * MiB, WS_H1 = 420 * MiB;
constexpr size_t WS_QDA = 268 * MiB, WS_KDA = 284 * MiB, WS_VDA = 300 * MiB, WS_NQ = 316 * MiB, WS_KV6 = 332 * MiB, WS_BG = 356 * MiB;
constexpr size_t WS_H1B = 272 * MiB, WS_QX = 304 * MiB, WS_OX = 312 * MiB, WS_H2 = 320 * MiB, WS_H2B = 384 * MiB, WS_PQ = 416 * MiB, WS_END = 484 * MiB;

__device__ __forceinline__ float bf2f(unsigned short v) { return __uint_as_float(((unsigned)v) << 16); }
__device__ __forceinline__ unsigned short f2bf(float f) { unsigned u = __float_as_uint(f); return (unsigned short)((u + 0x7fffu + ((u >> 16) & 1u)) >> 16); }
__device__ __forceinline__ unsigned pk2(float lo, float hi) { return (unsigned)f2bf(lo) | ((unsigned)f2bf(hi) << 16); }
template <int CTRL> __device__ __forceinline__ float dppf(float v) { return __uint_as_float(__builtin_amdgcn_mov_dpp(__float_as_uint(v), CTRL, 0xF, 0xF, true)); }
template <int CTRL> __device__ __forceinline__ int dppi(int v) { return __builtin_amdgcn_mov_dpp(v, CTRL, 0xF, 0xF, true); }
constexpr int DPP_X1 = 0xB1, DPP_X2 = 0x4E, DPP_HMIR = 0x141, DPP_MIR = 0x140;
__device__ __forceinline__ float sum_x32(float v) { auto r = __builtin_amdgcn_permlane32_swap(__float_as_uint(v), __float_as_uint(v), false, false); return __uint_as_float(r[0]) + __uint_as_float(r[1]); }
__device__ __forceinline__ float max_x32(float v) { auto r = __builtin_amdgcn_permlane32_swap(__float_as_uint(v), __float_as_uint(v), false, false); return fmaxf(__uint_as_float(r[0]), __uint_as_float(r[1])); }
__device__ __forceinline__ float sum_x16(float v) { auto r = __builtin_amdgcn_permlane16_swap(__float_as_uint(v), __float_as_uint(v), false, false); return __uint_as_float(r[0]) + __uint_as_float(r[1]); }
__device__ __forceinline__ float max_x16(float v) { auto r = __builtin_amdgcn_permlane16_swap(__float_as_uint(v), __float_as_uint(v), false, false); return fmaxf(__uint_as_float(r[0]), __uint_as_float(r[1])); }
__device__ __forceinline__ float wave_sum(float v) {
    v += dppf<DPP_X1>(v); v += dppf<DPP_X2>(v); v += dppf<DPP_HMIR>(v); v += dppf<DPP_MIR>(v);
    return sum_x32(sum_x16(v));
}
__device__ __forceinline__ float wave_max(float v) {
    v = fmaxf(v, dppf<DPP_X1>(v)); v = fmaxf(v, dppf<DPP_X2>(v)); v = fmaxf(v, dppf<DPP_HMIR>(v)); v = fmaxf(v, dppf<DPP_MIR>(v));
    return max_x32(max_x16(v));
}
__device__ __forceinline__ float gelu_exact(float x) { return 0.5f * x * (1.0f + erff(x * 0.70710678118654752f)); }
__device__ __forceinline__ float sigmoidf_(float x) { return 1.0f / (1.0f + __expf(-x)); }

struct Ptrs { const float* in[30]; float* out; unsigned char* ws; };

__device__ __forceinline__ int zmap(int n) { return n < 5632 ? n : (n < 9728 ? n + 48 : (n < 9776 ? n - 9728 + 5632 : -1)); }

struct TrItem { const float* W; bf16* WT; const float* gk; int K, Nsrc, kb, nb; bool zmap; };
__device__ __forceinline__ void tr_load(const TrItem& t, int lane, f32x4 (&v)[8]) {
    const int k0 = 64 * t.kb, n0 = 32 * t.nb, r8 = lane >> 3, c4 = (lane & 7) * 4;
    const int sc = t.zmap ? zmap(n0 + c4) : n0 + c4;
#pragma unroll
    for (int i = 0; i < 8; ++i) { const int kk = 8 * i + r8; v[i] = (f32x4){0.f, 0.f, 0.f, 0.f}; if (sc >= 0) { v[i] = *(const f32x4*)(t.W + (size_t)(k0 + kk) * t.Nsrc + sc); if (t.gk) v[i] = v[i] * t.gk[k0 + kk]; } }
}
__device__ __forceinline__ void tr_finish(const TrItem& t, int lane, const f32x4 (&v)[8], LAS float* scr) {
    const int k0 = 64 * t.kb, n0 = 32 * t.nb, r8 = lane >> 3, c4 = (lane & 7) * 4;
#pragma unroll
    for (int i = 0; i < 8; ++i) { const int kk = 8 * i + r8; scr[kk * 33 + c4] = v[i].x; scr[kk * 33 + c4 + 1] = v[i].y; scr[kk * 33 + c4 + 2] = v[i].z; scr[kk * 33 + c4 + 3] = v[i].w; }
    asm volatile("s_waitcnt lgkmcnt(0)" ::: "memory");
    const int c = lane & 7;
#pragma unroll
    for (int j = 0; j < 4; ++j) { const int n = (lane >> 3) + 8 * j; const LAS float* s = scr + (8 * c) * 33 + n;
        u32x4 o; o.x = pk2(s[0 * 33], s[1 * 33]); o.y = pk2(s[2 * 33], s[3 * 33]); o.z = pk2(s[4 * 33], s[5 * 33]); o.w = pk2(s[6 * 33], s[7 * 33]);
        *(u32x4*)(t.WT + (size_t)(n0 + n) * t.K + k0 + 8 * c) = o; }
    asm volatile("s_waitcnt lgkmcnt(0)" ::: "memory");
}
__device__ __forceinline__ void rms_row_to_bf16(const float* xrow, const float* g, bf16* orow, int lane) {
    const f32x4* xr = (const f32x4*)xrow + lane; const f32x4* gr = (const f32x4*)g + lane;
    f32x4 v[8]; float s = 0.f;
#pragma unroll
    for (int j = 0; j < 8; ++j) { v[j] = xr[64 * j]; s += (v[j].x * v[j].x + v[j].y * v[j].y) + (v[j].z * v[j].z + v[j].w * v[j].w); }
    const float r = rsqrtf(wave_sum(s) * (1.f / DM) + EPS);
    u32x2* o8 = (u32x2*)orow + lane;
#pragma unroll
    for (int j = 0; j < 8; ++j) { const f32x4 gg = gr[64 * j]; u32x2 w; w.x = pk2(v[j].x * r * gg.x, v[j].y * r * gg.y); w.y = pk2(v[j].z * r * gg.z, v[j].w * r * gg.w); o8[64 * j] = w; }
}
#define XB_TMO      128
#define XB_XCNT(j)  (256  + 64 * (j))
#define XB_XSUB(j)  (1280 + 64 * (j))
#define XB_XGEN(j)  (2304 + 64 * (j))
#define XB_TOP      3328
#define XB_TOPGEN   3392
#define XCD_BAR_WORDS 3456
#define XB_SPIN_CAP (1u << 18)

__device__ __forceinline__ unsigned xb_ld(unsigned* p)              { return __hip_atomic_load(p, __ATOMIC_RELAXED, __HIP_MEMORY_SCOPE_AGENT); }
__device__ __forceinline__ unsigned xb_add(unsigned* p, unsigned v) { return __hip_atomic_fetch_add(p, v, __ATOMIC_RELAXED, __HIP_MEMORY_SCOPE_AGENT); }
__device__ __forceinline__ unsigned xb_xcc_id() { return (unsigned)__builtin_amdgcn_s_getreg((3 << 11) | 20) & 0xFu; }
#define XB_SPIN(cond, bar) do { unsigned _sp = 0; while (cond) { __builtin_amdgcn_s_sleep(1); \
    if ((++_sp & 255u) == 0u) { if (xb_ld(&(bar)[XB_TMO])) break; if (_sp > XB_SPIN_CAP) { atomicAdd(&(bar)[XB_TMO], 1u); break; } } } } while (0)

struct XcdBarrier {
    unsigned* bar; unsigned x;
    volatile LAS unsigned* st;
};

__device__ __forceinline__ XcdBarrier xcd_barrier_post(unsigned* bar, volatile LAS unsigned* st) {
    XcdBarrier b; b.bar = bar; b.x = xb_xcc_id(); b.st = st;
    if (threadIdx.x == 0) (void)xb_add(&bar[XB_XCNT(b.x)], 1u);
    return b;
}
__device__ __forceinline__ void xcd_barrier_complete(unsigned* bar, unsigned x, unsigned& nloc, unsigned& nx) {
    const unsigned G = gridDim.x * gridDim.y * gridDim.z;
    unsigned sum, cnt, mine, sp = 0u;
    for (;;) {
        sum = 0u; cnt = 0u; mine = 0u;
#pragma unroll
        for (unsigned j = 0; j < 16; ++j) { const unsigned c = xb_ld(&bar[XB_XCNT(j)]); sum += c; cnt += (c > 0u) ? 1u : 0u; mine = (j == x) ? c : mine; }
        if (sum == G) break;
        __builtin_amdgcn_s_sleep(1);
        if ((++sp & 255u) == 0u) { if (xb_ld(&bar[XB_TMO])) break; if (sp > XB_SPIN_CAP) { atomicAdd(&bar[XB_TMO], 1u); break; } }
    }
    nloc = mine > 0u ? mine : 1u; nx = cnt > 0u ? cnt : 1u;
}

__device__ __forceinline__ void xcd_barrier(const XcdBarrier& b) {
    asm volatile("s_waitcnt vmcnt(0)" ::: "memory");
    __syncthreads();
    if (threadIdx.x == 0) {
        unsigned* bar = b.bar;
        __builtin_amdgcn_s_waitcnt(0);
        unsigned nloc = b.st[0], nx = b.st[1];
        if (nloc == 0u) { xcd_barrier_complete(bar, b.x, nloc, nx); b.st[0] = nloc; b.st[1] = nx; }
        const unsigned old = xb_add(&bar[XB_XSUB(b.x)], 1u);
        const unsigned gen = old / nloc;
        if (old + 1u == (gen + 1u) * nloc) {
            __builtin_amdgcn_fence(__ATOMIC_RELEASE, "agent");
            asm volatile("s_waitcnt vmcnt(0)" ::: "memory");
            const unsigned og = xb_add(&bar[XB_TOP], 1u);
            const unsigned tg = og / nx;
            if (og + 1u == (tg + 1u) * nx) xb_add(&bar[XB_TOPGEN], 1u);
            else XB_SPIN(xb_ld(&bar[XB_TOPGEN]) == tg, bar);
            __builtin_amdgcn_fence(__ATOMIC_ACQUIRE, "agent");
            xb_add(&bar[XB_XGEN(b.x)], 1u);
            asm volatile("s_waitcnt vmcnt(0)" ::: "memory");
        } else {
            XB_SPIN(xb_ld(&bar[XB_XGEN(b.x)]) == gen, bar);
            __builtin_amdgcn_fence(__ATOMIC_ACQUIRE, "agent");
            asm volatile("s_waitcnt vmcnt(0)" ::: "memory");
        }
    }
    __syncthreads();
}

constexpr int NWAVES = 8;
constexpr int RING_BYTES = 131072;
constexpr int LDSCTL_OFF = 144384, MISC_OFF = LDSCTL_OFF + 320, RTAB_OFF = LDSCTL_OFF + 1024;
constexpr int LDS_BYTES = 147456;
constexpr int CW_BAR = 4096;
typedef short bf16x8 __attribute__((ext_vector_type(8)));
typedef short s16x4 __attribute__((ext_vector_type(4)));
typedef float f32x16 __attribute__((ext_vector_type(16)));
typedef float f32x2_t __attribute__((ext_vector_type(2)));
typedef __bf16 bf16x2_t __attribute__((ext_vector_type(2)));
#define MFMA32(a, b, c) __builtin_amdgcn_mfma_f32_32x32x16_bf16((a), (b), (c), 0, 0, 0)
__device__ __forceinline__ unsigned cvtpk(float lo, float hi) { f32x2_t v = {lo, hi}; bf16x2_t b = __builtin_convertvector(v, bf16x2_t); return __builtin_bit_cast(unsigned, b); }
__device__ __forceinline__ int crow(int r, int hi) { return (r & 3) + 8 * (r >> 2) + 4 * hi; }
__device__ __forceinline__ float fexp2(float x) { return __builtin_amdgcn_exp2f(x); }
typedef short v4i16_t __attribute__((ext_vector_type(4)));
__device__ __forceinline__ s16x4 tr_read(const LAS char* p) { return __builtin_bit_cast(s16x4, __builtin_amdgcn_ds_read_tr16_b64_v4i16((LAS v4i16_t*)p)); }

struct Args { const float* in[30]; float* out; unsigned char* ws; int ph_lo, ph_hi; };

template <int DV> struct Flash { f32x16 o[DV / 32]; f32x16 negm; float mref, l; bool started; };
template <int DV> __device__ __forceinline__ void flash_init(Flash<DV>& f) {
#pragma unroll
    for (int d = 0; d < DV / 32; ++d)
#pragma unroll
        for (int r = 0; r < 16; ++r) f.o[d][r] = 0.f;
#pragma unroll
    for (int r = 0; r < 16; ++r) f.negm[r] = 0.f;
    f.mref = 0.f; f.l = 0.f; f.started = false;
}
constexpr float FLASH_THR = 6.0f;
template <int DK, int KS>
__device__ __forceinline__ void qk_scores(const bf16x8 (&qf)[DK / 16], const LAS char* kt, int lane, const f32x16& c, f32x16& p0, f32x16& p1) {
    const int r32 = lane & 31, hi = lane >> 5;
    const LAS char* kp = kt + r32 * KS + hi * 16;
    bf16x8 a0[DK / 16], a1[DK / 16];
#pragma unroll
    for (int ks = 0; ks < DK / 16; ++ks) { a0[ks] = *(const LAS bf16x8*)(kp + ks * 32); a1[ks] = *(const LAS bf16x8*)(kp + 32 * KS + ks * 32); }
    __builtin_amdgcn_sched_barrier(0);
#pragma unroll
    for (int ks = 0; ks < DK / 16; ++ks) {
        if (ks == 0) { p0 = MFMA32(a0[0], qf[0], c); p1 = MFMA32(a1[0], qf[0], c); }
        else { p0 = MFMA32(a0[ks], qf[ks], p0); p1 = MFMA32(a1[ks], qf[ks], p1); }
    }
}
__device__ __forceinline__ float tile_colmax(const f32x16& p0, const f32x16& p1) {
    float mx = fmaxf(p0[0], p1[0]);
#pragma unroll
    for (int r = 1; r < 16; ++r) mx = fmaxf(mx, fmaxf(p0[r], p1[r]));
    return max_x32(mx);
}
template <int DV, int VS>
__device__ __forceinline__ void pv_accum(f32x16 (&o)[DV / 32], const f32x16& p0, const f32x16& p1, const LAS char* vt, int lane) {
    const int hi = lane >> 5;
    const LAS char* vb = vt + (4 * hi + ((lane & 15) >> 2)) * VS + (((lane >> 4) & 1) * 16 + (lane & 3) * 4) * 2;
#pragma unroll
    for (int k4 = 0; k4 < 4; ++k4) {
        u32x4 pw;
        if (k4 < 2) { pw.x = cvtpk(p0[8 * (k4 & 1) + 0], p0[8 * (k4 & 1) + 1]); pw.y = cvtpk(p0[8 * (k4 & 1) + 2], p0[8 * (k4 & 1) + 3]); pw.z = cvtpk(p0[8 * (k4 & 1) + 4], p0[8 * (k4 & 1) + 5]); pw.w = cvtpk(p0[8 * (k4 & 1) + 6], p0[8 * (k4 & 1) + 7]); }
        else        { pw.x = cvtpk(p1[8 * (k4 & 1) + 0], p1[8 * (k4 & 1) + 1]); pw.y = cvtpk(p1[8 * (k4 & 1) + 2], p1[8 * (k4 & 1) + 3]); pw.z = cvtpk(p1[8 * (k4 & 1) + 4], p1[8 * (k4 & 1) + 5]); pw.w = cvtpk(p1[8 * (k4 & 1) + 6], p1[8 * (k4 & 1) + 7]); }
        const bf16x8 pf = __builtin_bit_cast(bf16x8, pw);
#pragma unroll
        for (int d = 0; d < DV / 32; ++d) {
            const s16x4 lo = tr_read(vb + (16 * k4) * VS + d * 64);
            const s16x4 hh = tr_read(vb + (16 * k4 + 8) * VS + d * 64);
            const bf16x8 a = {lo[0], lo[1], lo[2], lo[3], hh[0], hh[1], hh[2], hh[3]};
            o[d] = MFMA32(a, pf, o[d]);
        }
    }
}
typedef __bf16 bf16x2d __attribute__((ext_vector_type(2)));
__device__ __forceinline__ float dot2ones(unsigned a, float c) { return __builtin_amdgcn_fdot2_f32_bf16(__builtin_bit_cast(bf16x2d, a), __builtin_bit_cast(bf16x2d, 0x3f803f80u), c, false); }
struct PTile { u32x4 k[4]; };
__device__ __forceinline__ void pack_ptile(const f32x16& p0, const f32x16& p1, PTile& P) {
#pragma unroll
    for (int s = 0; s < 2; ++s) {
        P.k[s].x = cvtpk(p0[8 * s + 0], p0[8 * s + 1]); P.k[s].y = cvtpk(p0[8 * s + 2], p0[8 * s + 3]); P.k[s].z = cvtpk(p0[8 * s + 4], p0[8 * s + 5]); P.k[s].w = cvtpk(p0[8 * s + 6], p0[8 * s + 7]);
        P.k[2 + s].x = cvtpk(p1[8 * s + 0], p1[8 * s + 1]); P.k[2 + s].y = cvtpk(p1[8 * s + 2], p1[8 * s + 3]); P.k[2 + s].z = cvtpk(p1[8 * s + 4], p1[8 * s + 5]); P.k[2 + s].w = cvtpk(p1[8 * s + 6], p1[8 * s + 7]);
    }
}
template <int DV, int VS>
__device__ __forceinline__ void flash_pv(f32x16 (&o)[DV / 32], const PTile& P, const LAS char* vt, int lane) {
    const int hi = lane >> 5;
    const LAS char* vb = vt + (4 * hi + ((lane & 15) >> 2)) * VS + (((lane >> 4) & 1) * 16 + (lane & 3) * 4) * 2;
    s16x4 lo[2][DV / 32], hh[2][DV / 32];
#pragma unroll
    for (int d = 0; d < DV / 32; ++d) { lo[0][d] = tr_read(vb + d * 64); hh[0][d] = tr_read(vb + 8 * VS + d * 64); }
#pragma unroll
    for (int k4 = 0; k4 < 4; ++k4) {
        const int cur = k4 & 1, nxt = cur ^ 1;
        if (k4 < 3) {
#pragma unroll
            for (int d = 0; d < DV / 32; ++d) { lo[nxt][d] = tr_read(vb + (16 * (k4 + 1)) * VS + d * 64); hh[nxt][d] = tr_read(vb + (16 * (k4 + 1) + 8) * VS + d * 64); }
        }
        __builtin_amdgcn_sched_barrier(0);
        const bf16x8 pf = __builtin_bit_cast(bf16x8, P.k[k4]);
#pragma unroll
        for (int d = 0; d < DV / 32; ++d) {
            const bf16x8 a = {lo[cur][d][0], lo[cur][d][1], lo[cur][d][2], lo[cur][d][3], hh[cur][d][0], hh[cur][d][1], hh[cur][d][2], hh[cur][d][3]};
            o[d] = MFMA32(a, pf, o[d]);
        }
        __builtin_amdgcn_sched_barrier(0);
    }
}
template <int DK, int DV, int KS, bool HASCOL, class MaskF>
__device__ __forceinline__ void flash_qk_sm(Flash<DV>& f, const bf16x8 (&qf)[DK / 16], const LAS char* kt, int lane, bool colsel, MaskF mask, PTile& P) {
    f32x16 p0, p1;
    if (HASCOL) { f32x16 c;
#pragma unroll
        for (int r = 0; r < 16; ++r) c[r] = colsel ? f.negm[r] : -INFINITY;
        qk_scores<DK, KS>(qf, kt, lane, c, p0, p1);
    } else qk_scores<DK, KS>(qf, kt, lane, f.negm, p0, p1);
    mask(p0, p1);
    const float cm = tile_colmax(p0, p1);
    const bool fin = cm > -INFINITY;
    const float delta = f.started ? (cm > FLASH_THR ? cm : 0.f) : (fin ? cm : 0.f);
    if (__any(delta != 0.f)) {
        const float fac = f.started ? fexp2(-delta) : 1.f;
#pragma unroll
        for (int r = 0; r < 16; ++r) { p0[r] -= delta; p1[r] -= delta; }
#pragma unroll
        for (int d = 0; d < DV / 32; ++d)
#pragma unroll
            for (int r = 0; r < 16; ++r) f.o[d][r] *= fac;
        f.l *= fac; f.mref += delta;
#pragma unroll
        for (int r = 0; r < 16; ++r) f.negm[r] = -f.mref;
    }
    f.started = f.started || fin;
#pragma unroll
    for (int r = 0; r < 16; ++r) { p0[r] = fexp2(p0[r]); p1[r] = fexp2(p1[r]); }
    pack_ptile(p0, p1, P);
    float ps = 0.f;
#pragma unroll
    for (int k = 0; k < 4; ++k) { ps = dot2ones(P.k[k].x, ps); ps = dot2ones(P.k[k].y, ps); ps = dot2ones(P.k[k].z, ps); ps = dot2ones(P.k[k].w, ps); }
    f.l += ps;
}
template <int DK, int DV, int KS, int VS, bool HASCOL, class MaskF>
__device__ __forceinline__ void flash_tile(Flash<DV>& f, const bf16x8 (&qf)[DK / 16], const LAS char* kt, const LAS char* vt, int lane, bool colsel, MaskF mask) {
    PTile P; flash_qk_sm<DK, DV, KS, HASCOL>(f, qf, kt, lane, colsel, mask, P); flash_pv<DV, VS>(f.o, P, vt, lane);
}

#define LDS_BARRIER() do { asm volatile("s_waitcnt lgkmcnt(0)" ::: "memory"); __builtin_amdgcn_s_barrier(); asm volatile("" ::: "memory"); } while (0)
constexpr int DA_KS = 144, DA_VS = 320, DA_K1OFF = 64 * DA_KS, DA_KBUF = 2 * 64 * DA_KS, DA_VBUF = 64 * DA_VS, DA_VBASE = 2 * DA_KBUF;
__device__ __forceinline__ void da_unit(const Args& a, int h, int qb, LAS char* lds) {
    unsigned char* ws = a.ws;
    const bf16* QDA = (const bf16*)(ws + WS_QDA); const bf16* KDA = (const bf16*)(ws + WS_KDA); const bf16* VDA = (const bf16*)(ws + WS_VDA);
    bf16* ODA = (bf16*)(ws + WS_ODA);
    const int tid = threadIdx.x, lane = tid & 63, w = __builtin_amdgcn_readfirstlane(tid >> 6), m = w >> 2, wq = w & 3;
    const int r32 = lane & 31, hi = lane >> 5;
    const int qrow0 = 128 * qb + 32 * wq, q = qrow0 + r32;
    bf16x8 qf[4];
#pragma unroll
    for (int ks = 0; ks < 4; ++ks) qf[ks] = *(const bf16x8*)(QDA + (size_t)q * 1024 + h * 128 + m * 64 + 16 * ks + 8 * hi);
    Flash<128> f; flash_init(f);
    const int ntiles = 2 * qb + 2;
    const int nmine = (qrow0 + 31) / 64 + 1;
    const int kkey = tid >> 3, kc = tid & 7;
    const bf16* k0src = KDA + (size_t)kkey * 1024 + h * 128 + kc * 8;
    const bf16* vsrc0 = VDA + (size_t)(tid >> 4) * 1024 + h * 128 + (tid & 15) * 8;
    const int kdst = kkey * DA_KS + kc * 16, vdst0 = DA_VBASE + (tid >> 4) * DA_VS + (tid & 15) * 16, vdst1 = vdst0 + 32 * DA_VS;
    u32x4 sA[4], sB[4];
#define DA_LOAD(S, kt) do { const size_t o_ = (size_t)(kt) * 64 * 1024; S[0] = *(const u32x4*)(k0src + o_); S[1] = *(const u32x4*)(k0src + o_ + 64); S[2] = *(const u32x4*)(vsrc0 + o_); S[3] = *(const u32x4*)(vsrc0 + o_ + 32 * 1024); } while (0)
#define DA_STORE(S, kt) do { LAS char* kb_ = lds + ((kt) & 1) * DA_KBUF; const int vo_ = ((kt) % 3) * DA_VBUF; *(LAS u32x4*)(kb_ + kdst) = S[0]; *(LAS u32x4*)(kb_ + DA_K1OFF + kdst) = S[1]; *(LAS u32x4*)(lds + vo_ + vdst0) = S[2]; *(LAS u32x4*)(lds + vo_ + vdst1) = S[3]; } while (0)
#define DA_QKSM(kt) do { const int key0 = 64 * (kt); const bool need_mask = key0 + 63 > qrow0; \
            flash_qk_sm<64, 128, DA_KS, false>(f, qf, lds + ((kt) & 1) * DA_KBUF + m * DA_K1OFF, lane, true, [&](f32x16& p0, f32x16& p1) { \
                if (need_mask) { \
                    _Pragma("unroll") for (int r = 0; r < 16; ++r) { const int key = key0 + crow(r, hi); if (key > q) p0[r] = -INFINITY; if (key + 32 > q) p1[r] = -INFINITY; } \
                } }, P); } while (0)
#define DA_PV(kt) flash_pv<128, DA_VS>(f.o, P, lds + DA_VBASE + ((kt) % 3) * DA_VBUF, lane)
#define DA_STEP(kt, S) do { \
        if (m == 1 && (kt) >= 1 && (kt) - 1 < nmine) DA_PV((kt) - 1); \
        if ((kt) < nmine) DA_QKSM(kt); \
        if (m == 0 && (kt) < nmine) DA_PV(kt); \
        if ((kt) + 1 < ntiles) DA_STORE(S, (kt) + 1); if ((kt) + 3 < ntiles) DA_LOAD(S, (kt) + 3); LDS_BARRIER(); } while (0)
    PTile P;
    DA_LOAD(sA, 0); DA_STORE(sA, 0);
    DA_LOAD(sB, 1);
    if (ntiles > 2) DA_LOAD(sA, 2);
    __syncthreads();
    for (int kt = 0; kt < ntiles; kt += 2) { DA_STEP(kt, sB); DA_STEP(kt + 1, sA); }
    if (m == 1 && ntiles - 1 < nmine) DA_PV(ntiles - 1);
    __syncthreads();
#undef DA_LOAD
#undef DA_STORE
#undef DA_QKSM
#undef DA_PV
#undef DA_STEP
    const float l = sum_x32(f.l);
    const float inv = 1.f / l;
    LAS float* o1s = (LAS float*)lds;
    if (m == 1) {
#pragma unroll
        for (int d = 0; d < 4; ++d)
#pragma unroll
            for (int r = 0; r < 16; ++r) o1s[(d * 16 + r) * 256 + wq * 64 + lane] = f.o[d][r] * inv;
    }
    __syncthreads();
    if (m == 0) {
        const float lam = ((const float*)(ws + WS_SCAL))[0];
        float ss = 0.f;
#pragma unroll
        for (int d = 0; d < 4; ++d)
#pragma unroll
            for (int r = 0; r < 16; ++r) { const float v = f.o[d][r] * inv - lam * o1s[(d * 16 + r) * 256 + wq * 64 + lane]; f.o[d][r] = v; ss += v * v; }
        ss = sum_x32(ss);
        const float rr = rsqrtf(ss * (1.f / 128.f) + EPS) * (1.f - LAMBDA_INIT);
        const float* sg = a.in[9];
#pragma unroll
        for (int d = 0; d < 4; ++d)
#pragma unroll
            for (int r4 = 0; r4 < 4; ++r4) { const int dv = 32 * d + 8 * r4 + 4 * hi; const f32x4 g4 = *(const f32x4*)(sg + dv);
                u32x2 o; o.x = pk2(f.o[d][4 * r4] * rr * g4.x, f.o[d][4 * r4 + 1] * rr * g4.y); o.y = pk2(f.o[d][4 * r4 + 2] * rr * g4.z, f.o[d][4 * r4 + 3] * rr * g4.w);
                *(u32x2*)(ODA + (size_t)q * 1024 + h * 128 + dv) = o; }
    }
    __syncthreads();
}
template <class F> struct EpiFn {
    static constexpr bool PERM = false, AFTER_DRAIN = false; F f;
    __device__ __forceinline__ void operator()(const pg8::f32x4 (&acc)[2][2][4][2], const pg8::Unit& u, int wr, int wc, int fr, int fq) const {
#pragma unroll
        for (int ai = 0; ai < 2; ++ai)
#pragma unroll
            for (int m = 0; m < 4; ++m) { const int row = u.pm * 256 + ai * 128 + wr * 64 + m * 16 + fr;
#pragma unroll
                for (int bj = 0; bj < 2; ++bj)
#pragma unroll
                    for (int n = 0; n < 2; ++n) f(row, u.pn * 256 + bj * 128 + wc * 32 + n * 16 + fq * 4, acc[ai][bj][m][n]); }
    }
};
struct FStoreBf16 { bf16* O; int ldc; __device__ __forceinline__ void operator()(int row, int col, f32x4 v) const { u32x2 w; w.x = pk2(v.x, v.y); w.y = pk2(v.z, v.w); *(u32x2*)(O + (size_t)row * ldc + col) = w; } };
struct FGate0 { bf16* MIX; const bf16* BG; __device__ __forceinline__ void operator()(int row, int col, f32x4 v) const {
    const u32x2 g = *(const u32x2*)(BG + (size_t)row * 4096 + col); u32x2 w;
    w.x = pk2(v.x * __uint_as_float(g.x << 16), v.y * __uint_as_float(g.x & 0xffff0000u)); w.y = pk2(v.z * __uint_as_float(g.y << 16), v.w * __uint_as_float(g.y & 0xffff0000u));
    *(u32x2*)(MIX + (size_t)row * 2048 + col) = w; } };
struct FGate1 { bf16* MIX; const bf16* BG; __device__ __forceinline__ void operator()(int row, int col, f32x4 v) const {
    const u32x2 g = *(const u32x2*)(BG + (size_t)row * 4096 + 2048 + col); const u32x2 o = *(const u32x2*)(MIX + (size_t)row * 2048 + col); u32x2 w;
    w.x = pk2(__uint_as_float(o.x << 16) + v.x * __uint_as_float(g.x << 16), __uint_as_float(o.x & 0xffff0000u) + v.y * __uint_as_float(g.x & 0xffff0000u));
    w.y = pk2(__uint_as_float(o.y << 16) + v.z * __uint_as_float(g.y << 16), __uint_as_float(o.y & 0xffff0000u) + v.w * __uint_as_float(g.y & 0xffff0000u));
    *(u32x2*)(MIX + (size_t)row * 2048 + col) = w; } };
template <bool BB> struct EpiResSS {
    static constexpr bool PERM = false, AFTER_DRAIN = false; const void* base; bf16* outb; float* ss;
    __device__ __forceinline__ void operator()(const pg8::f32x4 (&acc)[2][2][4][2], const pg8::Unit& u, int wr, int wc, int fr, int fq) const {
#pragma unroll
        for (int ai = 0; ai < 2; ++ai)
#pragma unroll
            for (int m = 0; m < 4; ++m) { const int row = u.pm * 256 + ai * 128 + wr * 64 + m * 16 + fr; float sq = 0.f;
#pragma unroll
                for (int bj = 0; bj < 2; ++bj)
#pragma unroll
                    for (int n = 0; n < 2; ++n) { const size_t o = (size_t)row * 2048 + u.pn * 256 + bj * 128 + wc * 32 + n * 16 + fq * 4;
                        f32x4 bv;
                        if (BB) { const u32x2 t = *(const u32x2*)((const bf16*)base + o); bv = (f32x4){__uint_as_float(t.x << 16), __uint_as_float(t.x & 0xffff0000u), __uint_as_float(t.y << 16), __uint_as_float(t.y & 0xffff0000u)}; }
                        else bv = *(const f32x4*)((const float*)base + o);
                        const f32x4 v = acc[ai][bj][m][n] + bv; u32x2 w; w.x = pk2(v.x, v.y); w.y = pk2(v.z, v.w); *(u32x2*)(outb + o) = w;
                        sq += (v.x * v.x + v.y * v.y) + (v.z * v.z + v.w * v.w); }
                sq = sum_x32(sum_x16(sq));
                if (fq == 0) ss[(size_t)(u.pn * 4 + wc) * S_ + row] = sq; }
    }
};
struct FRowScaleL { const LAS float* rtab; bf16* O; float scale; int ldc;
    __device__ __forceinline__ void operator()(int row, int col, f32x4 v) const { const float s = rtab[row & 255] * scale; u32x2 w; w.x = pk2(v.x * s, v.y * s); w.y = pk2(v.z * s, v.w * s); *(u32x2*)(O + (size_t)row * ldc + col) = w; } };
__device__ __forceinline__ void make_rtab(const pg8::StaticOrder& S, const float* ss, LAS float* rtab) {
    pg8::Unit u;
    if (S.next(0, u) && threadIdx.x < 256) { const int row = u.pm * 256 + threadIdx.x; float s = 0.f;
#pragma unroll 8
        for (int k = 0; k < 32; ++k) s += ss[(size_t)k * S_ + row];
        rtab[threadIdx.x] = rsqrtf(s * (1.f / DM) + EPS); }
    __syncthreads();
}

constexpr int TR_I0 = 32 * (NZ / 32), TR_I1 = 16 * 64, TR_I2 = 16 * 64, TR_I3 = 32 * 64, TR_I4 = 32 * 16, TR_I5 = 32 * 32, TR_I6 = 8 * 64, TR_I7 = 32 * 64, TR_I8 = 32 * 4;
constexpr int TR_NEARLY = TR_I0 + TR_I5, TR_NIT = TR_I0 + TR_I1 + TR_I2 + TR_I3 + TR_I4 + TR_I5 + TR_I6 + TR_I7 + 2 * TR_I8;
__device__ __forceinline__ TrItem tr_item_of(const Args& P, int it) {
    unsigned char* ws = P.ws;
    int r = it; TrItem t; t.gk = nullptr; t.zmap = false;
    if (r < TR_I0) { t.W = P.in[4]; t.K = 2048; t.Nsrc = 9776; t.WT = (bf16*)(ws + WS_W1T); t.zmap = true; t.kb = r / (NZ / 32); t.nb = r % (NZ / 32); return t; } r -= TR_I0;
    if (r < TR_I5) { t.W = P.in[21]; t.K = 2048; t.Nsrc = 1024; t.WT = (bf16*)(ws + WS_WXKV); t.kb = r / 32; t.nb = r % 32; return t; } r -= TR_I5;
    if (r < TR_I1) { t.W = P.in[15]; t.K = 1024; t.Nsrc = 2048; t.WT = (bf16*)(ws + WS_WBDA); t.kb = r / 64; t.nb = r % 64; return t; } r -= TR_I1;
    if (r < TR_I2) { t.W = P.in[16]; t.K = 1024; t.Nsrc = 2048; t.WT = (bf16*)(ws + WS_WBNSA); t.kb = r / 64; t.nb = r % 64; return t; } r -= TR_I2;
    if (r < TR_I3) { t.W = P.in[17]; t.K = 2048; t.Nsrc = 2048; t.WT = (bf16*)(ws + WS_WOUT); t.kb = r / 64; t.nb = r % 64; return t; } r -= TR_I3;
    if (r < TR_I4) { t.W = P.in[20]; t.K = 2048; t.Nsrc = 512; t.WT = (bf16*)(ws + WS_WXQ); t.gk = P.in[18]; t.kb = r / 16; t.nb = r % 16; return t; } r -= TR_I4;
    if (r < TR_I6) { t.W = P.in[22]; t.K = 512; t.Nsrc = 2048; t.WT = (bf16*)(ws + WS_WXO); t.kb = r / 64; t.nb = r % 64; return t; } r -= TR_I6;
    if (r < TR_I7) { t.W = P.in[24]; t.K = 2048; t.Nsrc = 2048; t.WT = (bf16*)(ws + WS_WPQ); t.gk = P.in[23]; t.kb = r / 64; t.nb = r % 64; return t; } r -= TR_I7;
    const int wh = r / TR_I8; r %= TR_I8; t.W = P.in[wh ? 13 : 11]; t.K = 2048; t.Nsrc = 128; t.WT = (bf16*)(ws + WS_W1C) + (size_t)wh * 128 * 2048; t.kb = r / 4; t.nb = r % 4; return t;
}
__device__ __forceinline__ void tr_items(const Args& P, LAS float* scr, int lane, int lo, int hi, int w, int nw) {
    const int first = lo + w;
    if (first < hi) {
        f32x4 va[8], vb[8]; TrItem ta = tr_item_of(P, first), tb; tr_load(ta, lane, va);
        for (int it = first; it < hi; it += 2 * nw) {
            const bool hb = it + nw < hi;
            if (hb) { tb = tr_item_of(P, it + nw); tr_load(tb, lane, vb); }
            tr_finish(ta, lane, va, scr);
            if (it + 2 * nw < hi) { ta = tr_item_of(P, it + 2 * nw); tr_load(ta, lane, va); }
            if (hb) tr_finish(tb, lane, vb, scr);
        }
    }
}
__device__ __forceinline__ void p_prologue(const Args& P, LAS char* lds, int gw, int NGW, int gt, int NGT) {
    const int tid = threadIdx.x, lane = tid & 63, wave = tid >> 6;
    LAS float* scr = (LAS float*)lds + wave * 64 * 33;
    unsigned char* ws = P.ws;
    tr_items(P, scr, lane, 0, TR_NIT, gw, NGW);
    for (int m = gw; m < S_ + MEML; m += NGW) {
        if (m < S_) rms_row_to_bf16(P.in[0] + (size_t)m * DM, P.in[3], (bf16*)(ws + WS_XN) + (size_t)m * DM, lane);
        else rms_row_to_bf16(P.in[1] + (size_t)(m - S_) * DM, P.in[19], (bf16*)(ws + WS_MEMN) + (size_t)(m - S_) * DM, lane);
    }
    for (int i = gt; i < S_ * 8; i += NGT) {
        const int t = i >> 3, j = i & 7;
        float iv = 1.0f;
        iv = (j == 1) ? 0.19392274f : iv; iv = (j == 2) ? 0.037606031f : iv; iv = (j == 3) ? 0.0072926646f : iv; iv = (j == 4) ? 0.0014142136f : iv;
        iv = (j == 5) ? 0.00027424819f : iv; iv = (j == 6) ? 5.3182957e-05f : iv; iv = (j == 7) ? 1.0313385e-05f : iv;
        const float ang = (float)((const int*)P.in[2])[t] * iv;
        const double ad = (double)ang; const double k = rint(ad * 0.15915494309189535); const float rr = (float)(ad - k * 6.283185307179586);
        ((float*)(ws + WS_COS))[i] = cosf(rr); ((float*)(ws + WS_SIN))[i] = sinf(rr);
    }
    if (gt == 0) {
        float a = 0.f, b = 0.f;
        for (int i = 0; i < 64; ++i) { a += P.in[5][i] * P.in[6][i]; b += P.in[7][i] * P.in[8][i]; }
        ((float*)(ws + WS_SCAL))[0] = expf(a) - expf(b) + LAMBDA_INIT;
    }
    if (gt < 256) { ((bf16*)(ws + WS_KC))[511 * 256 + gt] = 0; ((bf16*)(ws + WS_VC))[511 * 256 + gt] = 0; }
    if (gw >= 256 && gw < 512) { const int o = gw - 256, wh = o >> 7, hcol = o & 127; const float* w1 = wh ? P.in[13] : P.in[11]; const float* pos = P.in[10]; float s = 0.f;
#pragma unroll 8
        for (int j = 0; j < 32; ++j) { const int i = lane + 64 * j; s += pos[i] * w1[(size_t)i * 128 + hcol]; }
        s = wave_sum(s); if (lane == 0) ((float*)(ws + WS_CPOS))[wh * 128 + hcol] = s; }
}

typedef __bf16 bf16x2v __attribute__((ext_vector_type(2)));
typedef _Float16 h2_t __attribute__((ext_vector_type(2)));
constexpr size_t WS_VQS = 176 * MiB;
__device__ __forceinline__ float ub0(unsigned x) { return (float)(x & 0xffu); }
__device__ __forceinline__ float ub1(unsigned x) { return (float)((x >> 8) & 0xffu); }
__device__ __forceinline__ float ub2(unsigned x) { return (float)((x >> 16) & 0xffu); }
__device__ __forceinline__ float ub3(unsigned x) { return (float)(x >> 24); }
__device__ __forceinline__ float dot2bf(unsigned a, unsigned b, float c) { return __builtin_amdgcn_fdot2_f32_bf16(__builtin_bit_cast(bf16x2v, a), __builtin_bit_cast(bf16x2v, b), c, false); }
__device__ __forceinline__ void top16_of_128(f32x16 (&acc)[4], LAS float* vout, LAS int* iout, int r32, int hi) {
    float e[64];
#pragma unroll
    for (int b = 0; b < 4; ++b)
#pragma unroll
        for (int r = 0; r < 16; ++r) e[16 * b + r] = __uint_as_float((__float_as_uint(acc[b][r]) & 0xffffff80u) | (unsigned)(32 * b + crow(r, hi)));
    { const float a_ = e[0], b_ = e[1]; e[0] = fmaxf(a_, b_); e[1] = fminf(a_, b_); }
    { const float a_ = e[3], b_ = e[2]; e[3] = fmaxf(a_, b_); e[2] = fminf(a_, b_); }
    { const float a_ = e[4], b_ = e[5]; e[4] = fmaxf(a_, b_); e[5] = fminf(a_, b_); }
    { const float a_ = e[7], b_ = e[6]; e[7] = fmaxf(a_, b_); e[6] = fminf(a_, b_); }
    { const float a_ = e[8], b_ = e[9]; e[8] = fmaxf(a_, b_); e[9] = fminf(a_, b_); }
    { const float a_ = e[11], b_ = e[10]; e[11] = fmaxf(a_, b_); e[10] = fminf(a_, b_); }
    { const float a_ = e[12], b_ = e[13]; e[12] = fmaxf(a_, b_); e[13] = fminf(a_, b_); }
    { const float a_ = e[15], b_ = e[14]; e[15] = fmaxf(a_, b_); e[14] = fminf(a_, b_); }
    { const float a_ = e[0], b_ = e[2]; e[0] = fmaxf(a_, b_); e[2] = fminf(a_, b_); }
    { const float a_ = e[1], b_ = e[3]; e[1] = fmaxf(a_, b_); e[3] = fminf(a_, b_); }
    { const float a_ = e[6], b_ = e[4]; e[6] = fmaxf(a_, b_); e[4] = fminf(a_, b_); }
    { const float a_ = e[7], b_ = e[5]; e[7] = fmaxf(a_, b_); e[5] = fminf(a_, b_); }
    { const float a_ = e[8], b_ = e[10]; e[8] = fmaxf(a_, b_); e[10] = fminf(a_, b_); }
    { const float a_ = e[9], b_ = e[11]; e[9] = fmaxf(a_, b_); e[11] = fminf(a_, b_); }
    { const float a_ = e[14], b_ = e[12]; e[14] = fmaxf(a_, b_); e[12] = fminf(a_, b_); }
    { const float a_ = e[15], b_ = e[13]; e[15] = fmaxf(a_, b_); e[13] = fminf(a_, b_); }
    { const float a_ = e[0], b_ = e[1]; e[0] = fmaxf(a_, b_); e[1] = fminf(a_, b_); }
    { const float a_ = e[2], b_ = e[3]; e[2] = fmaxf(a_, b_); e[3] = fminf(a_, b_); }
    { const float a_ = e[5], b_ = e[4]; e[5] = fmaxf(a_, b_); e[4] = fminf(a_, b_); }
    { const float a_ = e[7], b_ = e[6]; e[7] = fmaxf(a_, b_); e[6] = fminf(a_, b_); }
    { const float a_ = e[8], b_ = e[9]; e[8] = fmaxf(a_, b_); e[9] = fminf(a_, b_); }
    { const float a_ = e[10], b_ = e[11]; e[10] = fmaxf(a_, b_); e[11] = fminf(a_, b_); }
    { const float a_ = e[13], b_ = e[12]; e[13] = fmaxf(a_, b_); e[12] = fminf(a_, b_); }
    { const float a_ = e[15], b_ = e[14]; e[15] = fmaxf(a_, b_); e[14] = fminf(a_, b_); }
    { const float a_ = e[0], b_ = e[4]; e[0] = fmaxf(a_, b_); e[4] = fminf(a_, b_); }
    { const float a_ = e[1], b_ = e[5]; e[1] = fmaxf(a_, b_); e[5] = fminf(a_, b_); }
    { const float a_ = e[2], b_ = e[6]; e[2] = fmaxf(a_, b_); e[6] = fminf(a_, b_); }
    { const float a_ = e[3], b_ = e[7]; e[3] = fmaxf(a_, b_); e[7] = fminf(a_, b_); }
    { const float a_ = e[12], b_ = e[8]; e[12] = fmaxf(a_, b_); e[8] = fminf(a_, b_); }
    { const float a_ = e[13], b_ = e[9]; e[13] = fmaxf(a_, b_); e[9] = fminf(a_, b_); }
    { const float a_ = e[14], b_ = e[10]; e[14] = fmaxf(a_, b_); e[10] = fminf(a_, b_); }
    { const float a_ = e[15], b_ = e[11]; e[15] = fmaxf(a_, b_); e[11] = fminf(a_, b_); }
    { const float a_ = e[0], b_ = e[2]; e[0] = fmaxf(a_, b_); e[2] = fminf(a_, b_); }
    { const float a_ = e[1], b_ = e[3]; e[1] = fmaxf(a_, b_); e[3] = fminf(a_, b_); }
    { const float a_ = e[4], b_ = e[6]; e[4] = fmaxf(a_, b_); e[6] = fminf(a_, b_); }
    { const float a_ = e[5], b_ = e[7]; e[5] = fmaxf(a_, b_); e[7] = fminf(a_, b_); }
    { const float a_ = e[10], b_ = e[8]; e[10] = fmaxf(a_, b_); e[8] = fminf(a_, b_); }
    { const float a_ = e[11], b_ = e[9]; e[11] = fmaxf(a_, b_); e[9] = fminf(a_, b_); }
    { const float a_ = e[14], b_ = e[12]; e[14] = fmaxf(a_, b_); e[12] = fminf(a_, b_); }
    { const float a_ = e[15], b_ = e[13]; e[15] = fmaxf(a_, b_); e[13] = fminf(a_, b_); }
    { const float a_ = e[0], b_ = e[1]; e[0] = fmaxf(a_, b_); e[1] = fminf(a_, b_); }
    { const float a_ = e[2], b_ = e[3]; e[2] = fmaxf(a_, b_); e[3] = fminf(a_, b_); }
    { const float a_ = e[4], b_ = e[5]; e[4] = fmaxf(a_, b_); e[5] = fminf(a_, b_); }
    { const float a_ = e[6], b_ = e[7]; e[6] = fmaxf(a_, b_); e[7] = fminf(a_, b_); }
    { const float a_ = e[9], b_ = e[8]; e[9] = fmaxf(a_, b_); e[8] = fminf(a_, b_); }
    { const float a_ = e[11], b_ = e[10]; e[11] = fmaxf(a_, b_); e[10] = fminf(a_, b_); }
    { const float a_ = e[13], b_ = e[12]; e[13] = fmaxf(a_, b_); e[12] = fminf(a_, b_); }
    { const float a_ = e[15], b_ = e[14]; e[15] = fmaxf(a_, b_); e[14] = fminf(a_, b_); }
    { const float a_ = e[0], b_ = e[8]; e[0] = fmaxf(a_, b_); e[8] = fminf(a_, b_); }
    { const float a_ = e[1], b_ = e[9]; e[1] = fmaxf(a_, b_); e[9] = fminf(a_, b_); }
    { const float a_ = e[2], b_ = e[10]; e[2] = fmaxf(a_, b_); e[10] = fminf(a_, b_); }
    { const float a_ = e[3], b_ = e[11]; e[3] = fmaxf(a_, b_); e[11] = fminf(a_, b_); }
    { const float a_ = e[4], b_ = e[12]; e[4] = fmaxf(a_, b_); e[12] = fminf(a_, b_); }
    { const float a_ = e[5], b_ = e[13]; e[5] = fmaxf(a_, b_); e[13] = fminf(a_, b_); }
    { const float a_ = e[6], b_ = e[14]; e[6] = fmaxf(a_, b_); e[14] = fminf(a_, b_); }
    { const float a_ = e[7], b_ = e[15]; e[7] = fmaxf(a_, b_); e[15] = fminf(a_, b_); }
    { const float a_ = e[0], b_ = e[4]; e[0] = fmaxf(a_, b_); e[4] = fminf(a_, b_); }
    { const float a_ = e[1], b_ = e[5]; e[1] = fmaxf(a_, b_); e[5] = fminf(a_, b_); }
    { const float a_ = e[2], b_ = e[6]; e[2] = fmaxf(a_, b_); e[6] = fminf(a_, b_); }
    { const float a_ = e[3], b_ = e[7]; e[3] = fmaxf(a_, b_); e[7] = fminf(a_, b_); }
    { const float a_ = e[8], b_ = e[12]; e[8] = fmaxf(a_, b_); e[12] = fminf(a_, b_); }
    { const float a_ = e[9], b_ = e[13]; e[9] = fmaxf(a_, b_); e[13] = fminf(a_, b_); }
    { const float a_ = e[10], b_ = e[14]; e[10] = fmaxf(a_, b_); e[14] = fminf(a_, b_); }
    { const float a_ = e[11], b_ = e[15]; e[11] = fmaxf(a_, b_); e[15] = fminf(a_, b_); }
    { const float a_ = e[0], b_ = e[2]; e[0] = fmaxf(a_, b_); e[2] = fminf(a_, b_); }
    { const float a_ = e[1], b_ = e[3]; e[1] = fmaxf(a_, b_); e[3] = fminf(a_, b_); }
    { const float a_ = e[4], b_ = e[6]; e[4] = fmaxf(a_, b_); e[6] = fminf(a_, b_); }
    { const float a_ = e[5], b_ = e[7]; e[5] = fmaxf(a_, b_); e[7] = fminf(a_, b_); }
    { const float a_ = e[8], b_ = e[10]; e[8] = fmaxf(a_, b_); e[10] = fminf(a_, b_); }
    { const float a_ = e[9], b_ = e[11]; e[9] = fmaxf(a_, b_); e[11] = fminf(a_, b_); }
    { const float a_ = e[12], b_ = e[14]; e[12] = fmaxf(a_, b_); e[14] = fminf(a_, b_); }
    { const float a_ = e[13], b_ = e[15]; e[13] = fmaxf(a_, b_); e[15] = fminf(a_, b_); }
    { const float a_ = e[0], b_ = e[1]; e[0] = fmaxf(a_, b_); e[1] = fminf(a_, b_); }
    { const float a_ = e[2], b_ = e[3]; e[2] = fmaxf(a_, b_); e[3] = fminf(a_, b_); }
    { const float a_ = e[4], b_ = e[5]; e[4] = fmaxf(a_, b_); e[5] = fminf(a_, b_); }
    { const float a_ = e[6], b_ = e[7]; e[6] = fmaxf(a_, b_); e[7] = fminf(a_, b_); }
    { const float a_ = e[8], b_ = e[9]; e[8] = fmaxf(a_, b_); e[9] = fminf(a_, b_); }
    { const float a_ = e[10], b_ = e[11]; e[10] = fmaxf(a_, b_); e[11] = fminf(a_, b_); }
    { const float a_ = e[12], b_ = e[13]; e[12] = fmaxf(a_, b_); e[13] = fminf(a_, b_); }
    { const float a_ = e[14], b_ = e[15]; e[14] = fmaxf(a_, b_); e[15] = fminf(a_, b_); }
    { const float a_ = e[16], b_ = e[17]; e[16] = fmaxf(a_, b_); e[17] = fminf(a_, b_); }
    { const float a_ = e[19], b_ = e[18]; e[19] = fmaxf(a_, b_); e[18] = fminf(a_, b_); }
    { const float a_ = e[20], b_ = e[21]; e[20] = fmaxf(a_, b_); e[21] = fminf(a_, b_); }
    { const float a_ = e[23], b_ = e[22]; e[23] = fmaxf(a_, b_); e[22] = fminf(a_, b_); }
    { const float a_ = e[24], b_ = e[25]; e[24] = fmaxf(a_, b_); e[25] = fminf(a_, b_); }
    { const float a_ = e[27], b_ = e[26]; e[27] = fmaxf(a_, b_); e[26] = fminf(a_, b_); }
    { const float a_ = e[28], b_ = e[29]; e[28] = fmaxf(a_, b_); e[29] = fminf(a_, b_); }
    { const float a_ = e[31], b_ = e[30]; e[31] = fmaxf(a_, b_); e[30] = fminf(a_, b_); }
    { const float a_ = e[16], b_ = e[18]; e[16] = fmaxf(a_, b_); e[18] = fminf(a_, b_); }
    { const float a_ = e[17], b_ = e[19]; e[17] = fmaxf(a_, b_); e[19] = fminf(a_, b_); }
    { const float a_ = e[22], b_ = e[20]; e[22] = fmaxf(a_, b_); e[20] = fminf(a_, b_); }
    { const float a_ = e[23], b_ = e[21]; e[23] = fmaxf(a_, b_); e[21] = fminf(a_, b_); }
    { const float a_ = e[24], b_ = e[26]; e[24] = fmaxf(a_, b_); e[26] = fminf(a_, b_); }
    { const float a_ = e[25], b_ = e[27]; e[25] = fmaxf(a_, b_); e[27] = fminf(a_, b_); }
    { const float a_ = e[30], b_ = e[28]; e[30] = fmaxf(a_, b_); e[28] = fminf(a_, b_); }
    { const float a_ = e[31], b_ = e[29]; e[31] = fmaxf(a_, b_); e[29] = fminf(a_, b_); }
    { const float a_ = e[16], b_ = e[17]; e[16] = fmaxf(a_, b_); e[17] = fminf(a_, b_); }
    { const float a_ = e[18], b_ = e[19]; e[18] = fmaxf(a_, b_); e[19] = fminf(a_, b_); }
    { const float a_ = e[21], b_ = e[20]; e[21] = fmaxf(a_, b_); e[20] = fminf(a_, b_); }
    { const float a_ = e[23], b_ = e[22]; e[23] = fmaxf(a_, b_); e[22] = fminf(a_, b_); }
    { const float a_ = e[24], b_ = e[25]; e[24] = fmaxf(a_, b_); e[25] = fminf(a_, b_); }
    { const float a_ = e[26], b_ = e[27]; e[26] = fmaxf(a_, b_); e[27] = fminf(a_, b_); }
    { const float a_ = e[29], b_ = e[28]; e[29] = fmaxf(a_, b_); e[28] = fminf(a_, b_); }
    { const float a_ = e[31], b_ = e[30]; e[31] = fmaxf(a_, b_); e[30] = fminf(a_, b_); }
    { const float a_ = e[16], b_ = e[20]; e[16] = fmaxf(a_, b_); e[20] = fminf(a_, b_); }
    { const float a_ = e[17], b_ = e[21]; e[17] = fmaxf(a_, b_); e[21] = fminf(a_, b_); }
    { const float a_ = e[18], b_ = e[22]; e[18] = fmaxf(a_, b_); e[22] = fminf(a_, b_); }
    { const float a_ = e[19], b_ = e[23]; e[19] = fmaxf(a_, b_); e[23] = fminf(a_, b_); }
    { const float a_ = e[28], b_ = e[24]; e[28] = fmaxf(a_, b_); e[24] = fminf(a_, b_); }
    { const float a_ = e[29], b_ = e[25]; e[29] = fmaxf(a_, b_); e[25] = fminf(a_, b_); }
    { const float a_ = e[30], b_ = e[26]; e[30] = fmaxf(a_, b_); e[26] = fminf(a_, b_); }
    { const float a_ = e[31], b_ = e[27]; e[31] = fmaxf(a_, b_); e[27] = fminf(a_, b_); }
    { const float a_ = e[16], b_ = e[18]; e[16] = fmaxf(a_, b_); e[18] = fminf(a_, b_); }
    { const float a_ = e[17], b_ = e[19]; e[17] = fmaxf(a_, b_); e[19] = fminf(a_, b_); }
    { const float a_ = e[20], b_ = e[22]; e[20] = fmaxf(a_, b_); e[22] = fminf(a_, b_); }
    { const float a_ = e[21], b_ = e[23]; e[21] = fmaxf(a_, b_); e[23] = fminf(a_, b_); }
    { const float a_ = e[26], b_ = e[24]; e[26] = fmaxf(a_, b_); e[24] = fminf(a_, b_); }
    { const float a_ = e[27], b_ = e[25]; e[27] = fmaxf(a_, b_); e[25] = fminf(a_, b_); }
    { const float a_ = e[30], b_ = e[28]; e[30] = fmaxf(a_, b_); e[28] = fminf(a_, b_); }
    { const float a_ = e[31], b_ = e[29]; e[31] = fmaxf(a_, b_); e[29] = fminf(a_, b_); }
    { const float a_ = e[16], b_ = e[17]; e[16] = fmaxf(a_, b_); e[17] = fminf(a_, b_); }
    { const float a_ = e[18], b_ = e[19]; e[18] = fmaxf(a_, b_); e[19] = fminf(a_, b_); }
    { const float a_ = e[20], b_ = e[21]; e[20] = fmaxf(a_, b_); e[21] = fminf(a_, b_); }
    { const float a_ = e[22], b_ = e[23]; e[22] = fmaxf(a_, b_); e[23] = fminf(a_, b_); }
    { const float a_ = e[25], b_ = e[24]; e[25] = fmaxf(a_, b_); e[24] = fminf(a_, b_); }
    { const float a_ = e[27], b_ = e[26]; e[27] = fmaxf(a_, b_); e[26] = fminf(a_, b_); }
    { const float a_ = e[29], b_ = e[28]; e[29] = fmaxf(a_, b_); e[28] = fminf(a_, b_); }
    { const float a_ = e[31], b_ = e[30]; e[31] = fmaxf(a_, b_); e[30] = fminf(a_, b_); }
    { const float a_ = e[16], b_ = e[24]; e[16] = fmaxf(a_, b_); e[24] = fminf(a_, b_); }
    { const float a_ = e[17], b_ = e[25]; e[17] = fmaxf(a_, b_); e[25] = fminf(a_, b_); }
    { const float a_ = e[18], b_ = e[26]; e[18] = fmaxf(a_, b_); e[26] = fminf(a_, b_); }
    { const float a_ = e[19], b_ = e[27]; e[19] = fmaxf(a_, b_); e[27] = fminf(a_, b_); }
    { const float a_ = e[20], b_ = e[28]; e[20] = fmaxf(a_, b_); e[28] = fminf(a_, b_); }
    { const float a_ = e[21], b_ = e[29]; e[21] = fmaxf(a_, b_); e[29] = fminf(a_, b_); }
    { const float a_ = e[22], b_ = e[30]; e[22] = fmaxf(a_, b_); e[30] = fminf(a_, b_); }
    { const float a_ = e[23], b_ = e[31]; e[23] = fmaxf(a_, b_); e[31] = fminf(a_, b_); }
    { const float a_ = e[16], b_ = e[20]; e[16] = fmaxf(a_, b_); e[20] = fminf(a_, b_); }
    { const float a_ = e[17], b_ = e[21]; e[17] = fmaxf(a_, b_); e[21] = fminf(a_, b_); }
    { const float a_ = e[18], b_ = e[22]; e[18] = fmaxf(a_, b_); e[22] = fminf(a_, b_); }
    { const float a_ = e[19], b_ = e[23]; e[19] = fmaxf(a_, b_); e[23] = fminf(a_, b_); }
    { const float a_ = e[24], b_ = e[28]; e[24] = fmaxf(a_, b_); e[28] = fminf(a_, b_); }
    { const float a_ = e[25], b_ = e[29]; e[25] = fmaxf(a_, b_); e[29] = fminf(a_, b_); }
    { const float a_ = e[26], b_ = e[30]; e[26] = fmaxf(a_, b_); e[30] = fminf(a_, b_); }
    { const float a_ = e[27], b_ = e[31]; e[27] = fmaxf(a_, b_); e[31] = fminf(a_, b_); }
    { const float a_ = e[16], b_ = e[18]; e[16] = fmaxf(a_, b_); e[18] = fminf(a_, b_); }
    { const float a_ = e[17], b_ = e[19]; e[17] = fmaxf(a_, b_); e[19] = fminf(a_, b_); }
    { const float a_ = e[20], b_ = e[22]; e[20] = fmaxf(a_, b_); e[22] = fminf(a_, b_); }
    { const float a_ = e[21], b_ = e[23]; e[21] = fmaxf(a_, b_); e[23] = fminf(a_, b_); }
    { const float a_ = e[24], b_ = e[26]; e[24] = fmaxf(a_, b_); e[26] = fminf(a_, b_); }
    { const float a_ = e[25], b_ = e[27]; e[25] = fmaxf(a_, b_); e[27] = fminf(a_, b_); }
    { const float a_ = e[28], b_ = e[30]; e[28] = fmaxf(a_, b_); e[30] = fminf(a_, b_); }
    { const float a_ = e[29], b_ = e[31]; e[29] = fmaxf(a_, b_); e[31] = fminf(a_, b_); }
    { const float a_ = e[16], b_ = e[17]; e[16] = fmaxf(a_, b_); e[17] = fminf(a_, b_); }
    { const float a_ = e[18], b_ = e[19]; e[18] = fmaxf(a_, b_); e[19] = fminf(a_, b_); }
    { const float a_ = e[20], b_ = e[21]; e[20] = fmaxf(a_, b_); e[21] = fminf(a_, b_); }
    { const float a_ = e[22], b_ = e[23]; e[22] = fmaxf(a_, b_); e[23] = fminf(a_, b_); }
    { const float a_ = e[24], b_ = e[25]; e[24] = fmaxf(a_, b_); e[25] = fminf(a_, b_); }
    { const float a_ = e[26], b_ = e[27]; e[26] = fmaxf(a_, b_); e[27] = fminf(a_, b_); }
    { const float a_ = e[28], b_ = e[29]; e[28] = fmaxf(a_, b_); e[29] = fminf(a_, b_); }
    { const float a_ = e[30], b_ = e[31]; e[30] = fmaxf(a_, b_); e[31] = fminf(a_, b_); }
    { const float a_ = e[32], b_ = e[33]; e[32] = fmaxf(a_, b_); e[33] = fminf(a_, b_); }
    { const float a_ = e[35], b_ = e[34]; e[35] = fmaxf(a_, b_); e[34] = fminf(a_, b_); }
    { const float a_ = e[36], b_ = e[37]; e[36] = fmaxf(a_, b_); e[37] = fminf(a_, b_); }
    { const float a_ = e[39], b_ = e[38]; e[39] = fmaxf(a_, b_); e[38] = fminf(a_, b_); }
    { const float a_ = e[40], b_ = e[41]; e[40] = fmaxf(a_, b_); e[41] = fminf(a_, b_); }
    { const float a_ = e[43], b_ = e[42]; e[43] = fmaxf(a_, b_); e[42] = fminf(a_, b_); }
    { const float a_ = e[44], b_ = e[45]; e[44] = fmaxf(a_, b_); e[45] = fminf(a_, b_); }
    { const float a_ = e[47], b_ = e[46]; e[47] = fmaxf(a_, b_); e[46] = fminf(a_, b_); }
    { const float a_ = e[32], b_ = e[34]; e[32] = fmaxf(a_, b_); e[34] = fminf(a_, b_); }
    { const float a_ = e[33], b_ = e[35]; e[33] = fmaxf(a_, b_); e[35] = fminf(a_, b_); }
    { const float a_ = e[38], b_ = e[36]; e[38] = fmaxf(a_, b_); e[36] = fminf(a_, b_); }
    { const float a_ = e[39], b_ = e[37]; e[39] = fmaxf(a_, b_); e[37] = fminf(a_, b_); }
    { const float a_ = e[40], b_ = e[42]; e[40] = fmaxf(a_, b_); e[42] = fminf(a_, b_); }
    { const float a_ = e[41], b_ = e[43]; e[41] = fmaxf(a_, b_); e[43] = fminf(a_, b_); }
    { const float a_ = e[46], b_ = e[44]; e[46] = fmaxf(a_, b_); e[44] = fminf(a_, b_); }
    { const float a_ = e[47], b_ = e[45]; e[47] = fmaxf(a_, b_); e[45] = fminf(a_, b_); }
    { const float a_ = e[32], b_ = e[33]; e[32] = fmaxf(a_, b_); e[33] = fminf(a_, b_); }
    { const float a_ = e[34], b_ = e[35]; e[34] = fmaxf(a_, b_); e[35] = fminf(a_, b_); }
    { const float a_ = e[37], b_ = e[36]; e[37] = fmaxf(a_, b_); e[36] = fminf(a_, b_); }
    { const float a_ = e[39], b_ = e[38]; e[39] = fmaxf(a_, b_); e[38] = fminf(a_, b_); }
    { const float a_ = e[40], b_ = e[41]; e[40] = fmaxf(a_, b_); e[41] = fminf(a_, b_); }
    { const float a_ = e[42], b_ = e[43]; e[42] = fmaxf(a_, b_); e[43] = fminf(a_, b_); }
    { const float a_ = e[45], b_ = e[44]; e[45] = fmaxf(a_, b_); e[44] = fminf(a_, b_); }
    { const float a_ = e[47], b_ = e[46]; e[47] = fmaxf(a_, b_); e[46] = fminf(a_, b_); }
    { const float a_ = e[32], b_ = e[36]; e[32] = fmaxf(a_, b_); e[36] = fminf(a_, b_); }
    { const float a_ = e[33], b_ = e[37]; e[33] = fmaxf(a_, b_); e[37] = fminf(a_, b_); }
    { const float a_ = e[34], b_ = e[38]; e[34] = fmaxf(a_, b_); e[38] = fminf(a_, b_); }
    { const float a_ = e[35], b_ = e[39]; e[35] = fmaxf(a_, b_); e[39] = fminf(a_, b_); }
    { const float a_ = e[44], b_ = e[40]; e[44] = fmaxf(a_, b_); e[40] = fminf(a_, b_); }
    { const float a_ = e[45], b_ = e[41]; e[45] = fmaxf(a_, b_); e[41] = fminf(a_, b_); }
    { const float a_ = e[46], b_ = e[42]; e[46] = fmaxf(a_, b_); e[42] = fminf(a_, b_); }
    { const float a_ = e[47], b_ = e[43]; e[47] = fmaxf(a_, b_); e[43] = fminf(a_, b_); }
    { const float a_ = e[32], b_ = e[34]; e[32] = fmaxf(a_, b_); e[34] = fminf(a_, b_); }
    { const float a_ = e[33], b_ = e[35]; e[33] = fmaxf(a_, b_); e[35] = fminf(a_, b_); }
    { const float a_ = e[36], b_ = e[38]; e[36] = fmaxf(a_, b_); e[38] = fminf(a_, b_); }
    { const float a_ = e[37], b_ = e[39]; e[37] = fmaxf(a_, b_); e[39] = fminf(a_, b_); }
    { const float a_ = e[42], b_ = e[40]; e[42] = fmaxf(a_, b_); e[40] = fminf(a_, b_); }
    { const float a_ = e[43], b_ = e[41]; e[43] = fmaxf(a_, b_); e[41] = fminf(a_, b_); }
    { const float a_ = e[46], b_ = e[44]; e[46] = fmaxf(a_, b_); e[44] = fminf(a_, b_); }
    { const float a_ = e[47], b_ = e[45]; e[47] = fmaxf(a_, b_); e[45] = fminf(a_, b_); }
    { const float a_ = e[32], b_ = e[33]; e[32] = fmaxf(a_, b_); e[33] = fminf(a_, b_); }
    { const float a_ = e[34], b_ = e[35]; e[34] = fmaxf(a_, b_); e[35] = fminf(a_, b_); }
    { const float a_ = e[36], b_ = e[37]; e[36] = fmaxf(a_, b_); e[37] = fminf(a_, b_); }
    { const float a_ = e[38], b_ = e[39]; e[38] = fmaxf(a_, b_); e[39] = fminf(a_, b_); }
    { const float a_ = e[41], b_ = e[40]; e[41] = fmaxf(a_, b_); e[40] = fminf(a_, b_); }
    { const float a_ = e[43], b_ = e[42]; e[43] = fmaxf(a_, b_); e[42] = fminf(a_, b_); }
    { const float a_ = e[45], b_ = e[44]; e[45] = fmaxf(a_, b_); e[44] = fminf(a_, b_); }
    { const float a_ = e[47], b_ = e[46]; e[47] = fmaxf(a_, b_); e[46] = fminf(a_, b_); }
    { const float a_ = e[32], b_ = e[40]; e[32] = fmaxf(a_, b_); e[40] = fminf(a_, b_); }
    { const float a_ = e[33], b_ = e[41]; e[33] = fmaxf(a_, b_); e[41] = fminf(a_, b_); }
    { const float a_ = e[34], b_ = e[42]; e[34] = fmaxf(a_, b_); e[42] = fminf(a_, b_); }
    { const float a_ = e[35], b_ = e[43]; e[35] = fmaxf(a_, b_); e[43] = fminf(a_, b_); }
    { const float a_ = e[36], b_ = e[44]; e[36] = fmaxf(a_, b_); e[44] = fminf(a_, b_); }
    { const float a_ = e[37], b_ = e[45]; e[37] = fmaxf(a_, b_); e[45] = fminf(a_, b_); }
    { const float a_ = e[38], b_ = e[46]; e[38] = fmaxf(a_, b_); e[46] = fminf(a_, b_); }
    { const float a_ = e[39], b_ = e[47]; e[39] = fmaxf(a_, b_); e[47] = fminf(a_, b_); }
    { const float a_ = e[32], b_ = e[36]; e[32] = fmaxf(a_, b_); e[36] = fminf(a_, b_); }
    { const float a_ = e[33], b_ = e[37]; e[33] = fmaxf(a_, b_); e[37] = fminf(a_, b_); }
    { const float a_ = e[34], b_ = e[38]; e[34] = fmaxf(a_, b_); e[38] = fminf(a_, b_); }
    { const float a_ = e[35], b_ = e[39]; e[35] = fmaxf(a_, b_); e[39] = fminf(a_, b_); }
    { const float a_ = e[40], b_ = e[44]; e[40] = fmaxf(a_, b_); e[44] = fminf(a_, b_); }
    { const float a_ = e[41], b_ = e[45]; e[41] = fmaxf(a_, b_); e[45] = fminf(a_, b_); }
    { const float a_ = e[42], b_ = e[46]; e[42] = fmaxf(a_, b_); e[46] = fminf(a_, b_); }
    { const float a_ = e[43], b_ = e[47]; e[43] = fmaxf(a_, b_); e[47] = fminf(a_, b_); }
    { const float a_ = e[32], b_ = e[34]; e[32] = fmaxf(a_, b_); e[34] = fminf(a_, b_); }
    { const float a_ = e[33], b_ = e[35]; e[33] = fmaxf(a_, b_); e[35] = fminf(a_, b_); }
    { const float a_ = e[36], b_ = e[38]; e[36] = fmaxf(a_, b_); e[38] = fminf(a_, b_); }
    { const float a_ = e[37], b_ = e[39]; e[37] = fmaxf(a_, b_); e[39] = fminf(a_, b_); }
    { const float a_ = e[40], b_ = e[42]; e[40] = fmaxf(a_, b_); e[42] = fminf(a_, b_); }
    { const float a_ = e[41], b_ = e[43]; e[41] = fmaxf(a_, b_); e[43] = fminf(a_, b_); }
    { const float a_ = e[44], b_ = e[46]; e[44] = fmaxf(a_, b_); e[46] = fminf(a_, b_); }
    { const float a_ = e[45], b_ = e[47]; e[45] = fmaxf(a_, b_); e[47] = fminf(a_, b_); }
    { const float a_ = e[32], b_ = e[33]; e[32] = fmaxf(a_, b_); e[33] = fminf(a_, b_); }
    { const float a_ = e[34], b_ = e[35]; e[34] = fmaxf(a_, b_); e[35] = fminf(a_, b_); }
    { const float a_ = e[36], b_ = e[37]; e[36] = fmaxf(a_, b_); e[37] = fminf(a_, b_); }
    { const float a_ = e[38], b_ = e[39]; e[38] = fmaxf(a_, b_); e[39] = fminf(a_, b_); }
    { const float a_ = e[40], b_ = e[41]; e[40] = fmaxf(a_, b_); e[41] = fminf(a_, b_); }
    { const float a_ = e[42], b_ = e[43]; e[42] = fmaxf(a_, b_); e[43] = fminf(a_, b_); }
    { const float a_ = e[44], b_ = e[45]; e[44] = fmaxf(a_, b_); e[45] = fminf(a_, b_); }
    { const float a_ = e[46], b_ = e[47]; e[46] = fmaxf(a_, b_); e[47] = fminf(a_, b_); }
    { const float a_ = e[48], b_ = e[49]; e[48] = fmaxf(a_, b_); e[49] = fminf(a_, b_); }
    { const float a_ = e[51], b_ = e[50]; e[51] = fmaxf(a_, b_); e[50] = fminf(a_, b_); }
    { const float a_ = e[52], b_ = e[53]; e[52] = fmaxf(a_, b_); e[53] = fminf(a_, b_); }
    { const float a_ = e[55], b_ = e[54]; e[55] = fmaxf(a_, b_); e[54] = fminf(a_, b_); }
    { const float a_ = e[56], b_ = e[57]; e[56] = fmaxf(a_, b_); e[57] = fminf(a_, b_); }
    { const float a_ = e[59], b_ = e[58]; e[59] = fmaxf(a_, b_); e[58] = fminf(a_, b_); }
    { const float a_ = e[60], b_ = e[61]; e[60] = fmaxf(a_, b_); e[61] = fminf(a_, b_); }
    { const float a_ = e[63], b_ = e[62]; e[63] = fmaxf(a_, b_); e[62] = fminf(a_, b_); }
    { const float a_ = e[48], b_ = e[50]; e[48] = fmaxf(a_, b_); e[50] = fminf(a_, b_); }
    { const float a_ = e[49], b_ = e[51]; e[49] = fmaxf(a_, b_); e[51] = fminf(a_, b_); }
    { const float a_ = e[54], b_ = e[52]; e[54] = fmaxf(a_, b_); e[52] = fminf(a_, b_); }
    { const float a_ = e[55], b_ = e[53]; e[55] = fmaxf(a_, b_); e[53] = fminf(a_, b_); }
    { const float a_ = e[56], b_ = e[58]; e[56] = fmaxf(a_, b_); e[58] = fminf(a_, b_); }
    { const float a_ = e[57], b_ = e[59]; e[57] = fmaxf(a_, b_); e[59] = fminf(a_, b_); }
    { const float a_ = e[62], b_ = e[60]; e[62] = fmaxf(a_, b_); e[60] = fminf(a_, b_); }
    { const float a_ = e[63], b_ = e[61]; e[63] = fmaxf(a_, b_); e[61] = fminf(a_, b_); }
    { const float a_ = e[48], b_ = e[49]; e[48] = fmaxf(a_, b_); e[49] = fminf(a_, b_); }
    { const float a_ = e[50], b_ = e[51]; e[50] = fmaxf(a_, b_); e[51] = fminf(a_, b_); }
    { const float a_ = e[53], b_ = e[52]; e[53] = fmaxf(a_, b_); e[52] = fminf(a_, b_); }
    { const float a_ = e[55], b_ = e[54]; e[55] = fmaxf(a_, b_); e[54] = fminf(a_, b_); }
    { const float a_ = e[56], b_ = e[57]; e[56] = fmaxf(a_, b_); e[57] = fminf(a_, b_); }
    { const float a_ = e[58], b_ = e[59]; e[58] = fmaxf(a_, b_); e[59] = fminf(a_, b_); }
    { const float a_ = e[61], b_ = e[60]; e[61] = fmaxf(a_, b_); e[60] = fminf(a_, b_); }
    { const float a_ = e[63], b_ = e[62]; e[63] = fmaxf(a_, b_); e[62] = fminf(a_, b_); }
    { const float a_ = e[48], b_ = e[52]; e[48] = fmaxf(a_, b_); e[52] = fminf(a_, b_); }
    { const float a_ = e[49], b_ = e[53]; e[49] = fmaxf(a_, b_); e[53] = fminf(a_, b_); }
    { const float a_ = e[50], b_ = e[54]; e[50] = fmaxf(a_, b_); e[54] = fminf(a_, b_); }
    { const float a_ = e[51], b_ = e[55]; e[51] = fmaxf(a_, b_); e[55] = fminf(a_, b_); }
    { const float a_ = e[60], b_ = e[56]; e[60] = fmaxf(a_, b_); e[56] = fminf(a_, b_); }
    { const float a_ = e[61], b_ = e[57]; e[61] = fmaxf(a_, b_); e[57] = fminf(a_, b_); }
    { const float a_ = e[62], b_ = e[58]; e[62] = fmaxf(a_, b_); e[58] = fminf(a_, b_); }
    { const float a_ = e[63], b_ = e[59]; e[63] = fmaxf(a_, b_); e[59] = fminf(a_, b_); }
    { const float a_ = e[48], b_ = e[50]; e[48] = fmaxf(a_, b_); e[50] = fminf(a_, b_); }
    { const float a_ = e[49], b_ = e[51]; e[49] = fmaxf(a_, b_); e[51] = fminf(a_, b_); }
    { const float a_ = e[52], b_ = e[54]; e[52] = fmaxf(a_, b_); e[54] = fminf(a_, b_); }
    { const float a_ = e[53], b_ = e[55]; e[53] = fmaxf(a_, b_); e[55] = fminf(a_, b_); }
    { const float a_ = e[58], b_ = e[56]; e[58] = fmaxf(a_, b_); e[56] = fminf(a_, b_); }
    { const float a_ = e[59], b_ = e[57]; e[59] = fmaxf(a_, b_); e[57] = fminf(a_, b_); }
    { const float a_ = e[62], b_ = e[60]; e[62] = fmaxf(a_, b_); e[60] = fminf(a_, b_); }
    { const float a_ = e[63], b_ = e[61]; e[63] = fmaxf(a_, b_); e[61] = fminf(a_, b_); }
    { const float a_ = e[48], b_ = e[49]; e[48] = fmaxf(a_, b_); e[49] = fminf(a_, b_); }
    { const float a_ = e[50], b_ = e[51]; e[50] = fmaxf(a_, b_); e[51] = fminf(a_, b_); }
    { const float a_ = e[52], b_ = e[53]; e[52] = fmaxf(a_, b_); e[53] = fminf(a_, b_); }
    { const float a_ = e[54], b_ = e[55]; e[54] = fmaxf(a_, b_); e[55] = fminf(a_, b_); }
    { const float a_ = e[57], b_ = e[56]; e[57] = fmaxf(a_, b_); e[56] = fminf(a_, b_); }
    { const float a_ = e[59], b_ = e[58]; e[59] = fmaxf(a_, b_); e[58] = fminf(a_, b_); }
    { const float a_ = e[61], b_ = e[60]; e[61] = fmaxf(a_, b_); e[60] = fminf(a_, b_); }
    { const float a_ = e[63], b_ = e[62]; e[63] = fmaxf(a_, b_); e[62] = fminf(a_, b_); }
    { const float a_ = e[48], b_ = e[56]; e[48] = fmaxf(a_, b_); e[56] = fminf(a_, b_); }
    { const float a_ = e[49], b_ = e[57]; e[49] = fmaxf(a_, b_); e[57] = fminf(a_, b_); }
    { const float a_ = e[50], b_ = e[58]; e[50] = fmaxf(a_, b_); e[58] = fminf(a_, b_); }
    { const float a_ = e[51], b_ = e[59]; e[51] = fmaxf(a_, b_); e[59] = fminf(a_, b_); }
    { const float a_ = e[52], b_ = e[60]; e[52] = fmaxf(a_, b_); e[60] = fminf(a_, b_); }
    { const float a_ = e[53], b_ = e[61]; e[53] = fmaxf(a_, b_); e[61] = fminf(a_, b_); }
    { const float a_ = e[54], b_ = e[62]; e[54] = fmaxf(a_, b_); e[62] = fminf(a_, b_); }
    { const float a_ = e[55], b_ = e[63]; e[55] = fmaxf(a_, b_); e[63] = fminf(a_, b_); }
    { const float a_ = e[48], b_ = e[52]; e[48] = fmaxf(a_, b_); e[52] = fminf(a_, b_); }
    { const float a_ = e[49], b_ = e[53]; e[49] = fmaxf(a_, b_); e[53] = fminf(a_, b_); }
    { const float a_ = e[50], b_ = e[54]; e[50] = fmaxf(a_, b_); e[54] = fminf(a_, b_); }
    { const float a_ = e[51], b_ = e[55]; e[51] = fmaxf(a_, b_); e[55] = fminf(a_, b_); }
    { const float a_ = e[56], b_ = e[60]; e[56] = fmaxf(a_, b_); e[60] = fminf(a_, b_); }
    { const float a_ = e[57], b_ = e[61]; e[57] = fmaxf(a_, b_); e[61] = fminf(a_, b_); }
    { const float a_ = e[58], b_ = e[62]; e[58] = fmaxf(a_, b_); e[62] = fminf(a_, b_); }
    { const float a_ = e[59], b_ = e[63]; e[59] = fmaxf(a_, b_); e[63] = fminf(a_, b_); }
    { const float a_ = e[48], b_ = e[50]; e[48] = fmaxf(a_, b_); e[50] = fminf(a_, b_); }
    { const float a_ = e[49], b_ = e[51]; e[49] = fmaxf(a_, b_); e[51] = fminf(a_, b_); }
    { const float a_ = e[52], b_ = e[54]; e[52] = fmaxf(a_, b_); e[54] = fminf(a_, b_); }
    { const float a_ = e[53], b_ = e[55]; e[53] = fmaxf(a_, b_); e[55] = fminf(a_, b_); }
    { const float a_ = e[56], b_ = e[58]; e[56] = fmaxf(a_, b_); e[58] = fminf(a_, b_); }
    { const float a_ = e[57], b_ = e[59]; e[57] = fmaxf(a_, b_); e[59] = fminf(a_, b_); }
    { const float a_ = e[60], b_ = e[62]; e[60] = fmaxf(a_, b_); e[62] = fminf(a_, b_); }
    { const float a_ = e[61], b_ = e[63]; e[61] = fmaxf(a_, b_); e[63] = fminf(a_, b_); }
    { const float a_ = e[48], b_ = e[49]; e[48] = fmaxf(a_, b_); e[49] = fminf(a_, b_); }
    { const float a_ = e[50], b_ = e[51]; e[50] = fmaxf(a_, b_); e[51] = fminf(a_, b_); }
    { const float a_ = e[52], b_ = e[53]; e[52] = fmaxf(a_, b_); e[53] = fminf(a_, b_); }
    { const float a_ = e[54], b_ = e[55]; e[54] = fmaxf(a_, b_); e[55] = fminf(a_, b_); }
    { const float a_ = e[56], b_ = e[57]; e[56] = fmaxf(a_, b_); e[57] = fminf(a_, b_); }
    { const float a_ = e[58], b_ = e[59]; e[58] = fmaxf(a_, b_); e[59] = fminf(a_, b_); }
    { const float a_ = e[60], b_ = e[61]; e[60] = fmaxf(a_, b_); e[61] = fminf(a_, b_); }
    { const float a_ = e[62], b_ = e[63]; e[62] = fmaxf(a_, b_); e[63] = fminf(a_, b_); }
    float t0[16], t1[16];
    t0[0] = fmaxf(e[0], e[31]); t1[0] = fmaxf(e[32], e[63]);
    t0[1] = fmaxf(e[1], e[30]); t1[1] = fmaxf(e[33], e[62]);
    t0[2] = fmaxf(e[2], e[29]); t1[2] = fmaxf(e[34], e[61]);
    t0[3] = fmaxf(e[3], e[28]); t1[3] = fmaxf(e[35], e[60]);
    t0[4] = fmaxf(e[4], e[27]); t1[4] = fmaxf(e[36], e[59]);
    t0[5] = fmaxf(e[5], e[26]); t1[5] = fmaxf(e[37], e[58]);
    t0[6] = fmaxf(e[6], e[25]); t1[6] = fmaxf(e[38], e[57]);
    t0[7] = fmaxf(e[7], e[24]); t1[7] = fmaxf(e[39], e[56]);
    t0[8] = fmaxf(e[8], e[23]); t1[8] = fmaxf(e[40], e[55]);
    t0[9] = fmaxf(e[9], e[22]); t1[9] = fmaxf(e[41], e[54]);
    t0[10] = fmaxf(e[10], e[21]); t1[10] = fmaxf(e[42], e[53]);
    t0[11] = fmaxf(e[11], e[20]); t1[11] = fmaxf(e[43], e[52]);
    t0[12] = fmaxf(e[12], e[19]); t1[12] = fmaxf(e[44], e[51]);
    t0[13] = fmaxf(e[13], e[18]); t1[13] = fmaxf(e[45], e[50]);
    t0[14] = fmaxf(e[14], e[17]); t1[14] = fmaxf(e[46], e[49]);
    t0[15] = fmaxf(e[15], e[16]); t1[15] = fmaxf(e[47], e[48]);
    { const float a_ = t0[0], b_ = t0[8]; t0[0] = fmaxf(a_, b_); t0[8] = fminf(a_, b_); }
    { const float a_ = t0[1], b_ = t0[9]; t0[1] = fmaxf(a_, b_); t0[9] = fminf(a_, b_); }
    { const float a_ = t0[2], b_ = t0[10]; t0[2] = fmaxf(a_, b_); t0[10] = fminf(a_, b_); }
    { const float a_ = t0[3], b_ = t0[11]; t0[3] = fmaxf(a_, b_); t0[11] = fminf(a_, b_); }
    { const float a_ = t0[4], b_ = t0[12]; t0[4] = fmaxf(a_, b_); t0[12] = fminf(a_, b_); }
    { const float a_ = t0[5], b_ = t0[13]; t0[5] = fmaxf(a_, b_); t0[13] = fminf(a_, b_); }
    { const float a_ = t0[6], b_ = t0[14]; t0[6] = fmaxf(a_, b_); t0[14] = fminf(a_, b_); }
    { const float a_ = t0[7], b_ = t0[15]; t0[7] = fmaxf(a_, b_); t0[15] = fminf(a_, b_); }
    { const float a_ = t0[0], b_ = t0[4]; t0[0] = fmaxf(a_, b_); t0[4] = fminf(a_, b_); }
    { const float a_ = t0[1], b_ = t0[5]; t0[1] = fmaxf(a_, b_); t0[5] = fminf(a_, b_); }
    { const float a_ = t0[2], b_ = t0[6]; t0[2] = fmaxf(a_, b_); t0[6] = fminf(a_, b_); }
    { const float a_ = t0[3], b_ = t0[7]; t0[3] = fmaxf(a_, b_); t0[7] = fminf(a_, b_); }
    { const float a_ = t0[8], b_ = t0[12]; t0[8] = fmaxf(a_, b_); t0[12] = fminf(a_, b_); }
    { const float a_ = t0[9], b_ = t0[13]; t0[9] = fmaxf(a_, b_); t0[13] = fminf(a_, b_); }
    { const float a_ = t0[10], b_ = t0[14]; t0[10] = fmaxf(a_, b_); t0[14] = fminf(a_, b_); }
    { const float a_ = t0[11], b_ = t0[15]; t0[11] = fmaxf(a_, b_); t0[15] = fminf(a_, b_); }
    { const float a_ = t0[0], b_ = t0[2]; t0[0] = fmaxf(a_, b_); t0[2] = fminf(a_, b_); }
    { const float a_ = t0[1], b_ = t0[3]; t0[1] = fmaxf(a_, b_); t0[3] = fminf(a_, b_); }
    { const float a_ = t0[4], b_ = t0[6]; t0[4] = fmaxf(a_, b_); t0[6] = fminf(a_, b_); }
    { const float a_ = t0[5], b_ = t0[7]; t0[5] = fmaxf(a_, b_); t0[7] = fminf(a_, b_); }
    { const float a_ = t0[8], b_ = t0[10]; t0[8] = fmaxf(a_, b_); t0[10] = fminf(a_, b_); }
    { const float a_ = t0[9], b_ = t0[11]; t0[9] = fmaxf(a_, b_); t0[11] = fminf(a_, b_); }
    { const float a_ = t0[12], b_ = t0[14]; t0[12] = fmaxf(a_, b_); t0[14] = fminf(a_, b_); }
    { const float a_ = t0[13], b_ = t0[15]; t0[13] = fmaxf(a_, b_); t0[15] = fminf(a_, b_); }
    { const float a_ = t0[0], b_ = t0[1]; t0[0] = fmaxf(a_, b_); t0[1] = fminf(a_, b_); }
    { const float a_ = t0[2], b_ = t0[3]; t0[2] = fmaxf(a_, b_); t0[3] = fminf(a_, b_); }
    { const float a_ = t0[4], b_ = t0[5]; t0[4] = fmaxf(a_, b_); t0[5] = fminf(a_, b_); }
    { const float a_ = t0[6], b_ = t0[7]; t0[6] = fmaxf(a_, b_); t0[7] = fminf(a_, b_); }
    { const float a_ = t0[8], b_ = t0[9]; t0[8] = fmaxf(a_, b_); t0[9] = fminf(a_, b_); }
    { const float a_ = t0[10], b_ = t0[11]; t0[10] = fmaxf(a_, b_); t0[11] = fminf(a_, b_); }
    { const float a_ = t0[12], b_ = t0[13]; t0[12] = fmaxf(a_, b_); t0[13] = fminf(a_, b_); }
    { const float a_ = t0[14], b_ = t0[15]; t0[14] = fmaxf(a_, b_); t0[15] = fminf(a_, b_); }
    { const float a_ = t1[0], b_ = t1[8]; t1[0] = fmaxf(a_, b_); t1[8] = fminf(a_, b_); }
    { const float a_ = t1[1], b_ = t1[9]; t1[1] = fmaxf(a_, b_); t1[9] = fminf(a_, b_); }
    { const float a_ = t1[2], b_ = t1[10]; t1[2] = fmaxf(a_, b_); t1[10] = fminf(a_, b_); }
    { const float a_ = t1[3], b_ = t1[11]; t1[3] = fmaxf(a_, b_); t1[11] = fminf(a_, b_); }
    { const float a_ = t1[4], b_ = t1[12]; t1[4] = fmaxf(a_, b_); t1[12] = fminf(a_, b_); }
    { const float a_ = t1[5], b_ = t1[13]; t1[5] = fmaxf(a_, b_); t1[13] = fminf(a_, b_); }
    { const float a_ = t1[6], b_ = t1[14]; t1[6] = fmaxf(a_, b_); t1[14] = fminf(a_, b_); }
    { const float a_ = t1[7], b_ = t1[15]; t1[7] = fmaxf(a_, b_); t1[15] = fminf(a_, b_); }
    { const float a_ = t1[0], b_ = t1[4]; t1[0] = fmaxf(a_, b_); t1[4] = fminf(a_, b_); }
    { const float a_ = t1[1], b_ = t1[5]; t1[1] = fmaxf(a_, b_); t1[5] = fminf(a_, b_); }
    { const float a_ = t1[2], b_ = t1[6]; t1[2] = fmaxf(a_, b_); t1[6] = fminf(a_, b_); }
    { const float a_ = t1[3], b_ = t1[7]; t1[3] = fmaxf(a_, b_); t1[7] = fminf(a_, b_); }
    { const float a_ = t1[8], b_ = t1[12]; t1[8] = fmaxf(a_, b_); t1[12] = fminf(a_, b_); }
    { const float a_ = t1[9], b_ = t1[13]; t1[9] = fmaxf(a_, b_); t1[13] = fminf(a_, b_); }
    { const float a_ = t1[10], b_ = t1[14]; t1[10] = fmaxf(a_, b_); t1[14] = fminf(a_, b_); }
    { const float a_ = t1[11], b_ = t1[15]; t1[11] = fmaxf(a_, b_); t1[15] = fminf(a_, b_); }
    { const float a_ = t1[0], b_ = t1[2]; t1[0] = fmaxf(a_, b_); t1[2] = fminf(a_, b_); }
    { const float a_ = t1[1], b_ = t1[3]; t1[1] = fmaxf(a_, b_); t1[3] = fminf(a_, b_); }
    { const float a_ = t1[4], b_ = t1[6]; t1[4] = fmaxf(a_, b_); t1[6] = fminf(a_, b_); }
    { const float a_ = t1[5], b_ = t1[7]; t1[5] = fmaxf(a_, b_); t1[7] = fminf(a_, b_); }
    { const float a_ = t1[8], b_ = t1[10]; t1[8] = fmaxf(a_, b_); t1[10] = fminf(a_, b_); }
    { const float a_ = t1[9], b_ = t1[11]; t1[9] = fmaxf(a_, b_); t1[11] = fminf(a_, b_); }
    { const float a_ = t1[12], b_ = t1[14]; t1[12] = fmaxf(a_, b_); t1[14] = fminf(a_, b_); }
    { const float a_ = t1[13], b_ = t1[15]; t1[13] = fmaxf(a_, b_); t1[15] = fminf(a_, b_); }
    { const float a_ = t1[0], b_ = t1[1]; t1[0] = fmaxf(a_, b_); t1[1] = fminf(a_, b_); }
    { const float a_ = t1[2], b_ = t1[3]; t1[2] = fmaxf(a_, b_); t1[3] = fminf(a_, b_); }
    { const float a_ = t1[4], b_ = t1[5]; t1[4] = fmaxf(a_, b_); t1[5] = fminf(a_, b_); }
    { const float a_ = t1[6], b_ = t1[7]; t1[6] = fmaxf(a_, b_); t1[7] = fminf(a_, b_); }
    { const float a_ = t1[8], b_ = t1[9]; t1[8] = fmaxf(a_, b_); t1[9] = fminf(a_, b_); }
    { const float a_ = t1[10], b_ = t1[11]; t1[10] = fmaxf(a_, b_); t1[11] = fminf(a_, b_); }
    { const float a_ = t1[12], b_ = t1[13]; t1[12] = fmaxf(a_, b_); t1[13] = fminf(a_, b_); }
    { const float a_ = t1[14], b_ = t1[15]; t1[14] = fmaxf(a_, b_); t1[15] = fminf(a_, b_); }
    float u[16];
    u[0] = fmaxf(t0[0], t1[15]);
    u[1] = fmaxf(t0[1], t1[14]);
    u[2] = fmaxf(t0[2], t1[13]);
    u[3] = fmaxf(t0[3], t1[12]);
    u[4] = fmaxf(t0[4], t1[11]);
    u[5] = fmaxf(t0[5], t1[10]);
    u[6] = fmaxf(t0[6], t1[9]);
    u[7] = fmaxf(t0[7], t1[8]);
    u[8] = fmaxf(t0[8], t1[7]);
    u[9] = fmaxf(t0[9], t1[6]);
    u[10] = fmaxf(t0[10], t1[5]);
    u[11] = fmaxf(t0[11], t1[4]);
    u[12] = fmaxf(t0[12], t1[3]);
    u[13] = fmaxf(t0[13], t1[2]);
    u[14] = fmaxf(t0[14], t1[1]);
    u[15] = fmaxf(t0[15], t1[0]);
    { const float a_ = u[0], b_ = u[8]; u[0] = fmaxf(a_, b_); u[8] = fminf(a_, b_); }
    { const float a_ = u[1], b_ = u[9]; u[1] = fmaxf(a_, b_); u[9] = fminf(a_, b_); }
    { const float a_ = u[2], b_ = u[10]; u[2] = fmaxf(a_, b_); u[10] = fminf(a_, b_); }
    { const float a_ = u[3], b_ = u[11]; u[3] = fmaxf(a_, b_); u[11] = fminf(a_, b_); }
    { const float a_ = u[4], b_ = u[12]; u[4] = fmaxf(a_, b_); u[12] = fminf(a_, b_); }
    { const float a_ = u[5], b_ = u[13]; u[5] = fmaxf(a_, b_); u[13] = fminf(a_, b_); }
    { const float a_ = u[6], b_ = u[14]; u[6] = fmaxf(a_, b_); u[14] = fminf(a_, b_); }
    { const float a_ = u[7], b_ = u[15]; u[7] = fmaxf(a_, b_); u[15] = fminf(a_, b_); }
    { const float a_ = u[0], b_ = u[4]; u[0] = fmaxf(a_, b_); u[4] = fminf(a_, b_); }
    { const float a_ = u[1], b_ = u[5]; u[1] = fmaxf(a_, b_); u[5] = fminf(a_, b_); }
    { const float a_ = u[2], b_ = u[6]; u[2] = fmaxf(a_, b_); u[6] = fminf(a_, b_); }
    { const float a_ = u[3], b_ = u[7]; u[3] = fmaxf(a_, b_); u[7] = fminf(a_, b_); }
    { const float a_ = u[8], b_ = u[12]; u[8] = fmaxf(a_, b_); u[12] = fminf(a_, b_); }
    { const float a_ = u[9], b_ = u[13]; u[9] = fmaxf(a_, b_); u[13] = fminf(a_, b_); }
    { const float a_ = u[10], b_ = u[14]; u[10] = fmaxf(a_, b_); u[14] = fminf(a_, b_); }
    { const float a_ = u[11], b_ = u[15]; u[11] = fmaxf(a_, b_); u[15] = fminf(a_, b_); }
    { const float a_ = u[0], b_ = u[2]; u[0] = fmaxf(a_, b_); u[2] = fminf(a_, b_); }
    { const float a_ = u[1], b_ = u[3]; u[1] = fmaxf(a_, b_); u[3] = fminf(a_, b_); }
    { const float a_ = u[4], b_ = u[6]; u[4] = fmaxf(a_, b_); u[6] = fminf(a_, b_); }
    { const float a_ = u[5], b_ = u[7]; u[5] = fmaxf(a_, b_); u[7] = fminf(a_, b_); }
    { const float a_ = u[8], b_ = u[10]; u[8] = fmaxf(a_, b_); u[10] = fminf(a_, b_); }
    { const float a_ = u[9], b_ = u[11]; u[9] = fmaxf(a_, b_); u[11] = fminf(a_, b_); }
    { const float a_ = u[12], b_ = u[14]; u[12] = fmaxf(a_, b_); u[14] = fminf(a_, b_); }
    { const float a_ = u[13], b_ = u[15]; u[13] = fmaxf(a_, b_); u[15] = fminf(a_, b_); }
    { const float a_ = u[0], b_ = u[1]; u[0] = fmaxf(a_, b_); u[1] = fminf(a_, b_); }
    { const float a_ = u[2], b_ = u[3]; u[2] = fmaxf(a_, b_); u[3] = fminf(a_, b_); }
    { const float a_ = u[4], b_ = u[5]; u[4] = fmaxf(a_, b_); u[5] = fminf(a_, b_); }
    { const float a_ = u[6], b_ = u[7]; u[6] = fmaxf(a_, b_); u[7] = fminf(a_, b_); }
    { const float a_ = u[8], b_ = u[9]; u[8] = fmaxf(a_, b_); u[9] = fminf(a_, b_); }
    { const float a_ = u[10], b_ = u[11]; u[10] = fmaxf(a_, b_); u[11] = fminf(a_, b_); }
    { const float a_ = u[12], b_ = u[13]; u[12] = fmaxf(a_, b_); u[13] = fminf(a_, b_); }
    { const float a_ = u[14], b_ = u[15]; u[14] = fmaxf(a_, b_); u[15] = fminf(a_, b_); }
    float w[16];
    { auto r_ = __builtin_amdgcn_permlane32_swap(__float_as_uint(u[15]), __float_as_uint(u[15]), false, false); w[0] = fmaxf(u[0], __uint_as_float(hi ? r_[0] : r_[1])); }
    { auto r_ = __builtin_amdgcn_permlane32_swap(__float_as_uint(u[14]), __float_as_uint(u[14]), false, false); w[1] = fmaxf(u[1], __uint_as_float(hi ? r_[0] : r_[1])); }
    { auto r_ = __builtin_amdgcn_permlane32_swap(__float_as_uint(u[13]), __float_as_uint(u[13]), false, false); w[2] = fmaxf(u[2], __uint_as_float(hi ? r_[0] : r_[1])); }
    { auto r_ = __builtin_amdgcn_permlane32_swap(__float_as_uint(u[12]), __float_as_uint(u[12]), false, false); w[3] = fmaxf(u[3], __uint_as_float(hi ? r_[0] : r_[1])); }
    { auto r_ = __builtin_amdgcn_permlane32_swap(__float_as_uint(u[11]), __float_as_uint(u[11]), false, false); w[4] = fmaxf(u[4], __uint_as_float(hi ? r_[0] : r_[1])); }
    { auto r_ = __builtin_amdgcn_permlane32_swap(__float_as_uint(u[10]), __float_as_uint(u[10]), false, false); w[5] = fmaxf(u[5], __uint_as_float(hi ? r_[0] : r_[1])); }
    { auto r_ = __builtin_amdgcn_permlane32_swap(__float_as_uint(u[9]), __float_as_uint(u[9]), false, false); w[6] = fmaxf(u[6], __uint_as_float(hi ? r_[0] : r_[1])); }
    { auto r_ = __builtin_amdgcn_permlane32_swap(__float_as_uint(u[8]), __float_as_uint(u[8]), false, false); w[7] = fmaxf(u[7], __uint_as_float(hi ? r_[0] : r_[1])); }
    { auto r_ = __builtin_amdgcn_permlane32_swap(__float_as_uint(u[7]), __float_as_uint(u[7]), false, false); w[8] = fmaxf(u[8], __uint_as_float(hi ? r_[0] : r_[1])); }
    { auto r_ = __builtin_amdgcn_permlane32_swap(__float_as_uint(u[6]), __float_as_uint(u[6]), false, false); w[9] = fmaxf(u[9], __uint_as_float(hi ? r_[0] : r_[1])); }
    { auto r_ = __builtin_amdgcn_permlane32_swap(__float_as_uint(u[5]), __float_as_uint(u[5]), false, false); w[10] = fmaxf(u[10], __uint_as_float(hi ? r_[0] : r_[1])); }
    { auto r_ = __builtin_amdgcn_permlane32_swap(__float_as_uint(u[4]), __float_as_uint(u[4]), false, false); w[11] = fmaxf(u[11], __uint_as_float(hi ? r_[0] : r_[1])); }
    { auto r_ = __builtin_amdgcn_permlane32_swap(__float_as_uint(u[3]), __float_as_uint(u[3]), false, false); w[12] = fmaxf(u[12], __uint_as_float(hi ? r_[0] : r_[1])); }
    { auto r_ = __builtin_amdgcn_permlane32_swap(__float_as_uint(u[2]), __float_as_uint(u[2]), false, false); w[13] = fmaxf(u[13], __uint_as_float(hi ? r_[0] : r_[1])); }
    { auto r_ = __builtin_amdgcn_permlane32_swap(__float_as_uint(u[1]), __float_as_uint(u[1]), false, false); w[14] = fmaxf(u[14], __uint_as_float(hi ? r_[0] : r_[1])); }
    { auto r_ = __builtin_amdgcn_permlane32_swap(__float_as_uint(u[0]), __float_as_uint(u[0]), false, false); w[15] = fmaxf(u[15], __uint_as_float(hi ? r_[0] : r_[1])); }
    { const float a_ = w[0], b_ = w[8]; w[0] = fmaxf(a_, b_); w[8] = fminf(a_, b_); }
    { const float a_ = w[1], b_ = w[9]; w[1] = fmaxf(a_, b_); w[9] = fminf(a_, b_); }
    { const float a_ = w[2], b_ = w[10]; w[2] = fmaxf(a_, b_); w[10] = fminf(a_, b_); }
    { const float a_ = w[3], b_ = w[11]; w[3] = fmaxf(a_, b_); w[11] = fminf(a_, b_); }
    { const float a_ = w[4], b_ = w[12]; w[4] = fmaxf(a_, b_); w[12] = fminf(a_, b_); }
    { const float a_ = w[5], b_ = w[13]; w[5] = fmaxf(a_, b_); w[13] = fminf(a_, b_); }
    { const float a_ = w[6], b_ = w[14]; w[6] = fmaxf(a_, b_); w[14] = fminf(a_, b_); }
    { const float a_ = w[7], b_ = w[15]; w[7] = fmaxf(a_, b_); w[15] = fminf(a_, b_); }
    { const float a_ = w[0], b_ = w[4]; w[0] = fmaxf(a_, b_); w[4] = fminf(a_, b_); }
    { const float a_ = w[1], b_ = w[5]; w[1] = fmaxf(a_, b_); w[5] = fminf(a_, b_); }
    { const float a_ = w[2], b_ = w[6]; w[2] = fmaxf(a_, b_); w[6] = fminf(a_, b_); }
    { const float a_ = w[3], b_ = w[7]; w[3] = fmaxf(a_, b_); w[7] = fminf(a_, b_); }
    { const float a_ = w[8], b_ = w[12]; w[8] = fmaxf(a_, b_); w[12] = fminf(a_, b_); }
    { const float a_ = w[9], b_ = w[13]; w[9] = fmaxf(a_, b_); w[13] = fminf(a_, b_); }
    { const float a_ = w[10], b_ = w[14]; w[10] = fmaxf(a_, b_); w[14] = fminf(a_, b_); }
    { const float a_ = w[11], b_ = w[15]; w[11] = fmaxf(a_, b_); w[15] = fminf(a_, b_); }
    { const float a_ = w[0], b_ = w[2]; w[0] = fmaxf(a_, b_); w[2] = fminf(a_, b_); }
    { const float a_ = w[1], b_ = w[3]; w[1] = fmaxf(a_, b_); w[3] = fminf(a_, b_); }
    { const float a_ = w[4], b_ = w[6]; w[4] = fmaxf(a_, b_); w[6] = fminf(a_, b_); }
    { const float a_ = w[5], b_ = w[7]; w[5] = fmaxf(a_, b_); w[7] = fminf(a_, b_); }
    { const float a_ = w[8], b_ = w[10]; w[8] = fmaxf(a_, b_); w[10] = fminf(a_, b_); }
    { const float a_ = w[9], b_ = w[11]; w[9] = fmaxf(a_, b_); w[11] = fminf(a_, b_); }
    { const float a_ = w[12], b_ = w[14]; w[12] = fmaxf(a_, b_); w[14] = fminf(a_, b_); }
    { const float a_ = w[13], b_ = w[15]; w[13] = fmaxf(a_, b_); w[15] = fminf(a_, b_); }
    { const float a_ = w[0], b_ = w[1]; w[0] = fmaxf(a_, b_); w[1] = fminf(a_, b_); }
    { const float a_ = w[2], b_ = w[3]; w[2] = fmaxf(a_, b_); w[3] = fminf(a_, b_); }
    { const float a_ = w[4], b_ = w[5]; w[4] = fmaxf(a_, b_); w[5] = fminf(a_, b_); }
    { const float a_ = w[6], b_ = w[7]; w[6] = fmaxf(a_, b_); w[7] = fminf(a_, b_); }
    { const float a_ = w[8], b_ = w[9]; w[8] = fmaxf(a_, b_); w[9] = fminf(a_, b_); }
    { const float a_ = w[10], b_ = w[11]; w[10] = fmaxf(a_, b_); w[11] = fminf(a_, b_); }
    { const float a_ = w[12], b_ = w[13]; w[12] = fmaxf(a_, b_); w[13] = fminf(a_, b_); }
    { const float a_ = w[14], b_ = w[15]; w[14] = fmaxf(a_, b_); w[15] = fminf(a_, b_); }
    if (hi == 0) {
#pragma unroll
        for (int it = 0; it < 16; ++it) { const unsigned k_ = __float_as_uint(w[it]); vout[it * 32 + r32] = __uint_as_float(k_ & 0xffffff80u); iout[it * 32 + r32] = (int)(k_ & 127u); }
    }
}
__device__ __forceinline__ void peer_retrieve(const bf16* KEYB, const bf16* PQ, LAS char* wbase, int t0, int lane0) {
    LAS int* elist = (LAS int*)wbase; LAS float* glist = (LAS float*)(wbase + 2048); LAS float* vtab = (LAS float*)(wbase + 4608); LAS int* itab = (LAS int*)(wbase + 4608 + 4096);
        {
            int lv = lane0; asm volatile("" : "+v"(lv));
            const int r32 = lv & 31, hi = lv >> 5;
            const int tt = r32 >> 3, hd = r32 & 7;
#pragma unroll 1
            for (int side = 0; side < 2; ++side) {
                bf16x8 qf[8];
#pragma unroll
                for (int ks = 0; ks < 8; ++ks) qf[ks] = *(const bf16x8*)(PQ + (size_t)(t0 + tt) * DM + hd * 256 + side * 128 + 16 * ks + 8 * hi);
                f32x16 acc[4];
                bf16x8 ka[8], kn[8];
#pragma unroll
                for (int ks = 0; ks < 8; ++ks) ka[ks] = *(const bf16x8*)(KEYB + (size_t)(side * 128 + r32) * 128 + ks * 16 + hi * 8);
#pragma unroll
                for (int b = 0; b < 4; ++b) {
#pragma unroll
                    for (int r = 0; r < 16; ++r) acc[b][r] = 0.f;
                    if (b < 3) {
#pragma unroll
                        for (int ks = 0; ks < 8; ++ks) kn[ks] = *(const bf16x8*)(KEYB + (size_t)(side * 128 + 32 * (b + 1) + r32) * 128 + ks * 16 + hi * 8); }
                    __builtin_amdgcn_sched_barrier(0);
#pragma unroll
                    for (int ks = 0; ks < 8; ++ks) acc[b] = MFMA32(ka[ks], qf[ks], acc[b]);
                    __builtin_amdgcn_sched_barrier(0);
                    if (b < 3) {
#pragma unroll
                        for (int ks = 0; ks < 8; ++ks) ka[ks] = kn[ks]; }
                }
                top16_of_128(acc, vtab + side * 512, itab + side * 512, r32, hi);
            }
            asm volatile("s_waitcnt lgkmcnt(0)" ::: "memory"); __builtin_amdgcn_wave_barrier();
            float cs[25]; int ce[25];
    cs[0] = hi ? (vtab[0 + r32] + vtab[544 + r32]) : (vtab[0 + r32] + vtab[512 + r32]); ce[0] = hi ? (itab[0 + r32] * 128 + itab[544 + r32]) : (itab[0 + r32] * 128 + itab[512 + r32]);
    cs[1] = hi ? (vtab[0 + r32] + vtab[608 + r32]) : (vtab[0 + r32] + vtab[576 + r32]); ce[1] = hi ? (itab[0 + r32] * 128 + itab[608 + r32]) : (itab[0 + r32] * 128 + itab[576 + r32]);
    cs[2] = hi ? (vtab[0 + r32] + vtab[672 + r32]) : (vtab[0 + r32] + vtab[640 + r32]); ce[2] = hi ? (itab[0 + r32] * 128 + itab[672 + r32]) : (itab[0 + r32] * 128 + itab[640 + r32]);
    cs[3] = hi ? (vtab[0 + r32] + vtab[736 + r32]) : (vtab[0 + r32] + vtab[704 + r32]); ce[3] = hi ? (itab[0 + r32] * 128 + itab[736 + r32]) : (itab[0 + r32] * 128 + itab[704 + r32]);
    cs[4] = hi ? (vtab[0 + r32] + vtab[800 + r32]) : (vtab[0 + r32] + vtab[768 + r32]); ce[4] = hi ? (itab[0 + r32] * 128 + itab[800 + r32]) : (itab[0 + r32] * 128 + itab[768 + r32]);
    cs[5] = hi ? (vtab[0 + r32] + vtab[864 + r32]) : (vtab[0 + r32] + vtab[832 + r32]); ce[5] = hi ? (itab[0 + r32] * 128 + itab[864 + r32]) : (itab[0 + r32] * 128 + itab[832 + r32]);
    cs[6] = hi ? (vtab[0 + r32] + vtab[928 + r32]) : (vtab[0 + r32] + vtab[896 + r32]); ce[6] = hi ? (itab[0 + r32] * 128 + itab[928 + r32]) : (itab[0 + r32] * 128 + itab[896 + r32]);
    cs[7] = hi ? (vtab[0 + r32] + vtab[992 + r32]) : (vtab[0 + r32] + vtab[960 + r32]); ce[7] = hi ? (itab[0 + r32] * 128 + itab[992 + r32]) : (itab[0 + r32] * 128 + itab[960 + r32]);
    cs[8] = hi ? (vtab[32 + r32] + vtab[544 + r32]) : (vtab[32 + r32] + vtab[512 + r32]); ce[8] = hi ? (itab[32 + r32] * 128 + itab[544 + r32]) : (itab[32 + r32] * 128 + itab[512 + r32]);
    cs[9] = hi ? (vtab[32 + r32] + vtab[608 + r32]) : (vtab[32 + r32] + vtab[576 + r32]); ce[9] = hi ? (itab[32 + r32] * 128 + itab[608 + r32]) : (itab[32 + r32] * 128 + itab[576 + r32]);
    cs[10] = hi ? (vtab[32 + r32] + vtab[672 + r32]) : (vtab[32 + r32] + vtab[640 + r32]); ce[10] = hi ? (itab[32 + r32] * 128 + itab[672 + r32]) : (itab[32 + r32] * 128 + itab[640 + r32]);
    cs[11] = hi ? (vtab[32 + r32] + vtab[736 + r32]) : (vtab[32 + r32] + vtab[704 + r32]); ce[11] = hi ? (itab[32 + r32] * 128 + itab[736 + r32]) : (itab[32 + r32] * 128 + itab[704 + r32]);
    cs[12] = hi ? (vtab[64 + r32] + vtab[544 + r32]) : (vtab[64 + r32] + vtab[512 + r32]); ce[12] = hi ? (itab[64 + r32] * 128 + itab[544 + r32]) : (itab[64 + r32] * 128 + itab[512 + r32]);
    cs[13] = hi ? (vtab[64 + r32] + vtab[608 + r32]) : (vtab[64 + r32] + vtab[576 + r32]); ce[13] = hi ? (itab[64 + r32] * 128 + itab[608 + r32]) : (itab[64 + r32] * 128 + itab[576 + r32]);
    cs[14] = hi ? (vtab[96 + r32] + vtab[512 + r32]) : (vtab[64 + r32] + vtab[640 + r32]); ce[14] = hi ? (itab[96 + r32] * 128 + itab[512 + r32]) : (itab[64 + r32] * 128 + itab[640 + r32]);
    cs[15] = hi ? (vtab[96 + r32] + vtab[576 + r32]) : (vtab[96 + r32] + vtab[544 + r32]); ce[15] = hi ? (itab[96 + r32] * 128 + itab[576 + r32]) : (itab[96 + r32] * 128 + itab[544 + r32]);
    cs[16] = hi ? (vtab[128 + r32] + vtab[512 + r32]) : (vtab[96 + r32] + vtab[608 + r32]); ce[16] = hi ? (itab[128 + r32] * 128 + itab[512 + r32]) : (itab[96 + r32] * 128 + itab[608 + r32]);
    cs[17] = hi ? (vtab[128 + r32] + vtab[576 + r32]) : (vtab[128 + r32] + vtab[544 + r32]); ce[17] = hi ? (itab[128 + r32] * 128 + itab[576 + r32]) : (itab[128 + r32] * 128 + itab[544 + r32]);
    cs[18] = hi ? (vtab[160 + r32] + vtab[544 + r32]) : (vtab[160 + r32] + vtab[512 + r32]); ce[18] = hi ? (itab[160 + r32] * 128 + itab[544 + r32]) : (itab[160 + r32] * 128 + itab[512 + r32]);
    cs[19] = hi ? (vtab[192 + r32] + vtab[544 + r32]) : (vtab[192 + r32] + vtab[512 + r32]); ce[19] = hi ? (itab[192 + r32] * 128 + itab[544 + r32]) : (itab[192 + r32] * 128 + itab[512 + r32]);
    cs[20] = hi ? (vtab[224 + r32] + vtab[544 + r32]) : (vtab[224 + r32] + vtab[512 + r32]); ce[20] = hi ? (itab[224 + r32] * 128 + itab[544 + r32]) : (itab[224 + r32] * 128 + itab[512 + r32]);
    cs[21] = hi ? (vtab[288 + r32] + vtab[512 + r32]) : (vtab[256 + r32] + vtab[512 + r32]); ce[21] = hi ? (itab[288 + r32] * 128 + itab[512 + r32]) : (itab[256 + r32] * 128 + itab[512 + r32]);
    cs[22] = hi ? (vtab[352 + r32] + vtab[512 + r32]) : (vtab[320 + r32] + vtab[512 + r32]); ce[22] = hi ? (itab[352 + r32] * 128 + itab[512 + r32]) : (itab[320 + r32] * 128 + itab[512 + r32]);
    cs[23] = hi ? (vtab[416 + r32] + vtab[512 + r32]) : (vtab[384 + r32] + vtab[512 + r32]); ce[23] = hi ? (itab[416 + r32] * 128 + itab[512 + r32]) : (itab[384 + r32] * 128 + itab[512 + r32]);
    cs[24] = hi ? (vtab[480 + r32] + vtab[512 + r32]) : (vtab[448 + r32] + vtab[512 + r32]); ce[24] = hi ? (itab[480 + r32] * 128 + itab[512 + r32]) : (itab[448 + r32] * 128 + itab[512 + r32]);
            float sum = 0.f, top = 0.f;
#pragma unroll 1
            for (int it = 0; it < 16; ++it) {
                float lm = cs[0];
#pragma unroll
                for (int j = 1; j < 25; ++j) lm = fmaxf(lm, cs[j]);
                float pm; { auto r_ = __builtin_amdgcn_permlane32_swap(__float_as_uint(lm), __float_as_uint(lm), false, false); pm = __uint_as_float(hi ? r_[0] : r_[1]); } const float gm = fmaxf(lm, pm);
                const bool mine = (lm == gm) && !(pm == gm && hi == 1);
                int me = -1; bool found = false;
#pragma unroll
                for (int j = 0; j < 25; ++j) { const bool hit = mine && !found && cs[j] == gm; if (hit) { cs[j] = -INFINITY; me = ce[j]; found = true; } }
                if (it == 0) top = gm;
                const float p = __expf(gm - top); sum += p;
                if (mine) { elist[tt * 128 + hd * 16 + it] = me; glist[tt * 128 + hd * 16 + it] = p; }
            }
            asm volatile("s_waitcnt lgkmcnt(0)" ::: "memory"); __builtin_amdgcn_wave_barrier();
            const float isum = 1.f / sum;
            if (hi == 0) {
#pragma unroll
                for (int k = 0; k < 16; ++k) glist[tt * 128 + hd * 16 + k] *= isum;
            }
            asm volatile("s_waitcnt lgkmcnt(0)" ::: "memory"); __builtin_amdgcn_wave_barrier();
        }
}
__device__ __forceinline__ void quant_row(const float* src, unsigned char* dstbase, int rr, float* scale, int lane, bool uns) {
    f32x4 v[2][4]; float amax = 0.f;
#pragma unroll
    for (int c = 0; c < 2; ++c)
#pragma unroll
        for (int k = 0; k < 4; ++k) { v[c][k] = *(const f32x4*)(src + 1024 * c + 16 * lane + 4 * k); amax = fmaxf(amax, fmaxf(fmaxf(fabsf(v[c][k].x), fabsf(v[c][k].y)), fmaxf(fabsf(v[c][k].z), fabsf(v[c][k].w)))); }
    amax = wave_max(amax); const float s = amax > 0.f ? amax * (1.f / 127.f) : 1.f, is = 1.f / s; const int ofs = uns ? 128 : 0;
#pragma unroll
    for (int c = 0; c < 2; ++c) { u32x4 o; unsigned wv[4];
#pragma unroll
        for (int k = 0; k < 4; ++k) { const int q0 = (int)rintf(v[c][k].x * is) + ofs, q1 = (int)rintf(v[c][k].y * is) + ofs, q2 = (int)rintf(v[c][k].z * is) + ofs, q3 = (int)rintf(v[c][k].w * is) + ofs;
            wv[k] = (unsigned)(q0 & 255) | ((unsigned)(q1 & 255) << 8) | ((unsigned)(q2 & 255) << 16) | ((unsigned)(q3 & 255) << 24); }
        o.x = wv[0]; o.y = wv[1]; o.z = wv[2]; o.w = wv[3];
        unsigned char* d = uns ? dstbase + (WS_VQS - WS_VQ) + (size_t)(4 * c + (lane >> 4)) * (4 * MiB) + (size_t)rr * 256 + 16 * (lane & 15) : dstbase + (size_t)rr * DM + 1024 * c + 16 * lane;
        *(u32x4*)d = o;
    }
    if (lane == 0) *scale = s;
}
__device__ __forceinline__ void cvt_f32_bf16(const float* src, bf16* dst, size_t n, size_t thr, size_t nthr) {
    for (size_t i = thr * 8; i < n; i += nthr * 8) { const f32x4 a = *(const f32x4*)(src + i), b = *(const f32x4*)(src + i + 4); u32x4 o; o.x = pk2(a.x, a.y); o.y = pk2(a.z, a.w); o.z = pk2(b.x, b.y); o.w = pk2(b.z, b.w); *(u32x4*)(dst + i) = o; }
}
constexpr size_t WS_PE = 320 * MiB, WS_PG = 324 * MiB, WS_PW = 328 * MiB, WS_XQ8 = 332 * MiB, WS_SX = 348 * MiB, WS_SSP = 349 * MiB;
#define PEER_LOADG(buf, en, g, TAB) do { _Pragma("unroll") for (int i = 0; i < 4; ++i) { const unsigned e_ = (unsigned)__builtin_amdgcn_readfirstlane((int)list[4 * (g) + i]); en[i] = e_; \
        const unsigned char* row = TAB + (size_t)(e_ & 0x3fffu) * DM + 16 * lane; buf[i][0] = *(const u32x4*)row; buf[i][1] = *(const u32x4*)(row + 1024); } __builtin_amdgcn_sched_barrier(0); } while (0)
#define PEER_SWEEP(gs, ge, LOADM, COMPM) do { const int gs_ = (gs), ge_ = (ge); \
        if (gs_ < ge_) { const int gl_ = ge_ - 1; \
            LOADM(ba, ena, gs_); LOADM(bb, enb, (gs_ + 1 < ge_ ? gs_ + 1 : gl_)); \
            for (int g = gs_; g < ge_; g += 2) { \
                COMPM(ba, ena); LOADM(ba, ena, (g + 2 < ge_ ? g + 2 : gl_)); \
                if (g + 1 < ge_) COMPM(bb, enb); LOADM(bb, enb, (g + 3 < ge_ ? g + 3 : gl_)); } } } while (0)
#define PEER_LOADU(buf, en, g) PEER_LOADG(buf, en, g, UQ)
#define PEER_COMPU(buf, en) do { int dd[4]; \
        _Pragma("unroll") for (int i = 0; i < 4; ++i) { const int tt_ = (int)((en[i] >> 21) & 3u); \
            const u32x4 x0_ = xqL[(tt_ * 2) * 64 + lane], x1_ = xqL[(tt_ * 2 + 1) * 64 + lane]; int d = 0; \
            d = __builtin_amdgcn_sdot4((int)buf[i][0].x, (int)x0_.x, d, false); d = __builtin_amdgcn_sdot4((int)buf[i][0].y, (int)x0_.y, d, false); \
            d = __builtin_amdgcn_sdot4((int)buf[i][0].z, (int)x0_.z, d, false); d = __builtin_amdgcn_sdot4((int)buf[i][0].w, (int)x0_.w, d, false); \
            d = __builtin_amdgcn_sdot4((int)buf[i][1].x, (int)x1_.x, d, false); d = __builtin_amdgcn_sdot4((int)buf[i][1].y, (int)x1_.y, d, false); \
            d = __builtin_amdgcn_sdot4((int)buf[i][1].z, (int)x1_.z, d, false); d = __builtin_amdgcn_sdot4((int)buf[i][1].w, (int)x1_.w, d, false); \
            dd[i] = d; } \
        const int b16 = (lane >> 4) & 1; \
        int ra, rb, r1; \
        { auto q_ = __builtin_amdgcn_permlane32_swap((unsigned)dd[0], (unsigned)dd[2], false, false); ra = (int)q_[0] + (int)q_[1]; } \
        { auto q_ = __builtin_amdgcn_permlane32_swap((unsigned)dd[1], (unsigned)dd[3], false, false); rb = (int)q_[0] + (int)q_[1]; } \
        { auto q_ = __builtin_amdgcn_permlane16_swap((unsigned)ra, (unsigned)rb, false, false); r1 = (int)q_[0] + (int)q_[1]; } \
        r1 += dppi<DPP_X1>(r1); r1 += dppi<DPP_X2>(r1); r1 += dppi<DPP_HMIR>(r1); r1 += dppi<DPP_MIR>(r1); \
        const int ei = 2 * hi + b16; \
        unsigned em = en[0]; em = (ei == 1) ? en[1] : em; em = (ei == 2) ? en[2] : em; em = (ei == 3) ? en[3] : em; \
        if ((lane & 15) == 0 && !((em >> 23) & 1u)) wl4[((em >> 21) & 3u) * 128 + ((em >> 14) & 127u)] = (float)r1; } while (0)
#define PEER_PD(acc, xa, xb, wh, sel) do { unsigned t_; asm volatile("v_perm_b32 %1, %3, %2, %5\n\tv_dot2c_f32_f16 %0, %4, %1" : "+v"(acc), "=&v"(t_) : "v"(xa), "v"(xb), "v"(wh), "s"(sel)); } while (0)
#define PEER_D4(A, c, j, xa, xb, wh) do { \
        PEER_PD(A[c][4 * (j) + 0], xa, xb, wh, 0x0c040c00u); PEER_PD(A[c][4 * (j) + 1], xa, xb, wh, 0x0c050c01u); \
        PEER_PD(A[c][4 * (j) + 2], xa, xb, wh, 0x0c060c02u); PEER_PD(A[c][4 * (j) + 3], xa, xb, wh, 0x0c070c03u); } while (0)
__device__ __forceinline__ void p_peer_a(const Args& P, LAS char* lds, int gw, int NGW) {
    unsigned char* ws = P.ws;
    const int tid = threadIdx.x, lane0 = tid & 63, wave = __builtin_amdgcn_readfirstlane(tid >> 6);
    const bf16* KEYB = (const bf16*)(ws + WS_KEYB); const bf16* PQ = (const bf16*)(ws + WS_PQ);
    const bf16* H2 = (const bf16*)(ws + WS_H2B); const float* R2 = (const float*)(ws + WS_R2);
    unsigned short* PE = (unsigned short*)(ws + WS_PE); float* PG = (float*)(ws + WS_PG); unsigned char* XQ = ws + WS_XQ8; float* SX = (float*)(ws + WS_SX);
    LAS char* wbase = lds + wave * 17920;
    LAS int* elist = (LAS int*)wbase; LAS float* glist = (LAS float*)(wbase + 2048);
    for (int tile = gw; tile < S_ / 4; tile += NGW) {
        const int t0 = tile * 4;
        peer_retrieve(KEYB, PQ, wbase, t0, lane0);
        int lane = lane0; asm volatile("" : "+v"(lane));
#pragma unroll
        for (int i = 0; i < 8; ++i) { const int idx = lane + 64 * i; PE[(size_t)t0 * 128 + idx] = (unsigned short)elist[idx]; PG[(size_t)t0 * 128 + idx] = glist[idx]; }
#pragma unroll 1
        for (int tt = 0; tt < 4; ++tt) { const int t = t0 + tt; const float r2 = R2[t]; const float* gf = P.in[23]; f32x4 xv[2][4]; float amax = 0.f;
#pragma unroll
            for (int c = 0; c < 2; ++c)
#pragma unroll
                for (int k = 0; k < 4; ++k) { const size_t o = (size_t)1024 * c + 16 * lane + 4 * k; const u32x2 hb = *(const u32x2*)(H2 + (size_t)t * DM + o); const f32x4 gg = *(const f32x4*)(gf + o);
                    const f32x4 h = {__uint_as_float(hb.x << 16), __uint_as_float(hb.x & 0xffff0000u), __uint_as_float(hb.y << 16), __uint_as_float(hb.y & 0xffff0000u)};
                    xv[c][k] = h * gg * r2; amax = fmaxf(amax, fmaxf(fmaxf(fabsf(xv[c][k].x), fabsf(xv[c][k].y)), fmaxf(fabsf(xv[c][k].z), fabsf(xv[c][k].w)))); }
            amax = wave_max(amax); const float sxv = amax > 0.f ? amax * (1.f / 127.f) : 1.f; const float ix = 1.f / sxv;
            if (lane == 0) SX[t] = sxv;
#pragma unroll
            for (int c = 0; c < 2; ++c) { unsigned q_[4];
#pragma unroll
                for (int k = 0; k < 4; ++k) { const int q0 = (int)rintf(xv[c][k].x * ix), q1 = (int)rintf(xv[c][k].y * ix), q2 = (int)rintf(xv[c][k].z * ix), q3 = (int)rintf(xv[c][k].w * ix);
                    q_[k] = (unsigned)(q0 & 255) | ((unsigned)(q1 & 255) << 8) | ((unsigned)(q2 & 255) << 16) | ((unsigned)(q3 & 255) << 24); }
                *(u32x4*)(XQ + (size_t)t * DM + 1024 * c + 16 * lane) = (u32x4){q_[0], q_[1], q_[2], q_[3]}; } }
        asm volatile("s_waitcnt lgkmcnt(0)" ::: "memory"); __builtin_amdgcn_wave_barrier();
    }
}

__device__ __forceinline__ void p_peer_b(const Args& P, LAS char* lds) {
    unsigned char* ws = P.ws;
    const int tid = threadIdx.x, lane0 = tid & 63, wave = __builtin_amdgcn_readfirstlane(tid >> 6);
    const int x = blockIdx.x & 7, wi = (int)(blockIdx.x >> 3) * NWAVES + wave, NW = (int)(gridDim.x >> 3) * NWAVES;
    const unsigned char* UQ = ws + WS_UQ; const float* USC = (const float*)(ws + WS_USC); const float* VSC = (const float*)(ws + WS_VSC);
    const unsigned short* PE = (const unsigned short*)(ws + WS_PE); const float* PG = (const float*)(ws + WS_PG); float* PW = (float*)(ws + WS_PW);
    const unsigned char* XQ = ws + WS_XQ8; const float* SX = (const float*)(ws + WS_SX);
    LAS char* wbase = lds + wave * 17920;
    LAS unsigned* listbuf = (LAS unsigned*)wbase;
    LAS float* wl4 = (LAS float*)(wbase + 4224);
    LAS float* sxL = (LAS float*)(wbase + 6272);
    LAS u32x4* xqL = (LAS u32x4*)(wbase + 6400);
    const int NT = (S_ / 4 - wi + NW - 1) / NW;
    int lane = lane0; asm volatile("" : "+v"(lane)); const int hi = lane >> 5;
    u32x4 ev1, ev2, xrn[8]; float sxn;
#define PB_LOADEV(dst, i) do { const int tl_ = wi + ((i) < NT ? (i) : NT - 1) * NW; dst = *(const u32x4*)(PE + (size_t)tl_ * 512 + 8 * lane); } while (0)
#define PB_LOADXQ(i) do { const int t0_ = 4 * (wi + ((i) < NT ? (i) : NT - 1) * NW); sxn = SX[t0_ + (lane & 3)]; \
        _Pragma("unroll") for (int tt = 0; tt < 4; ++tt) _Pragma("unroll") for (int cc = 0; cc < 2; ++cc) xrn[tt * 2 + cc] = *(const u32x4*)(XQ + (size_t)(t0_ + tt) * DM + 1024 * cc + 16 * lane); } while (0)
#define PB_COMPACT(ev, lst, valid, TOT, GG) do { \
        unsigned ee[8]; ee[0] = ev.x & 0xffffu; ee[1] = ev.x >> 16; ee[2] = ev.y & 0xffffu; ee[3] = ev.y >> 16; ee[4] = ev.z & 0xffffu; ee[5] = ev.z >> 16; ee[6] = ev.w & 0xffffu; ee[7] = ev.w >> 16; \
        unsigned mm = 0; \
        _Pragma("unroll") for (int j = 0; j < 8; ++j) mm |= (unsigned)((((ee[j] >> 7) + ee[j]) & 7u) == (unsigned)x) << j; \
        mm = (valid) ? mm : 0u; \
        const int c = __builtin_popcount(mm); int incl = c; \
        _Pragma("unroll") for (int o = 1; o < 64; o <<= 1) { const int tv = __shfl_up(incl, o); if (lane >= o) incl += tv; } \
        TOT = __builtin_amdgcn_readlane(incl, 63); \
        { int off = incl - c; \
          _Pragma("unroll") for (int j = 0; j < 8; ++j) if ((mm >> j) & 1u) { lst[off] = ee[j] | ((unsigned)((8 * lane + j) & 127) << 14) | ((unsigned)(lane >> 4) << 21); ++off; } } \
        const int npad = (TOT == 0) ? 8 : ((-TOT) & 7); GG = (TOT + npad) >> 2; \
        if (lane < npad) lst[TOT + lane] = (1u << 23) | (unsigned)x; \
        asm volatile("s_waitcnt lgkmcnt(0)" ::: "memory"); __builtin_amdgcn_wave_barrier(); } while (0)
#define PB_LOADG(buf, en, lst, gi) do { _Pragma("unroll") for (int i = 0; i < 4; ++i) { const unsigned e_ = (unsigned)__builtin_amdgcn_readfirstlane((int)lst[4 * (gi) + i]); en[i] = e_; \
        const unsigned char* row = UQ + (size_t)(e_ & 0x3fffu) * DM + 16 * lane; buf[i][0] = *(const u32x4*)row; buf[i][1] = *(const u32x4*)(row + 1024); } __builtin_amdgcn_sched_barrier(0); } while (0)
    u32x4 ba[4][2], bb[4][2]; unsigned ena[4], enb[4];
    int tot, G;
    PB_LOADEV(ev1, 0); PB_LOADXQ(0); PB_LOADEV(ev2, 1);
    PB_COMPACT(ev1, listbuf, true, tot, G);
    PB_LOADG(ba, ena, listbuf, 0); PB_LOADG(bb, enb, listbuf, 1);
    ev1 = ev2;
#pragma unroll 1
    for (int it = 0; it < NT; ++it) {
        const int t0 = 4 * (wi + it * NW);
        LAS unsigned* cur = listbuf + (it & 1) * 528; LAS unsigned* nxt = listbuf + ((it + 1) & 1) * 528;
#pragma unroll
        for (int i = 0; i < 8; ++i) xqL[i * 64 + lane] = xrn[i];
        if (lane < 4) sxL[lane] = sxn;
        PB_LOADXQ(it + 1); PB_LOADEV(ev2, it + 2);
        __builtin_amdgcn_sched_barrier(0);
        int totn, Gn;
        PB_COMPACT(ev1, nxt, it + 1 < NT, totn, Gn);
        unsigned en_[2]; float ga_[2], us_[2], vs_[2];
#pragma unroll
        for (int q_ = 0; q_ < 2; ++q_) { const int j = lane + 64 * q_; const unsigned e_ = cur[j < tot ? j : 0]; en_[q_] = e_;
            ga_[q_] = PG[(size_t)(t0 + (int)((e_ >> 21) & 3u)) * 128 + ((e_ >> 14) & 127u)]; us_[q_] = USC[e_ & 0x3fffu]; vs_[q_] = VSC[e_ & 0x3fffu]; }
        __builtin_amdgcn_sched_barrier(0);
        for (int g = 0; g < G; g += 2) {
            PEER_COMPU(ba, ena); { const int r_ = g + 2; const bool in_ = r_ < G; LAS unsigned* l_ = in_ ? cur : nxt; const int gi_ = in_ ? r_ : r_ - G; PB_LOADG(ba, ena, l_, gi_); }
            PEER_COMPU(bb, enb); { const int r_ = g + 3; const bool in_ = r_ < G; LAS unsigned* l_ = in_ ? cur : nxt; const int gi_ = in_ ? r_ : r_ - G; PB_LOADG(bb, enb, l_, gi_); }
        }
        asm volatile("s_waitcnt lgkmcnt(0)" ::: "memory"); __builtin_amdgcn_wave_barrier();
#pragma unroll
        for (int q_ = 0; q_ < 2; ++q_) { const int j = lane + 64 * q_; const unsigned e_ = en_[q_]; const int tt = (int)((e_ >> 21) & 3u), k = (int)((e_ >> 14) & 127u);
            if (j < tot) PW[(size_t)(t0 + tt) * 128 + k] = ga_[q_] * gelu_exact(wl4[tt * 128 + k] * (us_[q_] * sxL[tt])) * vs_[q_]; }
        for (int j = lane + 128; j < tot; j += 64) { const unsigned e_ = cur[j]; const int tt = (int)((e_ >> 21) & 3u), k = (int)((e_ >> 14) & 127u);
            PW[(size_t)(t0 + tt) * 128 + k] = PG[(size_t)(t0 + tt) * 128 + k] * gelu_exact(wl4[tt * 128 + k] * (USC[e_ & 0x3fffu] * sxL[tt])) * VSC[e_ & 0x3fffu]; }
        asm volatile("s_waitcnt lgkmcnt(0)" ::: "memory"); __builtin_amdgcn_wave_barrier();
        tot = totn; G = Gn; ev1 = ev2;
    }
#undef PB_LOADEV
#undef PB_LOADXQ
#undef PB_COMPACT
#undef PB_LOADG
}

#ifndef PD_VALU2
#define PD_VALU2 0
#endif
template <unsigned EMASK> __device__ __forceinline__ void p_peer_d(const Args& P, LAS char* lds) {
    unsigned char* ws = P.ws;
    const int tid = threadIdx.x, lane0 = tid & 63, wave = __builtin_amdgcn_readfirstlane(tid >> 6);
    const int x = blockIdx.x & 7, wi = (int)(blockIdx.x >> 3) * NWAVES + wave;
    const unsigned short* PE = (const unsigned short*)(ws + WS_PE); const float* PW = (const float*)(ws + WS_PW);
    const bf16* H2 = (const bf16*)(ws + WS_H2B); float* SSP = (float*)(ws + WS_SSP);
    LAS char* wbase = lds + wave * 17920;
    LAS unsigned* lb = (LAS unsigned*)(wbase + 16384);
    int lane = lane0; asm volatile("" : "+v"(lane));
    const int g = lane >> 4, l16 = lane & 15;
    const unsigned char* VSu = ws + WS_VQS + (size_t)x * (4 * MiB);
    const unsigned l16b = 16u * (unsigned)l16;
    const int tb = wi * 32;
    float acc[1][16], accz[1][16];
#pragma unroll
    for (int j = 0; j < 16; ++j) { acc[0][j] = 0.f; accz[0][j] = 0.f; }
    unsigned short pe0, pe1; float pw0, pw1; u32x2 ph;
    u32x2 hcur; float sumw_cur, sumw_nxt;
#define PD_LOAD(n) do { const int t_ = tb + ((n) < 32 ? (n) : 31); pe0 = PE[(size_t)t_ * 128 + lane]; pe1 = PE[(size_t)t_ * 128 + 64 + lane]; pw0 = PW[(size_t)t_ * 128 + lane]; pw1 = PW[(size_t)t_ * 128 + 64 + lane]; \
        ph = *(const u32x2*)(H2 + (size_t)t_ * DM + 256 * x + 16 * l16 + 4 * g); } while (0)
#define PD_STORE(b) do { sumw_nxt = wave_sum(pw0 + pw1); const h2_t w2_ = {(_Float16)(pw0 * 256.f), (_Float16)(pw1 * 256.f)}; \
        lb[(b) * 192 + lane] = ((unsigned)pe0 & EMASK) << 8; lb[(b) * 192 + 64 + lane] = ((unsigned)pe1 & EMASK) << 8; lb[(b) * 192 + 128 + lane] = __builtin_bit_cast(unsigned, w2_); \
        asm volatile("s_waitcnt lgkmcnt(0)" ::: "memory"); __builtin_amdgcn_wave_barrier(); } while (0)
    u32x4 ra[8], rb[8]; unsigned rw[8];
#define PD_STEP(s, b, i, DO_CONSUME) do { const int ix_ = (b) * 192 + 4 * (i) + g; const unsigned oa_ = lb[ix_], ob_ = lb[ix_ + 64], wn_ = lb[ix_ + 128]; \
        if (DO_CONSUME && PD_VALU2 && EMASK != 0xffffu) { PEER_D4(accz, 0, 0, ra[s].x, rb[s].x, rw[s]); PEER_D4(accz, 0, 1, ra[s].y, rb[s].y, rw[s]); PEER_D4(accz, 0, 2, ra[s].z, rb[s].z, rw[s]); PEER_D4(accz, 0, 3, ra[s].w, rb[s].w, rw[s]); } \
        if (DO_CONSUME) { PEER_D4(acc, 0, 0, ra[s].x, rb[s].x, rw[s]); PEER_D4(acc, 0, 1, ra[s].y, rb[s].y, rw[s]); PEER_D4(acc, 0, 2, ra[s].z, rb[s].z, rw[s]); PEER_D4(acc, 0, 3, ra[s].w, rb[s].w, rw[s]); } \
        ra[s] = *(const u32x4*)(VSu + (oa_ | l16b)); rb[s] = *(const u32x4*)(VSu + (ob_ | l16b)); rw[s] = wn_; __builtin_amdgcn_sched_barrier(0); } while (0)
    PD_LOAD(0); PD_STORE(0); sumw_cur = sumw_nxt; hcur = ph;
#pragma unroll
    for (int s = 0; s < 8; ++s) PD_STEP(s, 0, s, false);
#pragma unroll 1
    for (int n = 0; n < 32; ++n) {
        const int b = n & 1;
        PD_LOAD(n + 1);
        __builtin_amdgcn_sched_barrier(0);
#pragma unroll
        for (int s = 0; s < 8; ++s) PD_STEP(s, b, 8 + s, true);
        PD_STORE(b ^ 1);
#pragma unroll
        for (int s = 0; s < 8; ++s) PD_STEP(s, b ^ 1, s, true);
        { const int t = tb + n; const float off = 128.f * sumw_cur; float u8[8], v[4];
#pragma unroll
          for (int j = 0; j < 8; ++j) { auto q_ = __builtin_amdgcn_permlane32_swap(__float_as_uint(acc[0][j]), __float_as_uint(acc[0][j + 8]), false, false); u8[j] = __uint_as_float(q_[0]) + __uint_as_float(q_[1]); acc[0][j] = 0.f; acc[0][j + 8] = 0.f; }
#pragma unroll
          for (int j = 0; j < 4; ++j) { auto q_ = __builtin_amdgcn_permlane16_swap(__float_as_uint(u8[j]), __float_as_uint(u8[j + 4]), false, false); v[j] = (__uint_as_float(q_[0]) + __uint_as_float(q_[1])) * 65536.f - off; }
          v[0] += __uint_as_float(hcur.x << 16); v[1] += __uint_as_float(hcur.x & 0xffff0000u); v[2] += __uint_as_float(hcur.y << 16); v[3] += __uint_as_float(hcur.y & 0xffff0000u);
          float ss = (v[0] * v[0] + v[1] * v[1]) + (v[2] * v[2] + v[3] * v[3]);
          ss = wave_sum(ss);
          if (lane == 0) SSP[(size_t)x * S_ + t] = ss;
          const h2_t a_ = {(_Float16)v[0], (_Float16)v[1]}, b_ = {(_Float16)v[2], (_Float16)v[3]};
          *(LAS u32x2*)(wbase + (size_t)(n * 256 + 16 * l16 + 4 * g) * 2) = (u32x2){__builtin_bit_cast(unsigned, a_), __builtin_bit_cast(unsigned, b_)};
          sumw_cur = sumw_nxt; hcur = ph; }
    }
#undef PD_LOAD
#undef PD_STORE
#undef PD_STEP
    asm volatile("s_waitcnt vmcnt(0) lgkmcnt(0)" ::: "memory"); __builtin_amdgcn_wave_barrier();
}

__device__ __forceinline__ void p_peer_e(const Args& P, LAS char* lds) {
    unsigned char* ws = P.ws;
    const int tid = threadIdx.x, lane = tid & 63, wave = __builtin_amdgcn_readfirstlane(tid >> 6);
    const int x = blockIdx.x & 7, wi = (int)(blockIdx.x >> 3) * NWAVES + wave, tb = wi * 32;
    const float* SSP = (const float*)(ws + WS_SSP);
    LAS char* wbase = lds + wave * 17920;
    float s = 0.f;
#pragma unroll
    for (int q = 0; q < 8; ++q) s += SSP[(size_t)q * S_ + tb + (lane & 31)];
    const float rrv = rsqrtf(s * (1.f / DM) + EPS);
    const f32x4 gg = *(const f32x4*)(P.in[29] + 256 * x + 4 * lane);
#pragma unroll 4
    for (int n = 0; n < 32; ++n) { const float rr = __shfl(rrv, n);
        const u32x2 hs = *(const LAS u32x2*)(wbase + (size_t)(n * 256 + 4 * lane) * 2);
        const unsigned s0_ = hs.x, s1_ = hs.y; const h2_t a_ = __builtin_bit_cast(h2_t, s0_); const h2_t b_ = __builtin_bit_cast(h2_t, s1_);
        const f32x4 ov = {(float)a_.x * rr * gg.x, (float)a_.y * rr * gg.y, (float)b_.x * rr * gg.z, (float)b_.y * rr * gg.w};
        *(f32x4*)(P.out + (size_t)(tb + n) * DM + 256 * x + 4 * lane) = ov; }
}
#undef PEER_LOADG
#undef PEER_SWEEP
#undef PEER_LOADU
#undef PEER_COMPU
#undef PEER_PD
#undef PEER_D4
constexpr int NS_KS = 144, NS_VS = 192, NS_VOFF = 64 * NS_KS, NS_BUF = NS_VOFF + 64 * NS_VS;
constexpr int NS_IMP_OFF = 2 * NS_BUF;
constexpr int NS_OACC_OFF = NS_IMP_OFF + 32768;
struct KVStage { u32x4 k, v; };
template <class TileF>
__device__ __forceinline__ void kv_tile_loop(const bf16* Kg, const bf16* Vg, int g, int kt_lo, int kt_hi, LAS char* lds, TileF f) {
    if (kt_lo >= kt_hi) return;
    int tid = threadIdx.x; asm volatile("" : "+v"(tid));
    const int kkey = tid >> 3, kc = tid & 7;
    const size_t soff = (size_t)kkey * 256 + g * 64 + kc * 8; const int kdst = kkey * NS_KS + kc * 16, vdst = NS_VOFF + kkey * NS_VS + kc * 16;
    KVStage sA, sB;
#define KV_LOAD(S, kt) do { S.k = *(const u32x4*)(Kg + (size_t)(kt) * 64 * 256 + soff); S.v = *(const u32x4*)(Vg + (size_t)(kt) * 64 * 256 + soff); } while (0)
#define KV_STORE(S, b) do { LAS char* nb_ = lds + (b) * NS_BUF; *(LAS u32x4*)(nb_ + kdst) = S.k; *(LAS u32x4*)(nb_ + vdst) = S.v; } while (0)
#define KV_ITER(kt, S, nb) do { f((kt), (const LAS char*)(lds + ((nb) ^ 1) * NS_BUF)); if ((kt) + 1 < kt_hi) KV_STORE(S, nb); if ((kt) + 3 < kt_hi) KV_LOAD(S, (kt) + 3); LDS_BARRIER(); } while (0)
    KV_LOAD(sA, kt_lo); KV_STORE(sA, 0);
    if (kt_lo + 1 < kt_hi) KV_LOAD(sB, kt_lo + 1);
    if (kt_lo + 2 < kt_hi) KV_LOAD(sA, kt_lo + 2);
    __syncthreads();
    for (int kt = kt_lo; kt < kt_hi; kt += 2) { KV_ITER(kt, sB, 1); if (kt + 1 < kt_hi) KV_ITER(kt + 1, sA, 0); }
#undef KV_LOAD
#undef KV_STORE
#undef KV_ITER
}
__device__ __forceinline__ void nsa_unit(const Args& a, int g, int qt, LAS char* lds) {
    unsigned char* ws = a.ws;
    const int tid = threadIdx.x, lane = tid & 63, w = __builtin_amdgcn_readfirstlane(tid >> 6), r32 = lane & 31, hi = lane >> 5;
    const int tokl = r32 >> 2, hh = r32 & 3, t = 64 * qt + 8 * w + tokl, cur = qt;
    const bf16* NQ = (const bf16*)(ws + WS_NQ);
    const bf16* KCb = (const bf16*)(ws + WS_KC); const bf16* VCb = (const bf16*)(ws + WS_VC);
    const bf16* KSEL = (const bf16*)(ws + WS_KV6 + 2 * 4 * MiB); const bf16* VSEL = (const bf16*)(ws + WS_KV6 + 3 * 4 * MiB);
    const bf16* KWIN = (const bf16*)(ws + WS_KV6 + 4 * 4 * MiB); const bf16* VWIN = (const bf16*)(ws + WS_KV6 + 5 * 4 * MiB);
    const float* NG = (const float*)(ws + WS_NG) + (size_t)t * 48 + (g * 4 + hh) * 3;
    bf16x8 qf[4];
#pragma unroll
    for (int ks = 0; ks < 4; ++ks) qf[ks] = *(const bf16x8*)(NQ + (size_t)t * 1024 + (g * 4 + hh) * 64 + 16 * ks + 8 * hi);
    LAS float* oaccL = (LAS float*)(lds + NS_OACC_OFF) + w * 2048 + lane;
    LAS float* imp = (LAS float*)(lds + NS_IMP_OFF) + w * 1024 + tokl * 128;

    {
        const int cnt = t >= 31 ? ((t - 31) >> 4) + 1 : 0;
        int cmax = 4 * qt + 3; cmax = cmax > 511 ? 511 : cmax;
        const int ntc = (cmax + 63) >> 6;
        float mc = -INFINITY, lc = 0.f; f32x16 zero16;
#pragma unroll
        for (int r = 0; r < 16; ++r) zero16[r] = 0.f;
        kv_tile_loop(KCb, VCb, g, 0, ntc, lds, [&](int kt, const LAS char* buf) {
            f32x16 p0, p1; qk_scores<64, NS_KS>(qf, buf, lane, zero16, p0, p1);
#pragma unroll
            for (int r = 0; r < 16; ++r) { const int n = 64 * kt + crow(r, hi); if (n >= cnt) p0[r] = -INFINITY; if (n + 32 >= cnt) p1[r] = -INFINITY; }
            const float mx = tile_colmax(p0, p1); const float mnew = fmaxf(mc, mx); const float msafe = (mnew == -INFINITY) ? 0.f : mnew;
            float ps = 0.f;
#pragma unroll
            for (int r = 0; r < 16; ++r) ps += fexp2(p0[r] - msafe) + fexp2(p1[r] - msafe);
            lc = lc * fexp2(mc - msafe) + ps; mc = mnew; });
        lc = sum_x32(lc);
        const float invl = lc > 0.f ? 1.f / lc : 0.f; const float msafe = (mc == -INFINITY) ? 0.f : mc;
#pragma unroll
        for (int i = 0; i < 16; ++i) ((LAS float*)(lds + NS_IMP_OFF) + w * 1024)[lane + 64 * i] = 0.f;
        asm volatile("s_waitcnt lgkmcnt(0)" ::: "memory"); __builtin_amdgcn_wave_barrier();
        f32x16 oc[2];
#pragma unroll
        for (int d = 0; d < 2; ++d)
#pragma unroll
            for (int r = 0; r < 16; ++r) oc[d][r] = 0.f;
        kv_tile_loop(KCb, VCb, g, 0, ntc, lds, [&](int kt, const LAS char* buf) {
            f32x16 p0, p1; qk_scores<64, NS_KS>(qf, buf, lane, zero16, p0, p1);
#pragma unroll
            for (int r = 0; r < 16; ++r) { const int n = 64 * kt + crow(r, hi); p0[r] = (n >= cnt) ? 0.f : fexp2(p0[r] - msafe) * invl; p1[r] = (n + 32 >= cnt) ? 0.f : fexp2(p1[r] - msafe) * invl; }
#pragma unroll
            for (int c = 0; c < 4; ++c) {
                float s0 = (p0[4 * c] + p0[4 * c + 1]) + (p0[4 * c + 2] + p0[4 * c + 3]), s1 = (p1[4 * c] + p1[4 * c + 1]) + (p1[4 * c + 2] + p1[4 * c + 3]);
                s0 += dppf<DPP_X1>(s0); s0 += dppf<DPP_X2>(s0); s1 += dppf<DPP_X1>(s1); s1 += dppf<DPP_X2>(s1);
                if (hh == 0) { imp[16 * kt + 2 * c + hi] = s0; imp[16 * kt + 8 + 2 * c + hi] = s1; } }
            pv_accum<64, NS_VS>(oc, p0, p1, buf + NS_VOFF, lane); });
        const float gc = NG[0];
#pragma unroll
        for (int d = 0; d < 2; ++d)
#pragma unroll
            for (int r = 0; r < 16; ++r) oaccL[(16 * d + r) * 64] = gc * oc[d][r];
    }
    unsigned long long sel_lo = 0ull, sel_hi = 0ull;
    {
        asm volatile("s_waitcnt lgkmcnt(0)" ::: "memory"); __builtin_amdgcn_wave_barrier();
        const int s8 = hh + 4 * hi;
        float vals[16];
#pragma unroll
        for (int i = 0; i < 16; ++i) { const int j = s8 + 8 * i; const bool forced = (j == 0) || (j == cur) || (j == cur - 1);
            vals[i] = (j <= cur) ? imp[j] + (forced ? 100.f : 0.f) : -INFINITY; }
        unsigned lsel = 0u;
#pragma unroll 1
        for (int it = 0; it < 16; ++it) {
            float lm = vals[0];
#pragma unroll
            for (int i = 1; i < 16; ++i) lm = fmaxf(lm, vals[i]);
            float gm = fmaxf(lm, dppf<DPP_X1>(lm)); gm = fmaxf(gm, dppf<DPP_X2>(gm)); gm = max_x32(gm);
            int cand = (lm == gm && gm > -INFINITY) ? s8 : 99;
            int mn = min(cand, dppi<DPP_X1>(cand)); mn = min(mn, dppi<DPP_X2>(mn)); { auto r_ = __builtin_amdgcn_permlane32_swap((unsigned)mn, (unsigned)mn, false, false); mn = min((int)r_[0], (int)r_[1]); }
            const bool win = (s8 == mn); bool found = false;
#pragma unroll
            for (int i = 0; i < 16; ++i) { const bool hit = win && !found && vals[i] == gm; if (hit) { vals[i] = -INFINITY; lsel |= 1u << i; found = true; } }
        }
#pragma unroll
        for (int k = 0; k < 4; ++k) { unsigned wv = 0u;
#pragma unroll
            for (int i = 0; i < 4; ++i) wv |= ((lsel >> (4 * k + i)) & 1u) << (s8 + 8 * i);
            wv |= (unsigned)dppi<DPP_X1>((int)wv); wv |= (unsigned)dppi<DPP_X2>((int)wv); { auto r_ = __builtin_amdgcn_permlane32_swap(wv, wv, false, false); wv = r_[0] | r_[1]; }
            if (k == 0) sel_lo |= (unsigned long long)wv; if (k == 1) sel_lo |= (unsigned long long)wv << 32; if (k == 2) sel_hi |= (unsigned long long)wv; if (k == 3) sel_hi |= (unsigned long long)wv << 32; }
    }
    {
        Flash<64> f; flash_init(f);
        kv_tile_loop(KSEL, VSEL, g, 0, cur + 1, lds, [&](int j, const LAS char* buf) {
            const unsigned long long wsel = j < 64 ? sel_lo : sel_hi;
            const bool sel = (wsel >> (j & 63)) & 1ull;
            if (__ballot(sel) != 0ull) {
                flash_tile<64, 64, NS_KS, NS_VS, true>(f, qf, buf, buf + NS_VOFF, lane, sel, [&](f32x16& p0, f32x16& p1) {
                    if (j == cur) {
#pragma unroll
                        for (int r = 0; r < 16; ++r) { const int key = 64 * j + crow(r, hi); if (key > t) p0[r] = -INFINITY; if (key + 32 > t) p1[r] = -INFINITY; }
                    } });
            } });
        const float l = sum_x32(f.l); const float gs = NG[1] * (l > 0.f ? 1.f / l : 0.f);
#pragma unroll
        for (int d = 0; d < 2; ++d)
#pragma unroll
            for (int r = 0; r < 16; ++r) oaccL[(16 * d + r) * 64] += gs * f.o[d][r];
    }
    {
        Flash<64> f; flash_init(f);
        const int kt_lo = qt >= 8 ? qt - 8 : 0;
        kv_tile_loop(KWIN, VWIN, g, kt_lo, qt + 1, lds, [&](int kt, const LAS char* buf) {
            const bool edge = (kt == qt) || (kt + 8 == qt);
            flash_tile<64, 64, NS_KS, NS_VS, false>(f, qf, buf, buf + NS_VOFF, lane, true, [&](f32x16& p0, f32x16& p1) {
                if (edge) {
#pragma unroll
                    for (int r = 0; r < 16; ++r) { const int key = 64 * kt + crow(r, hi); if (key > t || key + 511 < t) p0[r] = -INFINITY; if (key + 32 > t || key + 32 + 511 < t) p1[r] = -INFINITY; }
                } }); });
        const float l = sum_x32(f.l); const float gw = NG[2] * (l > 0.f ? 1.f / l : 0.f);
        bf16* ONSA = (bf16*)(ws + WS_ONSA);
#pragma unroll
        for (int d = 0; d < 2; ++d)
#pragma unroll
            for (int r4 = 0; r4 < 4; ++r4) { float v[4];
#pragma unroll
                for (int e = 0; e < 4; ++e) v[e] = oaccL[(16 * d + 4 * r4 + e) * 64] + gw * f.o[d][4 * r4 + e];
                u32x2 o; o.x = pk2(v[0], v[1]); o.y = pk2(v[2], v[3]);
                *(u32x2*)(ONSA + (size_t)t * 1024 + (g * 4 + hh) * 64 + 32 * d + 8 * r4 + 4 * hi) = o; }
    }
}
typedef float f32x4v __attribute__((ext_vector_type(4)));
__device__ __forceinline__ void compress_unit(const Args& P, int rg, LAS char* lds) {
    unsigned char* ws = P.ws;
    const int tid = threadIdx.x, lane = tid & 63, w = __builtin_amdgcn_readfirstlane(tid >> 6);
    const int which = rg & 1, g = (rg >> 1) & 3, nb = rg >> 3, n0 = 16 * nb;
    const bf16* src = (const bf16*)(ws + WS_KV6 + (size_t)which * 4 * MiB);
    const bf16* w1t = (const bf16*)(ws + WS_W1C) + (size_t)which * 128 * 2048;
    const float* cpos = (const float*)(ws + WS_CPOS) + which * 128;
    const float* w2 = which ? P.in[14] : P.in[12];
    const int i16 = lane & 15, kg = lane >> 4;
    int nrow = n0 + i16; nrow = nrow > 510 ? 510 : nrow;
    const bf16* arow = src + (size_t)(16 * nrow) * 256 + g * 64;
    const bf16* brow = w1t + (size_t)(16 * w + i16) * 2048;
    f32x4 w2r[4];
#pragma unroll
    for (int i = 0; i < 4; ++i) w2r[i] = *(const f32x4*)(w2 + (size_t)(i * 512 + tid) * 4);
    f32x4v acc = {0.f, 0.f, 0.f, 0.f};
    bf16x8 bwA[8], avA[8], bwB[8], avB[8];
#define CU_LOAD(BW, AV, bt) do { _Pragma("unroll") for (int i = 0; i < 8; ++i) { const int kk = 32 * (8 * (bt) + i) + 8 * kg; BW[i] = *(const bf16x8*)(brow + kk); AV[i] = *(const bf16x8*)(arow + (size_t)(kk >> 6) * 256 + (kk & 63)); } } while (0)
#define CU_MMA(BW, AV) do { _Pragma("unroll") for (int i = 0; i < 8; ++i) acc = __builtin_amdgcn_mfma_f32_16x16x32_bf16(BW[i], AV[i], acc, 0, 0, 0); } while (0)
    CU_LOAD(bwA, avA, 0);
#pragma unroll
    for (int bt = 0; bt < 8; bt += 2) {
        CU_LOAD(bwB, avB, bt + 1); __builtin_amdgcn_sched_barrier(0); CU_MMA(bwA, avA); __builtin_amdgcn_sched_barrier(0);
        if (bt + 2 < 8) CU_LOAD(bwA, avA, bt + 2);
        __builtin_amdgcn_sched_barrier(0); CU_MMA(bwB, avB); __builtin_amdgcn_sched_barrier(0);
    }
#undef CU_LOAD
#undef CU_MMA
    LAS float* hid = (LAS float*)lds;
    LAS float* w2L = (LAS float*)(lds + 8192);
#pragma unroll
    for (int e = 0; e < 4; ++e) { const int col = 16 * w + 4 * kg + e; hid[i16 * 128 + col] = gelu_exact(acc[e] + cpos[col]); }
#pragma unroll
    for (int i = 0; i < 4; ++i) *(LAS f32x4*)(w2L + (i * 512 + tid) * 4) = w2r[i];
    __syncthreads();
    { const int nl = tid >> 5, d = (tid & 31) * 2; float o0 = 0.f, o1 = 0.f;
#pragma unroll 16
      for (int hh = 0; hh < 128; ++hh) { const float hv = hid[nl * 128 + hh]; const f32x2_t wv = *(const LAS f32x2_t*)(w2L + hh * 64 + d); o0 += hv * wv.x; o1 += hv * wv.y; }
      if (n0 + nl < 511) *(unsigned*)((bf16*)(ws + (which ? WS_VC : WS_KC)) + (size_t)(n0 + nl) * 256 + g * 64 + d) = pk2(o0, o1); }
    __syncthreads();
}

struct EpiZ {
    static constexpr bool PERM = true, AFTER_DRAIN = false; unsigned char* ws;
    __device__ __forceinline__ void operator()(const pg8::f32x4 (&acc)[2][2][4][2], const pg8::Unit& u, int wr, int wc, int fr, int fq) const {
        const int pn = u.pn;
        const float* COS = (const float*)(ws + WS_COS); const float* SIN = (const float*)(ws + WS_SIN);
        bf16* dst; int ld, cbase; bool rope = false, sig = false; float scale = 1.f;
        if (pn < 4) { dst = (bf16*)(ws + WS_QDA); ld = 1024; cbase = 0; rope = true; scale = QSCALE; }
        else if (pn < 8) { dst = (bf16*)(ws + WS_KDA); ld = 1024; cbase = 1024; rope = true; }
        else if (pn < 12) { dst = (bf16*)(ws + WS_VDA); ld = 1024; cbase = 2048; }
        else if (pn < 16) { dst = (bf16*)(ws + WS_NQ); ld = 1024; cbase = 3072; rope = true; scale = QSCALE; }
        else if (pn < 22) { const int j = pn - 16; dst = (bf16*)(ws + WS_KV6 + (size_t)j * 4 * MiB); ld = 256; cbase = 4096 + 256 * j; rope = (j & 1) == 0; }
        else { dst = (bf16*)(ws + WS_BG); ld = 4096; cbase = 5632; sig = true; }
        const bool ropelane = rope && ((wc & 1) == 0) && (fq < 2);
#pragma unroll
        for (int ai = 0; ai < 2; ++ai)
#pragma unroll
            for (int m = 0; m < 4; ++m) { const int row = u.pm * 256 + ai * 128 + wr * 64 + m * 16 + fr;
                f32x4 c0 = {1.f, 1.f, 1.f, 1.f}, c1 = c0, s0 = {0.f, 0.f, 0.f, 0.f}, s1 = s0;
                if (rope) { c0 = *(const f32x4*)(COS + row * 8); c1 = *(const f32x4*)(COS + row * 8 + 4); s0 = *(const f32x4*)(SIN + row * 8); s1 = *(const f32x4*)(SIN + row * 8 + 4); }
#pragma unroll
                for (int bj = 0; bj < 2; ++bj) { f32x4 v0 = acc[ai][bj][m][0], v1 = acc[ai][bj][m][1];
                    const int c8 = pn * 256 + bj * 128 + wc * 32 + 8 * fq;
                    if (rope) {
                        f32x4 o0, o1;
#define XR16(x) ([&]() { auto r_ = __builtin_amdgcn_permlane16_swap(__float_as_uint(x), __float_as_uint(x), false, false); return __uint_as_float((fq & 1) ? r_[0] : r_[1]); }())
                        o0.x = XR16(v0.x); o0.y = XR16(v0.y); o0.z = XR16(v0.z); o0.w = XR16(v0.w);
                        o1.x = XR16(v1.x); o1.y = XR16(v1.y); o1.z = XR16(v1.z); o1.w = XR16(v1.w);
#undef XR16
                        if (ropelane) { const float sg = (fq == 0) ? -1.f : 1.f; v0 = v0 * c0 + o0 * s0 * sg; v1 = v1 * c1 + o1 * s1 * sg; }
                    }
                    if (pn == 38) {
                        const int c = c8 - 9728;
                        if (c < 48) { float* ng = (float*)(ws + WS_NG) + (size_t)row * 48 + c;
                            f32x4 a = {sigmoidf_(v0.x), sigmoidf_(v0.y), sigmoidf_(v0.z), sigmoidf_(v0.w)}, b = {sigmoidf_(v1.x), sigmoidf_(v1.y), sigmoidf_(v1.z), sigmoidf_(v1.w)};
                            *(f32x4*)ng = a; *(f32x4*)(ng + 4) = b; }
                    } else {
                        if (sig) { v0 = (f32x4){sigmoidf_(v0.x), sigmoidf_(v0.y), sigmoidf_(v0.z), sigmoidf_(v0.w)}; v1 = (f32x4){sigmoidf_(v1.x), sigmoidf_(v1.y), sigmoidf_(v1.z), sigmoidf_(v1.w)}; }
                        v0 = v0 * scale; v1 = v1 * scale;
                        u32x4 o; o.x = pk2(v0.x, v0.y); o.y = pk2(v0.z, v0.w); o.z = pk2(v1.x, v1.y); o.w = pk2(v1.z, v1.w);
                        *(u32x4*)(dst + (size_t)row * ld + (c8 - cbase)) = o;
                    } } }
    }
};

constexpr int XA_KS = 272, XA_VS = 320, XA_VOFF = 64 * XA_KS;
__device__ __forceinline__ void xattn_unit(const Args& P, int h, int qb, LAS char* lds) {
    unsigned char* ws = P.ws;
    const int tid = threadIdx.x, lane = tid & 63, w = __builtin_amdgcn_readfirstlane(tid >> 6), r32 = lane & 31, hi = lane >> 5;
    const bf16* QX = (const bf16*)(ws + WS_QX); const bf16* KVM = (const bf16*)(ws + WS_KVM); bf16* OX = (bf16*)(ws + WS_OX);
    const int q = 256 * qb + 32 * w + r32;
    bf16x8 qf[8];
#pragma unroll
    for (int ks = 0; ks < 8; ++ks) qf[ks] = *(const bf16x8*)(QX + (size_t)q * 512 + h * 128 + 16 * ks + 8 * hi);
    Flash<128> f; flash_init(f);
    for (int kt = 0; kt < 4; ++kt) {
#pragma unroll
        for (int i = 0; i < 2; ++i) { const int idx = tid + 512 * i, key = idx >> 4, c = idx & 15; const bf16* r = KVM + (size_t)(64 * kt + key) * 1024 + h * 128 + c * 8;
            *(LAS u32x4*)(lds + key * XA_KS + c * 16) = *(const u32x4*)r; *(LAS u32x4*)(lds + XA_VOFF + key * XA_VS + c * 16) = *(const u32x4*)(r + 512); }
        __syncthreads();
        flash_tile<128, 128, XA_KS, XA_VS, false>(f, qf, lds, lds + XA_VOFF, lane, true, [](f32x16&, f32x16&) {});
        __syncthreads();
    }
    const float l = sum_x32(f.l); const float inv = 1.f / l;
#pragma unroll
    for (int d = 0; d < 4; ++d)
#pragma unroll
        for (int r4 = 0; r4 < 4; ++r4) { u32x2 o; o.x = pk2(f.o[d][4 * r4] * inv, f.o[d][4 * r4 + 1] * inv); o.y = pk2(f.o[d][4 * r4 + 2] * inv, f.o[d][4 * r4 + 3] * inv);
            *(u32x2*)(OX + (size_t)q * 512 + h * 128 + 32 * d + 8 * r4 + 4 * hi) = o; }
}
__device__ __forceinline__ void phase0(const Args& a, LAS char* lds) {
    const int tid = threadIdx.x, lane = tid & 63, wave = __builtin_amdgcn_readfirstlane(tid >> 6); const int G = gridDim.x, bx = blockIdx.x;
    const int gw = bx * NWAVES + wave, NGW = G * NWAVES, gt = bx * 512 + tid, NGT = G * 512; unsigned char* ws = a.ws;
    LAS unsigned char* ring = (LAS unsigned char*)lds; LAS float* rtab = (LAS float*)(lds + RTAB_OFF);
    (void)lane; (void)gw; (void)NGW; (void)gt; (void)NGT; (void)ring; (void)rtab; (void)ws;
 p_prologue(a, lds, gw, NGW, gt, NGT);
        cvt_f32_bf16(a.in[25], (bf16*)(ws + WS_KEYB), 128 * 128, gt, NGT); cvt_f32_bf16(a.in[26], (bf16*)(ws + WS_KEYB) + 128 * 128, 128 * 128, gt, NGT);
}
__device__ __forceinline__ void phase1(const Args& a, LAS char* lds) {
    const int tid = threadIdx.x, lane = tid & 63, wave = __builtin_amdgcn_readfirstlane(tid >> 6); const int G = gridDim.x, bx = blockIdx.x;
    const int gw = bx * NWAVES + wave, NGW = G * NWAVES, gt = bx * 512 + tid, NGT = G * 512; unsigned char* ws = a.ws;
    LAS unsigned char* ring = (LAS unsigned char*)lds; LAS float* rtab = (LAS float*)(lds + RTAB_OFF);
    (void)lane; (void)gw; (void)NGW; (void)gt; (void)NGT; (void)ring; (void)rtab; (void)ws;

        { pg8::Gemm g{(const bf16*)(ws + WS_XN), (const bf16*)(ws + WS_W1T), S_, NZ, 2048}; pg8::StaticOrder S; S.init(S_, NZ, G, bx);
          EpiZ E{ws};
          pg8::gemm_phase<EpiZ, pg8::StaticOrder, true, true>(ring, g, S, E); }
        { pg8::Gemm g{(const bf16*)(ws + WS_MEMN), (const bf16*)(ws + WS_WXKV), MEML, 1024, 2048}; pg8::StaticOrder S; S.init(MEML, 1024, G, (bx + 4) % G);
          EpiFn<FStoreBf16> E{FStoreBf16{(bf16*)(ws + WS_KVM), 1024}};
          pg8::gemm_phase<EpiFn<FStoreBf16>, pg8::StaticOrder, false, true>(ring, g, S, E); }

}
__device__ __forceinline__ void phase2(const Args& a, LAS char* lds) {
    const int tid = threadIdx.x, lane = tid & 63, wave = __builtin_amdgcn_readfirstlane(tid >> 6); const int G = gridDim.x, bx = blockIdx.x;
    const int gw = bx * NWAVES + wave, NGW = G * NWAVES, gt = bx * 512 + tid, NGT = G * 512; unsigned char* ws = a.ws;
    LAS unsigned char* ring = (LAS unsigned char*)lds; LAS float* rtab = (LAS float*)(lds + RTAB_OFF);
    (void)lane; (void)gw; (void)NGW; (void)gt; (void)NGT; (void)ring; (void)rtab; (void)ws;

        for (int u = bx; u < 256; u += G) compress_unit(a, u, lds);
        for (int u = bx; u < 256; u += G) { const int h = u & 7, p = u >> 3; da_unit(a, h, 63 - p, lds); da_unit(a, h, p, lds); }

}
__device__ __forceinline__ void phase3(const Args& a, LAS char* lds) {
    const int tid = threadIdx.x, lane = tid & 63, wave = __builtin_amdgcn_readfirstlane(tid >> 6); const int G = gridDim.x, bx = blockIdx.x;
    const int gw = bx * NWAVES + wave, NGW = G * NWAVES, gt = bx * 512 + tid, NGT = G * 512; unsigned char* ws = a.ws;
    LAS unsigned char* ring = (LAS unsigned char*)lds; LAS float* rtab = (LAS float*)(lds + RTAB_OFF);
    (void)lane; (void)gw; (void)NGW; (void)gt; (void)NGT; (void)ring; (void)rtab; (void)ws;

        for (int u = bx; u < 256; u += G) { const int g = u & 3, p = u >> 2; nsa_unit(a, g, 127 - p, lds); nsa_unit(a, g, p, lds); }

}
__device__ __forceinline__ void phase4(const Args& a, LAS char* lds) {
    const int tid = threadIdx.x, lane = tid & 63, wave = __builtin_amdgcn_readfirstlane(tid >> 6); const int G = gridDim.x, bx = blockIdx.x;
    const int gw = bx * NWAVES + wave, NGW = G * NWAVES, gt = bx * 512 + tid, NGT = G * 512; unsigned char* ws = a.ws;
    LAS unsigned char* ring = (LAS unsigned char*)lds; LAS float* rtab = (LAS float*)(lds + RTAB_OFF);
    (void)lane; (void)gw; (void)NGW; (void)gt; (void)NGT; (void)ring; (void)rtab; (void)ws;

        pg8::StaticOrder S; S.init(S_, 2048, G, bx);
        { pg8::Gemm g{(const bf16*)(ws + WS_ODA), (const bf16*)(ws + WS_WBDA), S_, 2048, 1024};
          EpiFn<FGate0> E{FGate0{(bf16*)(ws + WS_MIX), (const bf16*)(ws + WS_BG)}};
          pg8::gemm_phase<EpiFn<FGate0>, pg8::StaticOrder, false, true>(ring, g, S, E); }
        asm volatile("s_waitcnt vmcnt(0)" ::: "memory"); __syncthreads();
        { pg8::Gemm g{(const bf16*)(ws + WS_ONSA), (const bf16*)(ws + WS_WBNSA), S_, 2048, 1024};
          EpiFn<FGate1> E{FGate1{(bf16*)(ws + WS_MIX), (const bf16*)(ws + WS_BG)}};
          pg8::gemm_phase<EpiFn<FGate1>, pg8::StaticOrder, false, true>(ring, g, S, E); }

}
__device__ __forceinline__ void phase5(const Args& a, LAS char* lds) {
    const int tid = threadIdx.x, lane = tid & 63, wave = __builtin_amdgcn_readfirstlane(tid >> 6); const int G = gridDim.x, bx = blockIdx.x;
    const int gw = bx * NWAVES + wave, NGW = G * NWAVES, gt = bx * 512 + tid, NGT = G * 512; unsigned char* ws = a.ws;
    LAS unsigned char* ring = (LAS unsigned char*)lds; LAS float* rtab = (LAS float*)(lds + RTAB_OFF);
    (void)lane; (void)gw; (void)NGW; (void)gt; (void)NGT; (void)ring; (void)rtab; (void)ws;

        pg8::Gemm g{(const bf16*)(ws + WS_MIX), (const bf16*)(ws + WS_WOUT), S_, 2048, 2048}; pg8::StaticOrder S; S.init(S_, 2048, G, bx);
        EpiResSS<false> E{a.in[0], (bf16*)(ws + WS_H1B), (float*)(ws + WS_SS1)};
        pg8::gemm_phase<EpiResSS<false>, pg8::StaticOrder, false, true>(ring, g, S, E);

}
__device__ __forceinline__ void phase6(const Args& a, LAS char* lds) {
    const int tid = threadIdx.x, lane = tid & 63, wave = __builtin_amdgcn_readfirstlane(tid >> 6); const int G = gridDim.x, bx = blockIdx.x;
    const int gw = bx * NWAVES + wave, NGW = G * NWAVES, gt = bx * 512 + tid, NGT = G * 512; unsigned char* ws = a.ws;
    LAS unsigned char* ring = (LAS unsigned char*)lds; LAS float* rtab = (LAS float*)(lds + RTAB_OFF);
    (void)lane; (void)gw; (void)NGW; (void)gt; (void)NGT; (void)ring; (void)rtab; (void)ws;

        pg8::Gemm g{(const bf16*)(ws + WS_H1B), (const bf16*)(ws + WS_WXQ), S_, 512, 2048}; pg8::StaticOrder S; S.init(S_, 512, G, bx);
        make_rtab(S, (const float*)(ws + WS_SS1), rtab);
        EpiFn<FRowScaleL> E{FRowScaleL{rtab, (bf16*)(ws + WS_QX), XSCALE, 512}};
        pg8::gemm_phase<EpiFn<FRowScaleL>, pg8::StaticOrder, false, true>(ring, g, S, E);
        if (bx >= 64) { const int w0 = (bx - 64) * NWAVES + wave, nw = (G - 64) * NWAVES;
            for (int r = w0; r < 2 * 16384; r += nw) { const int tb = r >= 16384, rr = r & 16383;
                quant_row(a.in[tb ? 28 : 27] + (size_t)rr * DM, ws + (tb ? WS_VQ : WS_UQ), rr, (float*)(ws + (tb ? WS_VSC : WS_USC)) + rr, lane, tb != 0); } }
}
__device__ __forceinline__ void phase7(const Args& a, LAS char* lds) {
    const int tid = threadIdx.x, lane = tid & 63, wave = __builtin_amdgcn_readfirstlane(tid >> 6); const int G = gridDim.x, bx = blockIdx.x;
    const int gw = bx * NWAVES + wave, NGW = G * NWAVES, gt = bx * 512 + tid, NGT = G * 512; unsigned char* ws = a.ws;
    LAS unsigned char* ring = (LAS unsigned char*)lds; LAS float* rtab = (LAS float*)(lds + RTAB_OFF);
    (void)lane; (void)gw; (void)NGW; (void)gt; (void)NGT; (void)ring; (void)rtab; (void)ws;

        for (int u = bx; u < 128; u += G) xattn_unit(a, u & 3, u >> 2, lds);

}
__device__ __forceinline__ void phase8(const Args& a, LAS char* lds) {
    const int tid = threadIdx.x, lane = tid & 63, wave = __builtin_amdgcn_readfirstlane(tid >> 6); const int G = gridDim.x, bx = blockIdx.x;
    const int gw = bx * NWAVES + wave, NGW = G * NWAVES, gt = bx * 512 + tid, NGT = G * 512; unsigned char* ws = a.ws;
    LAS unsigned char* ring = (LAS unsigned char*)lds; LAS float* rtab = (LAS float*)(lds + RTAB_OFF);
    (void)lane; (void)gw; (void)NGW; (void)gt; (void)NGT; (void)ring; (void)rtab; (void)ws;

        pg8::Gemm g{(const bf16*)(ws + WS_OX), (const bf16*)(ws + WS_WXO), S_, 2048, 512}; pg8::StaticOrder S; S.init(S_, 2048, G, bx);
        EpiResSS<true> E{ws + WS_H1B, (bf16*)(ws + WS_H2B), (float*)(ws + WS_SS2)};
        pg8::gemm_phase<EpiResSS<true>, pg8::StaticOrder, false, true>(ring, g, S, E);

}
__device__ __forceinline__ void phase9(const Args& a, LAS char* lds) {
    const int tid = threadIdx.x, lane = tid & 63, wave = __builtin_amdgcn_readfirstlane(tid >> 6); const int G = gridDim.x, bx = blockIdx.x;
    const int gw = bx * NWAVES + wave, NGW = G * NWAVES, gt = bx * 512 + tid, NGT = G * 512; unsigned char* ws = a.ws;
    LAS unsigned char* ring = (LAS unsigned char*)lds; LAS float* rtab = (LAS float*)(lds + RTAB_OFF);
    (void)lane; (void)gw; (void)NGW; (void)gt; (void)NGT; (void)ring; (void)rtab; (void)ws;

        pg8::Gemm g{(const bf16*)(ws + WS_H2B), (const bf16*)(ws + WS_WPQ), S_, 2048, 2048}; pg8::StaticOrder S; S.init(S_, 2048, G, bx);
        make_rtab(S, (const float*)(ws + WS_SS2), rtab);
        { pg8::Unit u; if (S.next(0, u) && tid < 256) ((float*)(ws + WS_R2))[u.pm * 256 + tid] = rtab[tid]; }
        EpiFn<FRowScaleL> E{FRowScaleL{rtab, (bf16*)(ws + WS_PQ), 1.0f, 2048}};
        pg8::gemm_phase<EpiFn<FRowScaleL>, pg8::StaticOrder, false, true>(ring, g, S, E);

}
__device__ __forceinline__ void phase10(const Args& a, LAS char* lds) { const int wave = __builtin_amdgcn_readfirstlane(threadIdx.x >> 6); p_peer_a(a, lds, blockIdx.x * NWAVES + wave, gridDim.x * NWAVES); }
__device__ __forceinline__ void phase11(const Args& a, LAS char* lds) { p_peer_b(a, lds); }
__device__ __forceinline__ void phase12(const Args& a, LAS char* lds) {
#ifdef MK_FAKEMASK
    p_peer_d<MK_FAKEMASK>(a, lds);
#endif
    p_peer_d<0xffffu>(a, lds); }
__device__ __forceinline__ void phase13(const Args& a, LAS char* lds) { p_peer_e(a, lds); }
#ifndef MK_DOUBLE
#define MK_DOUBLE 0
#endif
#ifndef MK_SPLIT
#define MK_SPLIT 0
#endif
constexpr int NPHASE = 14;
__global__ void __launch_bounds__(NWAVES * 64, 2) mk_fwd(Args a) {
    extern __shared__ __attribute__((aligned(16))) unsigned char lds_raw[];
    LAS char* lds = (LAS char*)lds_raw;
    const int tid = threadIdx.x, lane = tid & 63, wave = __builtin_amdgcn_readfirstlane(tid >> 6);
    const int G = gridDim.x, bx = blockIdx.x;
    unsigned char* ws = a.ws;
    for (int u = tid; u < (LDS_BYTES - LDSCTL_OFF) / 4; u += NWAVES * 64) ((LAS unsigned*)(lds + LDSCTL_OFF))[u] = 0u;
    __syncthreads();
    unsigned* ctl = (unsigned*)(ws + WS_CTL);
    XcdBarrier bar; bar.bar = ctl + CW_BAR; bar.x = 0; bar.st = nullptr;
    if (!MK_SPLIT) bar = xcd_barrier_post(ctl + CW_BAR, (volatile LAS unsigned*)(lds + MISC_OFF) + 8);
    const int lo = a.ph_lo, hi = a.ph_hi;
#define IN(k) (lo <= (k) && (k) < hi)
#define SEAM(k) do { if (IN(k) && IN((k) + 1)) xcd_barrier(bar); } while (0)

    if (IN(0)) { phase0(a, lds); if (MK_DOUBLE & (1 << 0)) { xcd_barrier(bar); phase0(a, lds); } }
    SEAM(0);
    if (IN(1)) { phase1(a, lds); if (MK_DOUBLE & (1 << 1)) { xcd_barrier(bar); phase1(a, lds); } }
    SEAM(1);
    if (IN(2)) { phase2(a, lds); if (MK_DOUBLE & (1 << 2)) { xcd_barrier(bar); phase2(a, lds); } }
    SEAM(2);
    if (IN(3)) { phase3(a, lds); if (MK_DOUBLE & (1 << 3)) { xcd_barrier(bar); phase3(a, lds); } }
    SEAM(3);
    if (IN(4)) { phase4(a, lds); if (MK_DOUBLE & (1 << 4)) { xcd_barrier(bar); phase4(a, lds); } }
    SEAM(4);
    if (IN(5)) { phase5(a, lds); if (MK_DOUBLE & (1 << 5)) { xcd_barrier(bar); phase5(a, lds); } }
    SEAM(5);
    if (IN(6)) { phase6(a, lds); if (MK_DOUBLE & (1 << 6)) { xcd_barrier(bar); phase6(a, lds); } }
    SEAM(6);
    if (IN(7)) { phase7(a, lds); if (MK_DOUBLE & (1 << 7)) { xcd_barrier(bar); phase7(a, lds); } }
    SEAM(7);
    if (IN(8)) { phase8(a, lds); if (MK_DOUBLE & (1 << 8)) { xcd_barrier(bar); phase8(a, lds); } }
    SEAM(8);
    if (IN(9)) { phase9(a, lds); if (MK_DOUBLE & (1 << 9)) { xcd_barrier(bar); phase9(a, lds); } }
    SEAM(9);
    if (IN(10)) { phase10(a, lds); if (MK_DOUBLE & (1 << 10)) { xcd_barrier(bar); phase10(a, lds); } }
    SEAM(10);
    if (IN(11)) { phase11(a, lds); if (MK_DOUBLE & (1 << 11)) { xcd_barrier(bar); phase11(a, lds); } }
    SEAM(11);
    if (IN(12)) { phase12(a, lds); if (MK_DOUBLE & (1 << 12)) { xcd_barrier(bar); phase12(a, lds); } }
    SEAM(12);
    if (IN(13)) { phase13(a, lds); if (MK_DOUBLE & (1 << 13)) { xcd_barrier(bar); phase13(a, lds); } }
#undef IN
#undef SEAM
}

extern "C" void kernel_launch(void* const* d_in, const int* in_sizes, int n_in, void* d_out, int out_size, void* d_ws, size_t ws_size, hipStream_t stream) {
    static int grid = 0;
    if (grid == 0) {
        if (n_in != 30 || ws_size < WS_END || out_size != S_ * DM) { fprintf(stderr, "kernel_launch: unexpected n_in %d / ws %zu / out %d\n", n_in, ws_size, out_size); grid = -1; return; }
        int dev = 0, cus = 0, per_cu = 0;
        if (hipGetDevice(&dev) != hipSuccess || hipDeviceGetAttribute(&cus, hipDeviceAttributeMultiprocessorCount, dev) != hipSuccess) { grid = -1; return; }
        if (hipFuncSetAttribute((const void*)mk_fwd, hipFuncAttributeMaxDynamicSharedMemorySize, LDS_BYTES) != hipSuccess) { fprintf(stderr, "kernel_launch: hipFuncSetAttribute failed\n"); grid = -1; return; }
        if (hipOccupancyMaxActiveBlocksPerMultiprocessor(&per_cu, (const void*)mk_fwd, NWAVES * 64, LDS_BYTES) != hipSuccess || per_cu < 1) { fprintf(stderr, "kernel_launch: occupancy query says %d blocks per CU\n", per_cu); }
        (void)hipGetLastError();
        grid = cus;
        if (grid != 256) { fprintf(stderr, "kernel_launch: built for a 256-CU device, found %d CUs\n", cus); grid = -1; return; }
    }
    if (grid < 0) return;
    (void)hipMemsetAsync((char*)d_ws + WS_CTL, 0, 1 * MiB, stream);
    Args a; memset(&a, 0, sizeof(a));
    for (int i = 0; i < 30; ++i) a.in[i] = (const float*)d_in[i];
    a.out = (float*)d_out; a.ws = (unsigned char*)d_ws;
#if MK_SPLIT
    for (int p = 0; p < NPHASE; ++p) { a.ph_lo = p; a.ph_hi = p + 1; hipLaunchKernelGGL(mk_fwd, dim3(grid), dim3(NWAVES * 64), LDS_BYTES, stream, a); }
#else
    a.ph_lo = 0; a.ph_hi = NPHASE;
    hipLaunchKernelGGL(mk_fwd, dim3(grid), dim3(NWAVES * 64), LDS_BYTES, stream, a);
#endif
}
```

```cpp
#include <hip/hip_runtime.h>
#include <cstdio>
#include <cstdint>
#include <cmath>
#include <cstring>
namespace pg8 {
#define PG8_LAS __attribute__((address_space(3)))
typedef unsigned short bf16_t;
typedef short bf16x8 __attribute__((ext_vector_type(8)));
typedef float f32x4 __attribute__((ext_vector_type(4)));
typedef unsigned u32x4 __attribute__((ext_vector_type(4)));
constexpr int BM = 256, BK = 64, HALF = 128, HTB = HALF * BK * 2  , STAGE_BYTES = 8 * HTB, NXCD = 8, WGM = 8;

__host__ __device__ __forceinline__ int lds_byte(int r, int c) { const int st = (r >> 4) * 2 + (c >> 5), rr = r & 15, cc = c & 31, ob = rr * 64 + cc * 2; return st * 1024 + (ob ^ (((ob >> 9) & 1) << 5)); }
__host__ __device__ __forceinline__ void stage_rc(int b, int& R, int& C) { const int st = b / 1024, sb = b % 1024, swz = sb ^ (((sb >> 9) & 1) << 5); R = (st >> 1) * 16 + swz / 64; C = (st & 1) * 32 + (swz % 64) / 2; }
__host__ __device__ __forceinline__ int perm32(int rho) { const int n = rho >> 4, i = rho & 15; return 8 * (i >> 2) + 4 * n + (i & 3); }

struct Unit { int pm, pn; };
struct Gemm { const bf16_t* A; const bf16_t* Bt; int M, N, K; };

struct StaticOrder {
    int nM, nN, nwg, G, c;
    __host__ __device__ __forceinline__ void init(int M, int N, int G_, int c_) { nM = M / BM; nN = N / BM; nwg = nM * nN; G = G_; c = c_; }
    __host__ __device__ __forceinline__ bool next(int i, Unit& u) const {
        const long L = (long)i * G + c; if (L >= nwg) return false;
        int wgid = (int)L; { const int q = nwg / NXCD, r = nwg % NXCD, xcd = wgid % NXCD, off = wgid / NXCD; wgid = (xcd < r ? xcd * (q + 1) : r * (q + 1) + (xcd - r) * q) + off; }
        const int nig = WGM * nN, gid = wgid / nig, fm = gid * WGM, gsz = (nM - fm) < WGM ? (nM - fm) : WGM;
        u.pm = fm + ((wgid % nig) % gsz); u.pn = (wgid % nig) / gsz; return true;
    }
    __device__ __forceinline__ void a_ready(const Unit&) const {}
    __device__ __forceinline__ void done(const Unit&) const {}
};

__device__ __forceinline__ unsigned cvt_pk_bf16(float lo, float hi) { unsigned r; asm volatile("v_cvt_pk_bf16_f32 %0, %1, %2" : "=v"(r) : "v"(lo), "v"(hi)); return r; }
typedef float f32x2 __attribute__((ext_vector_type(2)));
__device__ __forceinline__ f32x2 gelu_pk(f32x2 v) {
    const f32x2 av = __builtin_elementwise_abs(v), d = av * 0.2316418882f + 1.0f;
    f32x2 t; t.x = __builtin_amdgcn_rcpf(d.x); t.y = __builtin_amdgcn_rcpf(d.y);
    f32x2 q = t * 0.5307027145f + (-0.7265760135f); q = q * t + 0.7107068705f; q = q * t + (-0.142248368f); q = q * t + 0.127414796f; q = q * t;
    const f32x2 s = (v * v) * (-0.72134752044f);
    f32x2 e; e.x = __builtin_amdgcn_exp2f(s.x); e.y = __builtin_amdgcn_exp2f(s.y);
    const f32x2 m = v * (q * e), r = v - m;
    f32x2 o; o.x = v.x < 0.f ? m.x : r.x; o.y = v.y < 0.f ? m.y : r.y; return o;
}

template <class Epi, class Sched, bool ALIGN_EPI = false, bool SP2 = false>
__device__ __forceinline__ void gemm_phase(PG8_LAS unsigned char* lds, const Gemm g, const Sched& S, const Epi& E) {
    const int tid = threadIdx.x, wid = __builtin_amdgcn_readfirstlane(tid >> 6), lane = tid & 63, wr = wid >> 2, wc = wid & 3, fr = lane & 15, fq = lane >> 4;
    const int K = g.K, nt = K / BK;
    unsigned voffA[2], voffB[2];
#pragma unroll
    for (int i = 0; i < 2; ++i) { int R, C; stage_rc(tid * 16 + i * 8192, R, C); const int Rb = Epi::PERM ? ((R & ~31) + perm32(R & 31)) : R;
        voffA[i] = (unsigned)(R * K + C) * 2u; voffB[i] = (unsigned)(Rb * K + C) * 2u; }
    const size_t kstep = (size_t)(BK * 2);
    const size_t hstep = (size_t)HALF * K * 2;
    const size_t tstep = 2 * hstep;
    const unsigned ldsw = (unsigned)wid * 1024u;
    const int aoff = lds_byte(wr * 64 + fr, fq * 8), boff = lds_byte(wc * 32 + fr, fq * 8);
#define PG8_SA(b, h) (((b) * 2 + (h)) * HTB)
#define PG8_SB(b, h) ((4 + (b) * 2 + (h)) * HTB)
#define PG8_STAGE(bufoff, gbase, voff) do { _Pragma("unroll") for (int _i = 0; _i < 2; ++_i) \
        __builtin_amdgcn_global_load_lds((const unsigned*)((const char*)(gbase) + (voff)[_i]), (PG8_LAS unsigned*)(lds + (bufoff) + ldsw + _i * 8192), 16, 0, 0); } while (0)
#define PG8_LDA(dst, b, h) do { _Pragma("unroll") for (int m = 0; m < 4; ++m) _Pragma("unroll") for (int k = 0; k < 2; ++k) dst[m][k] = *(const PG8_LAS bf16x8*)(lds + PG8_SA(b, h) + aoff + m * 2048 + k * 1024); } while (0)
#define PG8_LDB(dst, b, h) do { _Pragma("unroll") for (int n = 0; n < 2; ++n) _Pragma("unroll") for (int k = 0; k < 2; ++k) dst[n][k] = *(const PG8_LAS bf16x8*)(lds + PG8_SB(b, h) + boff + n * 2048 + k * 1024); } while (0)
#define PG8_MMA(ai, bj, At, Bt) do { __builtin_amdgcn_s_setprio(1); _Pragma("unroll") for (int m = 0; m < 4; ++m) _Pragma("unroll") for (int n = 0; n < 2; ++n) _Pragma("unroll") for (int k = 0; k < 2; ++k) \
        acc[ai][bj][m][n] = __builtin_amdgcn_mfma_f32_16x16x32_bf16(Bt[n][k], At[m][k], acc[ai][bj][m][n], 0, 0, 0); __builtin_amdgcn_s_setprio(0); } while (0)
#define PG8_WAIT_V(n) asm volatile("s_waitcnt vmcnt(" #n ")" ::: "memory")
#define PG8_WAIT_L(n) asm volatile("s_waitcnt lgkmcnt(" #n ")" ::: "memory")
#define PG8_BAR __builtin_amdgcn_s_barrier()
#define PG8_SCHED __builtin_amdgcn_sched_barrier(0)
    Unit cur, nxt; int ui = 0;
    if (!S.next(0, cur)) return;
    f32x4 acc[2][2][4][2];
#pragma unroll
    for (int a = 0; a < 2; ++a)
#pragma unroll
        for (int b = 0; b < 2; ++b)
#pragma unroll
            for (int m = 0; m < 4; ++m)
#pragma unroll
                for (int n = 0; n < 2; ++n) acc[a][b][m][n] = (f32x4){0.f, 0.f, 0.f, 0.f};
    bf16x8 At[4][2], B0[2][2], B1[2][2];
    const char* cA = (const char*)g.A + (size_t)cur.pm * tstep; const char* cB = (const char*)g.Bt + (size_t)cur.pn * tstep;
    S.a_ready(cur);
    if constexpr (SP2) {
        PG8_STAGE(PG8_SB(0, 0), cB, voffB); PG8_STAGE(PG8_SB(0, 1), cB + hstep, voffB); PG8_STAGE(PG8_SA(0, 0), cA, voffA); PG8_STAGE(PG8_SA(0, 1), cA + hstep, voffA);
        if (wr == 1) PG8_BAR;
        PG8_WAIT_V(2); PG8_BAR;
        PG8_STAGE(PG8_SB(1, 0), cB + kstep, voffB); PG8_STAGE(PG8_SA(1, 0), cA + kstep, voffA); PG8_STAGE(PG8_SB(1, 1), cB + hstep + kstep, voffB);
        PG8_WAIT_V(6); PG8_BAR;
    } else {
        PG8_STAGE(PG8_SB(0, 0), cB, voffB); PG8_STAGE(PG8_SA(0, 0), cA, voffA); PG8_STAGE(PG8_SB(0, 1), cB + hstep, voffB); PG8_STAGE(PG8_SA(0, 1), cA + hstep, voffA);
        if (wr == 1) PG8_BAR;
        PG8_WAIT_V(4); PG8_BAR;
        PG8_STAGE(PG8_SB(1, 0), cB + kstep, voffB); PG8_STAGE(PG8_SA(1, 0), cA + kstep, voffA); PG8_STAGE(PG8_SB(1, 1), cB + hstep + kstep, voffB);
        PG8_WAIT_V(6); PG8_BAR;
    }
    for (;;) {
        const bool has_next = S.next(ui + 1, nxt);
        const char* nA = has_next ? (const char*)g.A + (size_t)nxt.pm * tstep : cA; const char* nB = has_next ? (const char*)g.Bt + (size_t)nxt.pn * tstep : cB;
        for (int t = 0; t < nt; t += 2) {
            const bool last = (t == nt - 2);
            const char* a1 = cA + (size_t)(t + 1) * kstep;
            const char* a2 = last ? nA : cA + (size_t)(t + 2) * kstep; const char* b2 = last ? nB : cB + (size_t)(t + 2) * kstep;
            const char* a3 = a2 + kstep; const char* b3 = b2 + kstep;
            if (last && has_next) S.a_ready(nxt);
            if constexpr (SP2) {
            PG8_LDB(B0, 0, 0); PG8_LDB(B1, 0, 1); PG8_SCHED; PG8_LDA(At, 0, 0); PG8_STAGE(PG8_SA(1, 1), a1 + hstep, voffA);
            PG8_WAIT_V(8); PG8_WAIT_L(0); PG8_BAR; PG8_MMA(0, 0, At, B0); PG8_MMA(0, 1, At, B1); PG8_BAR; PG8_SCHED;
            PG8_LDA(At, 0, 1); PG8_STAGE(PG8_SB(0, 0), b2, voffB); PG8_STAGE(PG8_SB(0, 1), b2 + hstep, voffB); PG8_STAGE(PG8_SA(0, 0), a2, voffA);
            PG8_WAIT_V(8); PG8_WAIT_L(0); PG8_BAR; PG8_MMA(1, 0, At, B0); PG8_MMA(1, 1, At, B1); PG8_BAR; PG8_SCHED;
            PG8_LDB(B0, 1, 0); PG8_LDB(B1, 1, 1); PG8_SCHED; PG8_LDA(At, 1, 0); PG8_STAGE(PG8_SA(0, 1), a2 + hstep, voffA);
            PG8_WAIT_V(8); PG8_WAIT_L(0); PG8_BAR; PG8_MMA(0, 0, At, B0); PG8_MMA(0, 1, At, B1); PG8_BAR; PG8_SCHED;
            PG8_LDA(At, 1, 1); PG8_STAGE(PG8_SB(1, 0), b3, voffB); PG8_STAGE(PG8_SB(1, 1), b3 + hstep, voffB); PG8_STAGE(PG8_SA(1, 0), a3, voffA);
            PG8_WAIT_V(8); PG8_WAIT_L(0); PG8_BAR; PG8_MMA(1, 0, At, B0); PG8_MMA(1, 1, At, B1); PG8_BAR; PG8_SCHED;
            } else {
            PG8_LDB(B0, 0, 0); PG8_SCHED; PG8_LDA(At, 0, 0); PG8_STAGE(PG8_SA(1, 1), a1 + hstep, voffA);
            PG8_WAIT_L(8); PG8_BAR; PG8_WAIT_L(0); PG8_MMA(0, 0, At, B0); PG8_BAR; PG8_SCHED;
            PG8_LDB(B1, 0, 1); PG8_STAGE(PG8_SB(0, 0), b2, voffB);
            PG8_BAR; PG8_WAIT_L(0); PG8_MMA(0, 1, At, B1); PG8_BAR;
            PG8_LDA(At, 0, 1); PG8_STAGE(PG8_SA(0, 0), a2, voffA);
            PG8_BAR; PG8_WAIT_L(0); PG8_MMA(1, 0, At, B0); PG8_BAR; PG8_SCHED;
            PG8_STAGE(PG8_SB(0, 1), b2 + hstep, voffB);
            PG8_WAIT_V(6); PG8_BAR; PG8_MMA(1, 1, At, B1); PG8_BAR;
            PG8_LDB(B0, 1, 0); PG8_SCHED; PG8_LDA(At, 1, 0); PG8_STAGE(PG8_SA(0, 1), a2 + hstep, voffA);
            PG8_WAIT_L(8); PG8_BAR; PG8_WAIT_L(0); PG8_MMA(0, 0, At, B0); PG8_BAR; PG8_SCHED;
            PG8_LDB(B1, 1, 1); PG8_STAGE(PG8_SB(1, 0), b3, voffB);
            PG8_BAR; PG8_WAIT_L(0); PG8_MMA(0, 1, At, B1); PG8_BAR;
            PG8_LDA(At, 1, 1); PG8_STAGE(PG8_SA(1, 0), a3, voffA);
            PG8_BAR; PG8_WAIT_L(0); PG8_MMA(1, 0, At, B0); PG8_BAR; PG8_SCHED;
            PG8_STAGE(PG8_SB(1, 1), b3 + hstep, voffB);
            PG8_WAIT_V(6); PG8_BAR; PG8_MMA(1, 1, At, B1); PG8_BAR;
            }
        }
        if constexpr (ALIGN_EPI) { if (wr == 0) PG8_BAR; }
        if constexpr (!Epi::AFTER_DRAIN) { E(acc, cur, wr, wc, fr, fq); S.done(cur); }
        if (!has_next) break;
#pragma unroll
        for (int a = 0; a < 2; ++a)
#pragma unroll
            for (int b = 0; b < 2; ++b)
#pragma unroll
                for (int m = 0; m < 4; ++m)
#pragma unroll
                    for (int n = 0; n < 2; ++n) acc[a][b][m][n] = (f32x4){0.f, 0.f, 0.f, 0.f};
        cur = nxt; cA = nA; cB = nB; ++ui;
        if constexpr (ALIGN_EPI) { if (wr == 1) PG8_BAR; }
    }
    PG8_WAIT_V(0);
    if constexpr (!ALIGN_EPI) { if (wr == 0) PG8_BAR; }
    PG8_BAR;
    if constexpr (Epi::AFTER_DRAIN) { E.fused(acc, cur, wr, wc, fr, fq, lds, wid, lane); S.done(cur); }
#undef PG8_SA
#undef PG8_SB
#undef PG8_STAGE
#undef PG8_LDA
#undef PG8_LDB
#undef PG8_MMA
#undef PG8_WAIT_V
#undef PG8_WAIT_L
#undef PG8_BAR
#undef PG8_SCHED
}
}
typedef unsigned short bf16;
typedef float f32x4 __attribute__((ext_vector_type(4)));
typedef unsigned u32x4 __attribute__((ext_vector_type(4)));
typedef unsigned u32x2 __attribute__((ext_vector_type(2)));
#define LAS __attribute__((address_space(3)))
constexpr int S_ = 8192, DM = 2048, MEML = 256;
constexpr int NZ = 9984;
constexpr float EPS = 1e-6f;
constexpr float LOG2E = 1.4426950408889634f;
constexpr float QSCALE = 0.125f * LOG2E;
constexpr float XSCALE = 0.08838834764831845f * LOG2E;
constexpr float LAMBDA_INIT = 0.2f;

constexpr size_t MiB = 1u << 20;
constexpr size_t WS_CTL = 0;
constexpr size_t WS_COS = 1 * MiB, WS_SIN = WS_COS + 256 * 1024, WS_SCAL = WS_SIN + 256 * 1024, WS_CPOS = WS_SCAL + 1024, WS_R1 = WS_SCAL + 4096, WS_R2 = WS_R1 + 32768;
constexpr size_t WS_SS1 = 2 * MiB, WS_SS2 = WS_SS1 + 256 * 1024, WS_KC = WS_SS2 + 256 * 1024, WS_VC = WS_KC + 256 * 1024;
constexpr size_t WS_KVM = 3 * MiB, WS_MEMN = WS_KVM + 512 * 1024;
constexpr size_t WS_NG = 5 * MiB, WS_KEYB = 7 * MiB, WS_USC = WS_KEYB + 128 * 1024, WS_VSC = WS_USC + 64 * 1024;
constexpr size_t WS_W1T = 8 * MiB, WS_WBDA = 47 * MiB, WS_WBNSA = 51 * MiB, WS_WOUT = 55 * MiB, WS_WXQ = 63 * MiB, WS_WXKV = 65 * MiB, WS_WXO = 69 * MiB, WS_WPQ = 71 * MiB, WS_W1C = 79 * MiB;
constexpr size_t WS_XN = 80 * MiB, WS_ODA = 80 * MiB, WS_ONSA = 96 * MiB;
constexpr size_t WS_Z = 112 * MiB, WS_UQ = 112 * MiB, WS_VQ = 144 * MiB, WS_MIX = 240 * MiB, WS_H1 = 420 * MiB;
constexpr size_t WS_QDA = 268 * MiB, WS_KDA = 284 * MiB, WS_VDA = 300 * MiB, WS_NQ = 316 * MiB, WS_KV6 = 332 * MiB, WS_BG = 356 * MiB;
constexpr size_t WS_H1B = 272 * MiB, WS_QX = 304 * MiB, WS_OX = 312 * MiB, WS_H2 = 320 * MiB, WS_H2B = 384 * MiB, WS_PQ = 416 * MiB, WS_END = 484 * MiB;

__device__ __forceinline__ float bf2f(unsigned short v) { return __uint_as_float(((unsigned)v) << 16); }
__device__ __forceinline__ unsigned short f2bf(float f) { unsigned u = __float_as_uint(f); return (unsigned short)((u + 0x7fffu + ((u >> 16) & 1u)) >> 16); }
__device__ __forceinline__ unsigned pk2(float lo, float hi) { return (unsigned)f2bf(lo) | ((unsigned)f2bf(hi) << 16); }
template <int CTRL> __device__ __forceinline__ float dppf(float v) { return __uint_as_float(__builtin_amdgcn_mov_dpp(__float_as_uint(v), CTRL, 0xF, 0xF, true)); }
template <int CTRL> __device__ __forceinline__ int dppi(int v) { return __builtin_amdgcn_mov_dpp(v, CTRL, 0xF, 0xF, true); }
constexpr int DPP_X1 = 0xB1, DPP_X2 = 0x4E, DPP_HMIR = 0x141, DPP_MIR = 0x140;
__device__ __forceinline__ float sum_x32(float v) { auto r = __builtin_amdgcn_permlane32_swap(__float_as_uint(v), __float_as_uint(v), false, false); return __uint_as_float(r[0]) + __uint_as_float(r[1]); }
__device__ __forceinline__ float max_x32(float v) { auto r = __builtin_amdgcn_permlane32_swap(__float_as_uint(v), __float_as_uint(v), false, false); return fmaxf(__uint_as_float(r[0]), __uint_as_float(r[1])); }
__device__ __forceinline__ float sum_x16(float v) { auto r = __builtin_amdgcn_permlane16_swap(__float_as_uint(v), __float_as_uint(v), false, false); return __uint_as_float(r[0]) + __uint_as_float(r[1]); }
__device__ __forceinline__ float max_x16(float v) { auto r = __builtin_amdgcn_permlane16_swap(__float_as_uint(v), __float_as_uint(v), false, false); return fmaxf(__uint_as_float(r[0]), __uint_as_float(r[1])); }
__device__ __forceinline__ float wave_sum(float v) {
    v += dppf<DPP_X1>(v); v += dppf<DPP_X2>(v); v += dppf<DPP_HMIR>(v); v += dppf<DPP_MIR>(v);
    return sum_x32(sum_x16(v));
}
__device__ __forceinline__ float wave_max(float v) {
    v = fmaxf(v, dppf<DPP_X1>(v)); v = fmaxf(v, dppf<DPP_X2>(v)); v = fmaxf(v, dppf<DPP_HMIR>(v)); v = fmaxf(v, dppf<DPP_MIR>(v));
    return max_x32(max_x16(v));
}
__device__ __forceinline__ float gelu_exact(float x) { return 0.5f * x * (1.0f + erff(x * 0.70710678118654752f)); }
__device__ __forceinline__ float sigmoidf_(float x) { return 1.0f / (1.0f + __expf(-x)); }

struct Ptrs { const float* in[30]; float* out; unsigned char* ws; };

__device__ __forceinline__ int zmap(int n) { return n < 5632 ? n : (n < 9728 ? n + 48 : (n < 9776 ? n - 9728 + 5632 : -1)); }

struct TrItem { const float* W; bf16* WT; const float* gk; int K, Nsrc, kb, nb; bool zmap, kblk; };
__device__ __forceinline__ void tr_load(const TrItem& t, int lane, f32x4 (&v)[8]) {
    const int k0 = 64 * t.kb, n0 = 32 * t.nb, r8 = lane >> 3, c4 = (lane & 7) * 4;
    const int sc = t.zmap ? zmap(n0 + c4) : n0 + c4;
#pragma unroll
    for (int i = 0; i < 8; ++i) { const int kk = 8 * i + r8; v[i] = (f32x4){0.f, 0.f, 0.f, 0.f}; if (sc >= 0) { v[i] = *(const f32x4*)(t.W + (size_t)(k0 + kk) * t.Nsrc + sc); if (t.gk) v[i] = v[i] * t.gk[k0 + kk]; } }
}
__device__ __forceinline__ void tr_finish(const TrItem& t, int lane, const f32x4 (&v)[8], LAS float* scr) {
    const int k0 = 64 * t.kb, n0 = 32 * t.nb, r8 = lane >> 3, c4 = (lane & 7) * 4;
#pragma unroll
    for (int i = 0; i < 8; ++i) { const int kk = 8 * i + r8; scr[kk * 33 + c4] = v[i].x; scr[kk * 33 + c4 + 1] = v[i].y; scr[kk * 33 + c4 + 2] = v[i].z; scr[kk * 33 + c4 + 3] = v[i].w; }
    asm volatile("s_waitcnt lgkmcnt(0)" ::: "memory");
    const int c = lane & 7;
#pragma unroll
    for (int j = 0; j < 4; ++j) { const int n = (lane >> 3) + 8 * j; const LAS float* s = scr + (8 * c) * 33 + n;
        u32x4 o; o.x = pk2(s[0 * 33], s[1 * 33]); o.y = pk2(s[2 * 33], s[3 * 33]); o.z = pk2(s[4 * 33], s[5 * 33]); o.w = pk2(s[6 * 33], s[7 * 33]);
        const int kq = k0 + 8 * c; bf16* dp = t.kblk ? t.WT + ((size_t)(kq >> 5) * 128 + (n0 + n)) * 32 + (kq & 31) : t.WT + (size_t)(n0 + n) * t.K + kq;
        *(u32x4*)dp = o; }
    asm volatile("s_waitcnt lgkmcnt(0)" ::: "memory");
}
__device__ __forceinline__ void rms_row_to_bf16(const float* xrow, const float* g, bf16* orow, int lane) {
    const f32x4* xr = (const f32x4*)xrow + lane; const f32x4* gr = (const f32x4*)g + lane;
    f32x4 v[8]; float s = 0.f;
#pragma unroll
    for (int j = 0; j < 8; ++j) { v[j] = xr[64 * j]; s += (v[j].x * v[j].x + v[j].y * v[j].y) + (v[j].z * v[j].z + v[j].w * v[j].w); }
    const float r = rsqrtf(wave_sum(s) * (1.f / DM) + EPS);
    u32x2* o8 = (u32x2*)orow + lane;
#pragma unroll
    for (int j = 0; j < 8; ++j) { const f32x4 gg = gr[64 * j]; u32x2 w; w.x = pk2(v[j].x * r * gg.x, v[j].y * r * gg.y); w.y = pk2(v[j].z * r * gg.z, v[j].w * r * gg.w); o8[64 * j] = w; }
}
#define XB_TMO      128
#define XB_XCNT(j)  (256  + 64 * (j))
#define XB_XSUB(j)  (1280 + 64 * (j))
#define XB_XGEN(j)  (2304 + 64 * (j))
#define XB_TOP      3328
#define XB_TOPGEN   3392
#define XCD_BAR_WORDS 3456
#define XB_SPIN_CAP (1u << 18)

__device__ __forceinline__ unsigned xb_ld(unsigned* p)              { return __hip_atomic_load(p, __ATOMIC_RELAXED, __HIP_MEMORY_SCOPE_AGENT); }
__device__ __forceinline__ unsigned xb_add(unsigned* p, unsigned v) { return __hip_atomic_fetch_add(p, v, __ATOMIC_RELAXED, __HIP_MEMORY_SCOPE_AGENT); }
__device__ __forceinline__ unsigned xb_xcc_id() { return (unsigned)__builtin_amdgcn_s_getreg((3 << 11) | 20) & 0xFu; }
#define XB_SPIN(cond, bar) do { unsigned _sp = 0; while (cond) { __builtin_amdgcn_s_sleep(1); \
    if ((++_sp & 255u) == 0u) { if (xb_ld(&(bar)[XB_TMO])) break; if (_sp > XB_SPIN_CAP) { atomicAdd(&(bar)[XB_TMO], 1u); break; } } } } while (0)

struct XcdBarrier {
    unsigned* bar; unsigned x;
    volatile LAS unsigned* st;
};

__device__ __forceinline__ XcdBarrier xcd_barrier_post(unsigned* bar, volatile LAS unsigned* st) {
    XcdBarrier b; b.bar = bar; b.x = xb_xcc_id(); b.st = st;
    if (threadIdx.x == 0) (void)xb_add(&bar[XB_XCNT(b.x)], 1u);
    return b;
}
__device__ __forceinline__ void xcd_barrier_complete(unsigned* bar, unsigned x, unsigned& nloc, unsigned& nx) {
    const unsigned G = gridDim.x * gridDim.y * gridDim.z;
    unsigned sum, cnt, mine, sp = 0u;
    for (;;) {
        sum = 0u; cnt = 0u; mine = 0u;
#pragma unroll
        for (unsigned j = 0; j < 16; ++j) { const unsigned c = xb_ld(&bar[XB_XCNT(j)]); sum += c; cnt += (c > 0u) ? 1u : 0u; mine = (j == x) ? c : mine; }
        if (sum == G) break;
        __builtin_amdgcn_s_sleep(1);
        if ((++sp & 255u) == 0u) { if (xb_ld(&bar[XB_TMO])) break; if (sp > XB_SPIN_CAP) { atomicAdd(&bar[XB_TMO], 1u); break; } }
    }
    nloc = mine > 0u ? mine : 1u; nx = cnt > 0u ? cnt : 1u;
}

__device__ __forceinline__ void xcd_barrier(const XcdBarrier& b) {
    asm volatile("s_waitcnt vmcnt(0)" ::: "memory");
    __syncthreads();
    if (threadIdx.x == 0) {
        unsigned* bar = b.bar;
        __builtin_amdgcn_s_waitcnt(0);
        unsigned nloc = b.st[0], nx = b.st[1];
        if (nloc == 0u) { xcd_barrier_complete(bar, b.x, nloc, nx); b.st[0] = nloc; b.st[1] = nx; }
        const unsigned old = xb_add(&bar[XB_XSUB(b.x)], 1u);
        const unsigned gen = old / nloc;
        if (old + 1u == (gen + 1u) * nloc) {
            __builtin_amdgcn_fence(__ATOMIC_RELEASE, "agent");
            asm volatile("s_waitcnt vmcnt(0)" ::: "memory");
            const unsigned og = xb_add(&bar[XB_TOP], 1u);
            const unsigned tg = og / nx;
            if (og + 1u == (tg + 1u) * nx) xb_add(&bar[XB_TOPGEN], 1u);
            else XB_SPIN(xb_ld(&bar[XB_TOPGEN]) == tg, bar);
            __builtin_amdgcn_fence(__ATOMIC_ACQUIRE, "agent");
            xb_add(&bar[XB_XGEN(b.x)], 1u);
            asm volatile("s_waitcnt vmcnt(0)" ::: "memory");
        } else {
            XB_SPIN(xb_ld(&bar[XB_XGEN(b.x)]) == gen, bar);
            __builtin_amdgcn_fence(__ATOMIC_ACQUIRE, "agent");
            asm volatile("s_waitcnt vmcnt(0)" ::: "memory");
        }
    }
    __syncthreads();
}

constexpr int NWAVES = 8;
constexpr int RING_BYTES = 131072;
constexpr int LDSCTL_OFF = 144384, MISC_OFF = LDSCTL_OFF + 320, RTAB_OFF = LDSCTL_OFF + 1024;
constexpr int LDS_BYTES = 147456;
constexpr int CW_BAR = 4096;
typedef short bf16x8 __attribute__((ext_vector_type(8)));
typedef short s16x4 __attribute__((ext_vector_type(4)));
typedef float f32x16 __attribute__((ext_vector_type(16)));
typedef float f32x2_t __attribute__((ext_vector_type(2)));
typedef __bf16 bf16x2_t __attribute__((ext_vector_type(2)));
#define MFMA32(a, b, c) __builtin_amdgcn_mfma_f32_32x32x16_bf16((a), (b), (c), 0, 0, 0)
__device__ __forceinline__ unsigned cvtpk(float lo, float hi) { f32x2_t v = {lo, hi}; bf16x2_t b = __builtin_convertvector(v, bf16x2_t); return __builtin_bit_cast(unsigned, b); }
__device__ __forceinline__ int crow(int r, int hi) { return (r & 3) + 8 * (r >> 2) + 4 * hi; }
__device__ __forceinline__ float fexp2(float x) { return __builtin_amdgcn_exp2f(x); }
typedef short v4i16_t __attribute__((ext_vector_type(4)));
__device__ __forceinline__ s16x4 tr_read(const LAS char* p) { return __builtin_bit_cast(s16x4, __builtin_amdgcn_ds_read_tr16_b64_v4i16((LAS v4i16_t*)p)); }

struct Args { const float* in[30]; float* out; unsigned char* ws; int ph_lo, ph_hi; };

template <int DV> struct Flash { f32x16 o[DV / 32]; f32x16 negm; float mref, l; bool started; };
template <int DV> __device__ __forceinline__ void flash_init(Flash<DV>& f) {
#pragma unroll
    for (int d = 0; d < DV / 32; ++d)
#pragma unroll
        for (int r = 0; r < 16; ++r) f.o[d][r] = 0.f;
#pragma unroll
    for (int r = 0; r < 16; ++r) f.negm[r] = 0.f;
    f.mref = 0.f; f.l = 0.f; f.started = false;
}
constexpr float FLASH_THR = 6.0f;
template <int DK, int KS>
__device__ __forceinline__ void qk_scores(const bf16x8 (&qf)[DK / 16], const LAS char* kt, int lane, const f32x16& c, f32x16& p0, f32x16& p1) {
    const int r32 = lane & 31, hi = lane >> 5;
    const LAS char* kp = kt + r32 * KS + hi * 16;
    bf16x8 a0[DK / 16], a1[DK / 16];
#pragma unroll
    for (int ks = 0; ks < DK / 16; ++ks) { a0[ks] = *(const LAS bf16x8*)(kp + ks * 32); a1[ks] = *(const LAS bf16x8*)(kp + 32 * KS + ks * 32); }
    __builtin_amdgcn_sched_barrier(0);
#pragma unroll
    for (int ks = 0; ks < DK / 16; ++ks) {
        if (ks == 0) { p0 = MFMA32(a0[0], qf[0], c); p1 = MFMA32(a1[0], qf[0], c); }
        else { p0 = MFMA32(a0[ks], qf[ks], p0); p1 = MFMA32(a1[ks], qf[ks], p1); }
    }
}
__device__ __forceinline__ float tile_colmax(const f32x16& p0, const f32x16& p1) {
    float mx = fmaxf(p0[0], p1[0]);
#pragma unroll
    for (int r = 1; r < 16; ++r) mx = fmaxf(mx, fmaxf(p0[r], p1[r]));
    return max_x32(mx);
}
template <int DV, int VS>
__device__ __forceinline__ void pv_accum(f32x16 (&o)[DV / 32], const f32x16& p0, const f32x16& p1, const LAS char* vt, int lane) {
    const int hi = lane >> 5;
    const LAS char* vb = vt + (4 * hi + ((lane & 15) >> 2)) * VS + (((lane >> 4) & 1) * 16 + (lane & 3) * 4) * 2;
#pragma unroll
    for (int k4 = 0; k4 < 4; ++k4) {
        u32x4 pw;
        if (k4 < 2) { pw.x = cvtpk(p0[8 * (k4 & 1) + 0], p0[8 * (k4 & 1) + 1]); pw.y = cvtpk(p0[8 * (k4 & 1) + 2], p0[8 * (k4 & 1) + 3]); pw.z = cvtpk(p0[8 * (k4 & 1) + 4], p0[8 * (k4 & 1) + 5]); pw.w = cvtpk(p0[8 * (k4 & 1) + 6], p0[8 * (k4 & 1) + 7]); }
        else        { pw.x = cvtpk(p1[8 * (k4 & 1) + 0], p1[8 * (k4 & 1) + 1]); pw.y = cvtpk(p1[8 * (k4 & 1) + 2], p1[8 * (k4 & 1) + 3]); pw.z = cvtpk(p1[8 * (k4 & 1) + 4], p1[8 * (k4 & 1) + 5]); pw.w = cvtpk(p1[8 * (k4 & 1) + 6], p1[8 * (k4 & 1) + 7]); }
        const bf16x8 pf = __builtin_bit_cast(bf16x8, pw);
#pragma unroll
        for (int d = 0; d < DV / 32; ++d) {
            const s16x4 lo = tr_read(vb + (16 * k4) * VS + d * 64);
            const s16x4 hh = tr_read(vb + (16 * k4 + 8) * VS + d * 64);
            const bf16x8 a = {lo[0], lo[1], lo[2], lo[3], hh[0], hh[1], hh[2], hh[3]};
            o[d] = MFMA32(a, pf, o[d]);
        }
    }
}
typedef __bf16 bf16x2d __attribute__((ext_vector_type(2)));
__device__ __forceinline__ float dot2ones(unsigned a, float c) { return __builtin_amdgcn_fdot2_f32_bf16(__builtin_bit_cast(bf16x2d, a), __builtin_bit_cast(bf16x2d, 0x3f803f80u), c, false); }
struct PTile { u32x4 k[4]; };
__device__ __forceinline__ void pack_ptile(const f32x16& p0, const f32x16& p1, PTile& P) {
#pragma unroll
    for (int s = 0; s < 2; ++s) {
        P.k[s].x = cvtpk(p0[8 * s + 0], p0[8 * s + 1]); P.k[s].y = cvtpk(p0[8 * s + 2], p0[8 * s + 3]); P.k[s].z = cvtpk(p0[8 * s + 4], p0[8 * s + 5]); P.k[s].w = cvtpk(p0[8 * s + 6], p0[8 * s + 7]);
        P.k[2 + s].x = cvtpk(p1[8 * s + 0], p1[8 * s + 1]); P.k[2 + s].y = cvtpk(p1[8 * s + 2], p1[8 * s + 3]); P.k[2 + s].z = cvtpk(p1[8 * s + 4], p1[8 * s + 5]); P.k[2 + s].w = cvtpk(p1[8 * s + 6], p1[8 * s + 7]);
    }
}
template <int DV, int VS>
__device__ __forceinline__ void flash_pv(f32x16 (&o)[DV / 32], const PTile& P, const LAS char* vt, int lane) {
    const int hi = lane >> 5;
    const LAS char* vb = vt + (4 * hi + ((lane & 15) >> 2)) * VS + (((lane >> 4) & 1) * 16 + (lane & 3) * 4) * 2;
    s16x4 lo[2][DV / 32], hh[2][DV / 32];
#pragma unroll
    for (int d = 0; d < DV / 32; ++d) { lo[0][d] = tr_read(vb + d * 64); hh[0][d] = tr_read(vb + 8 * VS + d * 64); }
#pragma unroll
    for (int k4 = 0; k4 < 4; ++k4) {
        const int cur = k4 & 1, nxt = cur ^ 1;
        if (k4 < 3) {
#pragma unroll
            for (int d = 0; d < DV / 32; ++d) { lo[nxt][d] = tr_read(vb + (16 * (k4 + 1)) * VS + d * 64); hh[nxt][d] = tr_read(vb + (16 * (k4 + 1) + 8) * VS + d * 64); }
        }
        __builtin_amdgcn_sched_barrier(0);
        const bf16x8 pf = __builtin_bit_cast(bf16x8, P.k[k4]);
#pragma unroll
        for (int d = 0; d < DV / 32; ++d) {
            const bf16x8 a = {lo[cur][d][0], lo[cur][d][1], lo[cur][d][2], lo[cur][d][3], hh[cur][d][0], hh[cur][d][1], hh[cur][d][2], hh[cur][d][3]};
            o[d] = MFMA32(a, pf, o[d]);
        }
        __builtin_amdgcn_sched_barrier(0);
    }
}
template <int DK, int DV, int KS, bool HASCOL, class MaskF>
__device__ __forceinline__ void flash_qk_sm(Flash<DV>& f, const bf16x8 (&qf)[DK / 16], const LAS char* kt, int lane, bool colsel, MaskF mask, PTile& P) {
    f32x16 p0, p1;
    if (HASCOL) { f32x16 c;
#pragma unroll
        for (int r = 0; r < 16; ++r) c[r] = colsel ? f.negm[r] : -INFINITY;
        qk_scores<DK, KS>(qf, kt, lane, c, p0, p1);
    } else qk_scores<DK, KS>(qf, kt, lane, f.negm, p0, p1);
    mask(p0, p1);
    const float cm = tile_colmax(p0, p1);
    const bool fin = cm > -INFINITY;
    const float delta = f.started ? (cm > FLASH_THR ? cm : 0.f) : (fin ? cm : 0.f);
    if (__any(delta != 0.f)) {
        const float fac = f.started ? fexp2(-delta) : 1.f;
#pragma unroll
        for (int r = 0; r < 16; ++r) { p0[r] -= delta; p1[r] -= delta; }
#pragma unroll
        for (int d = 0; d < DV / 32; ++d)
#pragma unroll
            for (int r = 0; r < 16; ++r) f.o[d][r] *= fac;
        f.l *= fac; f.mref += delta;
#pragma unroll
        for (int r = 0; r < 16; ++r) f.negm[r] = -f.mref;
    }
    f.started = f.started || fin;
#pragma unroll
    for (int r = 0; r < 16; ++r) { p0[r] = fexp2(p0[r]); p1[r] = fexp2(p1[r]); }
    pack_ptile(p0, p1, P);
    float ps = 0.f;
#pragma unroll
    for (int k = 0; k < 4; ++k) { ps = dot2ones(P.k[k].x, ps); ps = dot2ones(P.k[k].y, ps); ps = dot2ones(P.k[k].z, ps); ps = dot2ones(P.k[k].w, ps); }
    f.l += ps;
}
template <int DK, int DV, int KS, int VS, bool HASCOL, class MaskF>
__device__ __forceinline__ void flash_tile(Flash<DV>& f, const bf16x8 (&qf)[DK / 16], const LAS char* kt, const LAS char* vt, int lane, bool colsel, MaskF mask) {
    PTile P; flash_qk_sm<DK, DV, KS, HASCOL>(f, qf, kt, lane, colsel, mask, P); flash_pv<DV, VS>(f.o, P, vt, lane);
}

#define LDS_BARRIER() do { asm volatile("s_waitcnt lgkmcnt(0)" ::: "memory"); __builtin_amdgcn_s_barrier(); asm volatile("" ::: "memory"); } while (0)
constexpr int DA_KS = 144, DA_VS = 320, DA_K1OFF = 64 * DA_KS, DA_KBUF = 2 * 64 * DA_KS, DA_VBUF = 64 * DA_VS, DA_VBASE = 2 * DA_KBUF;
__device__ __forceinline__ void da_unit(const Args& a, int h, int qb, LAS char* lds) {
    unsigned char* ws = a.ws;
    const bf16* QDA = (const bf16*)(ws + WS_QDA); const bf16* KDA = (const bf16*)(ws + WS_KDA); const bf16* VDA = (const bf16*)(ws + WS_VDA);
    bf16* ODA = (bf16*)(ws + WS_ODA);
    const int tid = threadIdx.x, lane = tid & 63, w = __builtin_amdgcn_readfirstlane(tid >> 6), m = w >> 2, wq = w & 3;
    const int r32 = lane & 31, hi = lane >> 5;
    const int qrow0 = 128 * qb + 32 * wq, q = qrow0 + r32;
    bf16x8 qf[4];
#pragma unroll
    for (int ks = 0; ks < 4; ++ks) qf[ks] = *(const bf16x8*)(QDA + (size_t)q * 1024 + h * 128 + m * 64 + 16 * ks + 8 * hi);
    Flash<128> f; flash_init(f);
    const int ntiles = 2 * qb + 2;
    const int nmine = (qrow0 + 31) / 64 + 1;
    const int kkey = tid >> 3, kc = tid & 7;
    const bf16* k0src = KDA + (size_t)kkey * 1024 + h * 128 + kc * 8;
    const bf16* vsrc0 = VDA + (size_t)(tid >> 4) * 1024 + h * 128 + (tid & 15) * 8;
    const int kdst = kkey * DA_KS + kc * 16, vdst0 = DA_VBASE + (tid >> 4) * DA_VS + (tid & 15) * 16, vdst1 = vdst0 + 32 * DA_VS;
    u32x4 sA[4], sB[4];
#define DA_LOAD(S, kt) do { const size_t o_ = (size_t)(kt) * 64 * 1024; S[0] = *(const u32x4*)(k0src + o_); S[1] = *(const u32x4*)(k0src + o_ + 64); S[2] = *(const u32x4*)(vsrc0 + o_); S[3] = *(const u32x4*)(vsrc0 + o_ + 32 * 1024); } while (0)
#define DA_STORE(S, kt) do { LAS char* kb_ = lds + ((kt) & 1) * DA_KBUF; const int vo_ = ((kt) % 3) * DA_VBUF; *(LAS u32x4*)(kb_ + kdst) = S[0]; *(LAS u32x4*)(kb_ + DA_K1OFF + kdst) = S[1]; *(LAS u32x4*)(lds + vo_ + vdst0) = S[2]; *(LAS u32x4*)(lds + vo_ + vdst1) = S[3]; } while (0)
#define DA_QKSM(kt) do { const int key0 = 64 * (kt); const bool need_mask = key0 + 63 > qrow0; \
            flash_qk_sm<64, 128, DA_KS, false>(f, qf, lds + ((kt) & 1) * DA_KBUF + m * DA_K1OFF, lane, true, [&](f32x16& p0, f32x16& p1) { \
                if (need_mask) { \
                    _Pragma("unroll") for (int r = 0; r < 16; ++r) { const int key = key0 + crow(r, hi); if (key > q) p0[r] = -INFINITY; if (key + 32 > q) p1[r] = -INFINITY; } \
                } }, P); } while (0)
#define DA_PV(kt) flash_pv<128, DA_VS>(f.o, P, lds + DA_VBASE + ((kt) % 3) * DA_VBUF, lane)
#define DA_STEP(kt, S) do { \
        if (m == 1 && (kt) >= 1 && (kt) - 1 < nmine) DA_PV((kt) - 1); \
        if ((kt) < nmine) DA_QKSM(kt); \
        if (m == 0 && (kt) < nmine) DA_PV(kt); \
        if ((kt) + 1 < ntiles) DA_STORE(S, (kt) + 1); if ((kt) + 3 < ntiles) DA_LOAD(S, (kt) + 3); LDS_BARRIER(); } while (0)
    PTile P;
    DA_LOAD(sA, 0); DA_STORE(sA, 0);
    DA_LOAD(sB, 1);
    if (ntiles > 2) DA_LOAD(sA, 2);
    __syncthreads();
    for (int kt = 0; kt < ntiles; kt += 2) { DA_STEP(kt, sB); DA_STEP(kt + 1, sA); }
    if (m == 1 && ntiles - 1 < nmine) DA_PV(ntiles - 1);
    __syncthreads();
#undef DA_LOAD
#undef DA_STORE
#undef DA_QKSM
#undef DA_PV
#undef DA_STEP
    const float l = sum_x32(f.l);
    const float inv = 1.f / l;
    LAS float* o1s = (LAS float*)lds;
    if (m == 1) {
#pragma unroll
        for (int d = 0; d < 4; ++d)
#pragma unroll
            for (int r = 0; r < 16; ++r) o1s[(d * 16 + r) * 256 + wq * 64 + lane] = f.o[d][r] * inv;
    }
    __syncthreads();
    if (m == 0) {
        const float lam = ((const float*)(ws + WS_SCAL))[0];
        float ss = 0.f;
#pragma unroll
        for (int d = 0; d < 4; ++d)
#pragma unroll
            for (int r = 0; r < 16; ++r) { const float v = f.o[d][r] * inv - lam * o1s[(d * 16 + r) * 256 + wq * 64 + lane]; f.o[d][r] = v; ss += v * v; }
        ss = sum_x32(ss);
        const float rr = rsqrtf(ss * (1.f / 128.f) + EPS) * (1.f - LAMBDA_INIT);
        const float* sg = a.in[9];
#pragma unroll
        for (int d = 0; d < 4; ++d)
#pragma unroll
            for (int r4 = 0; r4 < 4; ++r4) { const int dv = 32 * d + 8 * r4 + 4 * hi; const f32x4 g4 = *(const f32x4*)(sg + dv);
                u32x2 o; o.x = pk2(f.o[d][4 * r4] * rr * g4.x, f.o[d][4 * r4 + 1] * rr * g4.y); o.y = pk2(f.o[d][4 * r4 + 2] * rr * g4.z, f.o[d][4 * r4 + 3] * rr * g4.w);
                *(u32x2*)(ODA + (size_t)q * 1024 + h * 128 + dv) = o; }
    }
    __syncthreads();
}
template <class F> struct EpiFn {
    static constexpr bool PERM = false, AFTER_DRAIN = false; F f;
    __device__ __forceinline__ void operator()(const pg8::f32x4 (&acc)[2][2][4][2], const pg8::Unit& u, int wr, int wc, int fr, int fq) const {
#pragma unroll
        for (int ai = 0; ai < 2; ++ai)
#pragma unroll
            for (int m = 0; m < 4; ++m) { const int row = u.pm * 256 + ai * 128 + wr * 64 + m * 16 + fr;
#pragma unroll
                for (int bj = 0; bj < 2; ++bj)
#pragma unroll
                    for (int n = 0; n < 2; ++n) f(row, u.pn * 256 + bj * 128 + wc * 32 + n * 16 + fq * 4, acc[ai][bj][m][n]); }
    }
};
struct FStoreBf16 { bf16* O; int ldc; __device__ __forceinline__ void operator()(int row, int col, f32x4 v) const { u32x2 w; w.x = pk2(v.x, v.y); w.y = pk2(v.z, v.w); *(u32x2*)(O + (size_t)row * ldc + col) = w; } };
struct FGate0 { bf16* MIX; const bf16* BG; __device__ __forceinline__ void operator()(int row, int col, f32x4 v) const {
    const u32x2 g = *(const u32x2*)(BG + (size_t)row * 4096 + col); u32x2 w;
    w.x = pk2(v.x * __uint_as_float(g.x << 16), v.y * __uint_as_float(g.x & 0xffff0000u)); w.y = pk2(v.z * __uint_as_float(g.y << 16), v.w * __uint_as_float(g.y & 0xffff0000u));
    *(u32x2*)(MIX + (size_t)row * 2048 + col) = w; } };
struct FGate1 { bf16* MIX; const bf16* BG; __device__ __forceinline__ void operator()(int row, int col, f32x4 v) const {
    const u32x2 g = *(const u32x2*)(BG + (size_t)row * 4096 + 2048 + col); const u32x2 o = *(const u32x2*)(MIX + (size_t)row * 2048 + col); u32x2 w;
    w.x = pk2(__uint_as_float(o.x << 16) + v.x * __uint_as_float(g.x << 16), __uint_as_float(o.x & 0xffff0000u) + v.y * __uint_as_float(g.x & 0xffff0000u));
    w.y = pk2(__uint_as_float(o.y << 16) + v.z * __uint_as_float(g.y << 16), __uint_as_float(o.y & 0xffff0000u) + v.w * __uint_as_float(g.y & 0xffff0000u));
    *(u32x2*)(MIX + (size_t)row * 2048 + col) = w; } };
template <bool BB> struct EpiResSS {
    static constexpr bool PERM = false, AFTER_DRAIN = false; const void* base; bf16* outb; float* ss;
    __device__ __forceinline__ void operator()(const pg8::f32x4 (&acc)[2][2][4][2], const pg8::Unit& u, int wr, int wc, int fr, int fq) const {
#pragma unroll
        for (int ai = 0; ai < 2; ++ai)
#pragma unroll
            for (int m = 0; m < 4; ++m) { const int row = u.pm * 256 + ai * 128 + wr * 64 + m * 16 + fr; float sq = 0.f;
#pragma unroll
                for (int bj = 0; bj < 2; ++bj)
#pragma unroll
                    for (int n = 0; n < 2; ++n) { const size_t o = (size_t)row * 2048 + u.pn * 256 + bj * 128 + wc * 32 + n * 16 + fq * 4;
                        f32x4 bv;
                        if (BB) { const u32x2 t = *(const u32x2*)((const bf16*)base + o); bv = (f32x4){__uint_as_float(t.x << 16), __uint_as_float(t.x & 0xffff0000u), __uint_as_float(t.y << 16), __uint_as_float(t.y & 0xffff0000u)}; }
                        else bv = *(const f32x4*)((const float*)base + o);
                        const f32x4 v = acc[ai][bj][m][n] + bv; u32x2 w; w.x = pk2(v.x, v.y); w.y = pk2(v.z, v.w); *(u32x2*)(outb + o) = w;
                        sq += (v.x * v.x + v.y * v.y) + (v.z * v.z + v.w * v.w); }
                sq = sum_x32(sum_x16(sq));
                if (fq == 0) ss[(size_t)(u.pn * 4 + wc) * S_ + row] = sq; }
    }
};
struct FRowScaleL { const LAS float* rtab; bf16* O; float scale; int ldc;
    __device__ __forceinline__ void operator()(int row, int col, f32x4 v) const { const float s = rtab[row & 255] * scale; u32x2 w; w.x = pk2(v.x * s, v.y * s); w.y = pk2(v.z * s, v.w * s); *(u32x2*)(O + (size_t)row * ldc + col) = w; } };
__device__ __forceinline__ void make_rtab(const pg8::StaticOrder& S, const float* ss, LAS float* rtab) {
    pg8::Unit u;
    if (S.next(0, u) && threadIdx.x < 256) { const int row = u.pm * 256 + threadIdx.x; float s = 0.f;
#pragma unroll 8
        for (int k = 0; k < 32; ++k) s += ss[(size_t)k * S_ + row];
        rtab[threadIdx.x] = rsqrtf(s * (1.f / DM) + EPS); }
    __syncthreads();
}

constexpr int TR_I0 = 32 * (NZ / 32), TR_I1 = 16 * 64, TR_I2 = 16 * 64, TR_I3 = 32 * 64, TR_I4 = 32 * 16, TR_I5 = 32 * 32, TR_I6 = 8 * 64, TR_I7 = 32 * 64, TR_I8 = 32 * 4;
constexpr int TR_NEARLY = TR_I0 + TR_I5, TR_NIT = TR_I0 + TR_I1 + TR_I2 + TR_I3 + TR_I4 + TR_I5 + TR_I6 + TR_I7 + 2 * TR_I8;
__device__ __forceinline__ TrItem tr_item_of(const Args& P, int it) {
    unsigned char* ws = P.ws;
    int r = it; TrItem t; t.gk = nullptr; t.zmap = false; t.kblk = false;
    if (r < TR_I0) { t.W = P.in[4]; t.K = 2048; t.Nsrc = 9776; t.WT = (bf16*)(ws + WS_W1T); t.zmap = true; t.kb = r / (NZ / 32); t.nb = r % (NZ / 32); return t; } r -= TR_I0;
    if (r < TR_I5) { t.W = P.in[21]; t.K = 2048; t.Nsrc = 1024; t.WT = (bf16*)(ws + WS_WXKV); t.kb = r / 32; t.nb = r % 32; return t; } r -= TR_I5;
    if (r < TR_I1) { t.W = P.in[15]; t.K = 1024; t.Nsrc = 2048; t.WT = (bf16*)(ws + WS_WBDA); t.kb = r / 64; t.nb = r % 64; return t; } r -= TR_I1;
    if (r < TR_I2) { t.W = P.in[16]; t.K = 1024; t.Nsrc = 2048; t.WT = (bf16*)(ws + WS_WBNSA); t.kb = r / 64; t.nb = r % 64; return t; } r -= TR_I2;
    if (r < TR_I3) { t.W = P.in[17]; t.K = 2048; t.Nsrc = 2048; t.WT = (bf16*)(ws + WS_WOUT); t.kb = r / 64; t.nb = r % 64; return t; } r -= TR_I3;
    if (r < TR_I4) { t.W = P.in[20]; t.K = 2048; t.Nsrc = 512; t.WT = (bf16*)(ws + WS_WXQ); t.gk = P.in[18]; t.kb = r / 16; t.nb = r % 16; return t; } r -= TR_I4;
    if (r < TR_I6) { t.W = P.in[22]; t.K = 512; t.Nsrc = 2048; t.WT = (bf16*)(ws + WS_WXO); t.kb = r / 64; t.nb = r % 64; return t; } r -= TR_I6;
    if (r < TR_I7) { t.W = P.in[24]; t.K = 2048; t.Nsrc = 2048; t.WT = (bf16*)(ws + WS_WPQ); t.gk = P.in[23]; t.kb = r / 64; t.nb = r % 64; return t; } r -= TR_I7;
    const int wh = r / TR_I8; r %= TR_I8; t.W = P.in[wh ? 13 : 11]; t.K = 2048; t.Nsrc = 128; t.WT = (bf16*)(ws + WS_W1C) + (size_t)wh * 128 * 2048; t.kb = r / 4; t.nb = r % 4; t.kblk = true; return t;
}
__device__ __forceinline__ void tr_items(const Args& P, LAS float* scr, int lane, int lo, int hi, int w, int nw) {
    const int first = lo + w;
    if (first < hi) {
        f32x4 va[8], vb[8]; TrItem ta = tr_item_of(P, first), tb; tr_load(ta, lane, va);
        for (int it = first; it < hi; it += 2 * nw) {
            const bool hb = it + nw < hi;
            if (hb) { tb = tr_item_of(P, it + nw); tr_load(tb, lane, vb); }
            tr_finish(ta, lane, va, scr);
            if (it + 2 * nw < hi) { ta = tr_item_of(P, it + 2 * nw); tr_load(ta, lane, va); }
            if (hb) tr_finish(tb, lane, vb, scr);
        }
    }
}
__device__ __forceinline__ void p_prologue(const Args& P, LAS char* lds, int gw, int NGW, int gt, int NGT) {
    const int tid = threadIdx.x, lane = tid & 63, wave = tid >> 6;
    LAS float* scr = (LAS float*)lds + wave * 64 * 33;
    unsigned char* ws = P.ws;
    tr_items(P, scr, lane, 0, TR_NIT, gw, NGW);
    for (int m = gw; m < S_ + MEML; m += NGW) {
        if (m < S_) rms_row_to_bf16(P.in[0] + (size_t)m * DM, P.in[3], (bf16*)(ws + WS_XN) + (size_t)m * DM, lane);
        else rms_row_to_bf16(P.in[1] + (size_t)(m - S_) * DM, P.in[19], (bf16*)(ws + WS_MEMN) + (size_t)(m - S_) * DM, lane);
    }
    for (int i = gt; i < S_ * 8; i += NGT) {
        const int t = i >> 3, j = i & 7;
        float iv = 1.0f;
        iv = (j == 1) ? 0.19392274f : iv; iv = (j == 2) ? 0.037606031f : iv; iv = (j == 3) ? 0.0072926646f : iv; iv = (j == 4) ? 0.0014142136f : iv;
        iv = (j == 5) ? 0.00027424819f : iv; iv = (j == 6) ? 5.3182957e-05f : iv; iv = (j == 7) ? 1.0313385e-05f : iv;
        const float ang = (float)((const int*)P.in[2])[t] * iv;
        const double ad = (double)ang; const double k = rint(ad * 0.15915494309189535); const float rr = (float)(ad - k * 6.283185307179586);
        ((float*)(ws + WS_COS))[i] = cosf(rr); ((float*)(ws + WS_SIN))[i] = sinf(rr);
    }
    if (gt == 0) {
        float a = 0.f, b = 0.f;
        for (int i = 0; i < 64; ++i) { a += P.in[5][i] * P.in[6][i]; b += P.in[7][i] * P.in[8][i]; }
        ((float*)(ws + WS_SCAL))[0] = expf(a) - expf(b) + LAMBDA_INIT;
    }
    if (gt < 256) { ((bf16*)(ws + WS_KC))[511 * 256 + gt] = 0; ((bf16*)(ws + WS_VC))[511 * 256 + gt] = 0; }
    if (gw >= 256 && gw < 512) { const int o = gw - 256, wh = o >> 7, hcol = o & 127; const float* w1 = wh ? P.in[13] : P.in[11]; const float* pos = P.in[10]; float s = 0.f;
#pragma unroll 8
        for (int j = 0; j < 32; ++j) { const int i = lane + 64 * j; s += pos[i] * w1[(size_t)i * 128 + hcol]; }
        s = wave_sum(s); if (lane == 0) ((float*)(ws + WS_CPOS))[wh * 128 + hcol] = s; }
}

typedef __bf16 bf16x2v __attribute__((ext_vector_type(2)));
typedef _Float16 h2_t __attribute__((ext_vector_type(2)));
constexpr size_t WS_VQS = 176 * MiB;
__device__ __forceinline__ float ub0(unsigned x) { return (float)(x & 0xffu); }
__device__ __forceinline__ float ub1(unsigned x) { return (float)((x >> 8) & 0xffu); }
__device__ __forceinline__ float ub2(unsigned x) { return (float)((x >> 16) & 0xffu); }
__device__ __forceinline__ float ub3(unsigned x) { return (float)(x >> 24); }
__device__ __forceinline__ float dot2bf(unsigned a, unsigned b, float c) { return __builtin_amdgcn_fdot2_f32_bf16(__builtin_bit_cast(bf16x2v, a), __builtin_bit_cast(bf16x2v, b), c, false); }
__device__ __forceinline__ void top16_of_128(f32x16 (&acc)[4], LAS float* vout, LAS int* iout, int r32, int hi) {
    float e[64];
#pragma unroll
    for (int b = 0; b < 4; ++b)
#pragma unroll
        for (int r = 0; r < 16; ++r) e[16 * b + r] = __uint_as_float((__float_as_uint(acc[b][r]) & 0xffffff80u) | (unsigned)(32 * b + crow(r, hi)));
    { const float a_ = e[0], b_ = e[1]; e[0] = fmaxf(a_, b_); e[1] = fminf(a_, b_); }
    { const float a_ = e[3], b_ = e[2]; e[3] = fmaxf(a_, b_); e[2] = fminf(a_, b_); }
    { const float a_ = e[4], b_ = e[5]; e[4] = fmaxf(a_, b_); e[5] = fminf(a_, b_); }
    { const float a_ = e[7], b_ = e[6]; e[7] = fmaxf(a_, b_); e[6] = fminf(a_, b_); }
    { const float a_ = e[8], b_ = e[9]; e[8] = fmaxf(a_, b_); e[9] = fminf(a_, b_); }
    { const float a_ = e[11], b_ = e[10]; e[11] = fmaxf(a_, b_); e[10] = fminf(a_, b_); }
    { const float a_ = e[12], b_ = e[13]; e[12] = fmaxf(a_, b_); e[13] = fminf(a_, b_); }
    { const float a_ = e[15], b_ = e[14]; e[15] = fmaxf(a_, b_); e[14] = fminf(a_, b_); }
    { const float a_ = e[0], b_ = e[2]; e[0] = fmaxf(a_, b_); e[2] = fminf(a_, b_); }
    { const float a_ = e[1], b_ = e[3]; e[1] = fmaxf(a_, b_); e[3] = fminf(a_, b_); }
    { const float a_ = e[6], b_ = e[4]; e[6] = fmaxf(a_, b_); e[4] = fminf(a_, b_); }
    { const float a_ = e[7], b_ = e[5]; e[7] = fmaxf(a_, b_); e[5] = fminf(a_, b_); }
    { const float a_ = e[8], b_ = e[10]; e[8] = fmaxf(a_, b_); e[10] = fminf(a_, b_); }
    { const float a_ = e[9], b_ = e[11]; e[9] = fmaxf(a_, b_); e[11] = fminf(a_, b_); }
    { const float a_ = e[14], b_ = e[12]; e[14] = fmaxf(a_, b_); e[12] = fminf(a_, b_); }
    { const float a_ = e[15], b_ = e[13]; e[15] = fmaxf(a_, b_); e[13] = fminf(a_, b_); }
    { const float a_ = e[0], b_ = e[1]; e[0] = fmaxf(a_, b_); e[1] = fminf(a_, b_); }
    { const float a_ = e[2], b_ = e[3]; e[2] = fmaxf(a_, b_); e[3] = fminf(a_, b_); }
    { const float a_ = e[5], b_ = e[4]; e[5] = fmaxf(a_, b_); e[4] = fminf(a_, b_); }
    { const float a_ = e[7], b_ = e[6]; e[7] = fmaxf(a_, b_); e[6] = fminf(a_, b_); }
    { const float a_ = e[8], b_ = e[9]; e[8] = fmaxf(a_, b_); e[9] = fminf(a_, b_); }
    { const float a_ = e[10], b_ = e[11]; e[10] = fmaxf(a_, b_); e[11] = fminf(a_, b_); }
    { const float a_ = e[13], b_ = e[12]; e[13] = fmaxf(a_, b_); e[12] = fminf(a_, b_); }
    { const float a_ = e[15], b_ = e[14]; e[15] = fmaxf(a_, b_); e[14] = fminf(a_, b_); }
    { const float a_ = e[0], b_ = e[4]; e[0] = fmaxf(a_, b_); e[4] = fminf(a_, b_); }
    { const float a_ = e[1], b_ = e[5]; e[1] = fmaxf(a_, b_); e[5] = fminf(a_, b_); }
    { const float a_ = e[2], b_ = e[6]; e[2] = fmaxf(a_, b_); e[6] = fminf(a_, b_); }
    { const float a_ = e[3], b_ = e[7]; e[3] = fmaxf(a_, b_); e[7] = fminf(a_, b_); }
    { const float a_ = e[12], b_ = e[8]; e[12] = fmaxf(a_, b_); e[8] = fminf(a_, b_); }
    { const float a_ = e[13], b_ = e[9]; e[13] = fmaxf(a_, b_); e[9] = fminf(a_, b_); }
    { const float a_ = e[14], b_ = e[10]; e[14] = fmaxf(a_, b_); e[10] = fminf(a_, b_); }
    { const float a_ = e[15], b_ = e[11]; e[15] = fmaxf(a_, b_); e[11] = fminf(a_, b_); }
    { const float a_ = e[0], b_ = e[2]; e[0] = fmaxf(a_, b_); e[2] = fminf(a_, b_); }
    { const float a_ = e[1], b_ = e[3]; e[1] = fmaxf(a_, b_); e[3] = fminf(a_, b_); }
    { const float a_ = e[4], b_ = e[6]; e[4] = fmaxf(a_, b_); e[6] = fminf(a_, b_); }
    { const float a_ = e[5], b_ = e[7]; e[5] = fmaxf(a_, b_); e[7] = fminf(a_, b_); }
    { const float a_ = e[10], b_ = e[8]; e[10] = fmaxf(a_, b_); e[8] = fminf(a_, b_); }
    { const float a_ = e[11], b_ = e[9]; e[11] = fmaxf(a_, b_); e[9] = fminf(a_, b_); }
    { const float a_ = e[14], b_ = e[12]; e[14] = fmaxf(a_, b_); e[12] = fminf(a_, b_); }
    { const float a_ = e[15], b_ = e[13]; e[15] = fmaxf(a_, b_); e[13] = fminf(a_, b_); }
    { const float a_ = e[0], b_ = e[1]; e[0] = fmaxf(a_, b_); e[1] = fminf(a_, b_); }
    { const float a_ = e[2], b_ = e[3]; e[2] = fmaxf(a_, b_); e[3] = fminf(a_, b_); }
    { const float a_ = e[4], b_ = e[5]; e[4] = fmaxf(a_, b_); e[5] = fminf(a_, b_); }
    { const float a_ = e[6], b_ = e[7]; e[6] = fmaxf(a_, b_); e[7] = fminf(a_, b_); }
    { const float a_ = e[9], b_ = e[8]; e[9] = fmaxf(a_, b_); e[8] = fminf(a_, b_); }
    { const float a_ = e[11], b_ = e[10]; e[11] = fmaxf(a_, b_); e[10] = fminf(a_, b_); }
    { const float a_ = e[13], b_ = e[12]; e[13] = fmaxf(a_, b_); e[12] = fminf(a_, b_); }
    { const float a_ = e[15], b_ = e[14]; e[15] = fmaxf(a_, b_); e[14] = fminf(a_, b_); }
    { const float a_ = e[0], b_ = e[8]; e[0] = fmaxf(a_, b_); e[8] = fminf(a_, b_); }
    { const float a_ = e[1], b_ = e[9]; e[1] = fmaxf(a_, b_); e[9] = fminf(a_, b_); }
    { const float a_ = e[2], b_ = e[10]; e[2] = fmaxf(a_, b_); e[10] = fminf(a_, b_); }
    { const float a_ = e[3], b_ = e[11]; e[3] = fmaxf(a_, b_); e[11] = fminf(a_, b_); }
    { const float a_ = e[4], b_ = e[12]; e[4] = fmaxf(a_, b_); e[12] = fminf(a_, b_); }
    { const float a_ = e[5], b_ = e[13]; e[5] = fmaxf(a_, b_); e[13] = fminf(a_, b_); }
    { const float a_ = e[6], b_ = e[14]; e[6] = fmaxf(a_, b_); e[14] = fminf(a_, b_); }
    { const float a_ = e[7], b_ = e[15]; e[7] = fmaxf(a_, b_); e[15] = fminf(a_, b_); }
    { const float a_ = e[0], b_ = e[4]; e[0] = fmaxf(a_, b_); e[4] = fminf(a_, b_); }
    { const float a_ = e[1], b_ = e[5]; e[1] = fmaxf(a_, b_); e[5] = fminf(a_, b_); }
    { const float a_ = e[2], b_ = e[6]; e[2] = fmaxf(a_, b_); e[6] = fminf(a_, b_); }
    { const float a_ = e[3], b_ = e[7]; e[3] = fmaxf(a_, b_); e[7] = fminf(a_, b_); }
    { const float a_ = e[8], b_ = e[12]; e[8] = fmaxf(a_, b_); e[12] = fminf(a_, b_); }
    { const float a_ = e[9], b_ = e[13]; e[9] = fmaxf(a_, b_); e[13] = fminf(a_, b_); }
    { const float a_ = e[10], b_ = e[14]; e[10] = fmaxf(a_, b_); e[14] = fminf(a_, b_); }
    { const float a_ = e[11], b_ = e[15]; e[11] = fmaxf(a_, b_); e[15] = fminf(a_, b_); }
    { const float a_ = e[0], b_ = e[2]; e[0] = fmaxf(a_, b_); e[2] = fminf(a_, b_); }
    { const float a_ = e[1], b_ = e[3]; e[1] = fmaxf(a_, b_); e[3] = fminf(a_, b_); }
    { const float a_ = e[4], b_ = e[6]; e[4] = fmaxf(a_, b_); e[6] = fminf(a_, b_); }
    { const float a_ = e[5], b_ = e[7]; e[5] = fmaxf(a_, b_); e[7] = fminf(a_, b_); }
    { const float a_ = e[8], b_ = e[10]; e[8] = fmaxf(a_, b_); e[10] = fminf(a_, b_); }
    { const float a_ = e[9], b_ = e[11]; e[9] = fmaxf(a_, b_); e[11] = fminf(a_, b_); }
    { const float a_ = e[12], b_ = e[14]; e[12] = fmaxf(a_, b_); e[14] = fminf(a_, b_); }
    { const float a_ = e[13], b_ = e[15]; e[13] = fmaxf(a_, b_); e[15] = fminf(a_, b_); }
    { const float a_ = e[0], b_ = e[1]; e[0] = fmaxf(a_, b_); e[1] = fminf(a_, b_); }
    { const float a_ = e[2], b_ = e[3]; e[2] = fmaxf(a_, b_); e[3] = fminf(a_, b_); }
    { const float a_ = e[4], b_ = e[5]; e[4] = fmaxf(a_, b_); e[5] = fminf(a_, b_); }
    { const float a_ = e[6], b_ = e[7]; e[6] = fmaxf(a_, b_); e[7] = fminf(a_, b_); }
    { const float a_ = e[8], b_ = e[9]; e[8] = fmaxf(a_, b_); e[9] = fminf(a_, b_); }
    { const float a_ = e[10], b_ = e[11]; e[10] = fmaxf(a_, b_); e[11] = fminf(a_, b_); }
    { const float a_ = e[12], b_ = e[13]; e[12] = fmaxf(a_, b_); e[13] = fminf(a_, b_); }
    { const float a_ = e[14], b_ = e[15]; e[14] = fmaxf(a_, b_); e[15] = fminf(a_, b_); }
    { const float a_ = e[16], b_ = e[17]; e[16] = fmaxf(a_, b_); e[17] = fminf(a_, b_); }
    { const float a_ = e[19], b_ = e[18]; e[19] = fmaxf(a_, b_); e[18] = fminf(a_, b_); }
    { const float a_ = e[20], b_ = e[21]; e[20] = fmaxf(a_, b_); e[21] = fminf(a_, b_); }
    { const float a_ = e[23], b_ = e[22]; e[23] = fmaxf(a_, b_); e[22] = fminf(a_, b_); }
    { const float a_ = e[24], b_ = e[25]; e[24] = fmaxf(a_, b_); e[25] = fminf(a_, b_); }
    { const float a_ = e[27], b_ = e[26]; e[27] = fmaxf(a_, b_); e[26] = fminf(a_, b_); }
    { const float a_ = e[28], b_ = e[29]; e[28] = fmaxf(a_, b_); e[29] = fminf(a_, b_); }
    { const float a_ = e[31], b_ = e[30]; e[31] = fmaxf(a_, b_); e[30] = fminf(a_, b_); }
    { const float a_ = e[16], b_ = e[18]; e[16] = fmaxf(a_, b_); e[18] = fminf(a_, b_); }
    { const float a_ = e[17], b_ = e[19]; e[17] = fmaxf(a_, b_); e[19] = fminf(a_, b_); }
    { const float a_ = e[22], b_ = e[20]; e[22] = fmaxf(a_, b_); e[20] = fminf(a_, b_); }
    { const float a_ = e[23], b_ = e[21]; e[23] = fmaxf(a_, b_); e[21] = fminf(a_, b_); }
    { const float a_ = e[24], b_ = e[26]; e[24] = fmaxf(a_, b_); e[26] = fminf(a_, b_); }
    { const float a_ = e[25], b_ = e[27]; e[25] = fmaxf(a_, b_); e[27] = fminf(a_, b_); }
    { const float a_ = e[30], b_ = e[28]; e[30] = fmaxf(a_, b_); e[28] = fminf(a_, b_); }
    { const float a_ = e[31], b_ = e[29]; e[31] = fmaxf(a_, b_); e[29] = fminf(a_, b_); }
    { const float a_ = e[16], b_ = e[17]; e[16] = fmaxf(a_, b_); e[17] = fminf(a_, b_); }
    { const float a_ = e[18], b_ = e[19]; e[18] = fmaxf(a_, b_); e[19] = fminf(a_, b_); }
    { const float a_ = e[21], b_ = e[20]; e[21] = fmaxf(a_, b_); e[20] = fminf(a_, b_); }
    { const float a_ = e[23], b_ = e[22]; e[23] = fmaxf(a_, b_); e[22] = fminf(a_, b_); }
    { const float a_ = e[24], b_ = e[25]; e[24] = fmaxf(a_, b_); e[25] = fminf(a_, b_); }
    { const float a_ = e[26], b_ = e[27]; e[26] = fmaxf(a_, b_); e[27] = fminf(a_, b_); }
    { const float a_ = e[29], b_ = e[28]; e[29] = fmaxf(a_, b_); e[28] = fminf(a_, b_); }
    { const float a_ = e[31], b_ = e[30]; e[31] = fmaxf(a_, b_); e[30] = fminf(a_, b_); }
    { const float a_ = e[16], b_ = e[20]; e[16] = fmaxf(a_, b_); e[20] = fminf(a_, b_); }
    { const float a_ = e[17], b_ = e[21]; e[17] = fmaxf(a_, b_); e[21] = fminf(a_, b_); }
    { const float a_ = e[18], b_ = e[22]; e[18] = fmaxf(a_, b_); e[22] = fminf(a_, b_); }
    { const float a_ = e[19], b_ = e[23]; e[19] = fmaxf(a_, b_); e[23] = fminf(a_, b_); }
    { const float a_ = e[28], b_ = e[24]; e[28] = fmaxf(a_, b_); e[24] = fminf(a_, b_); }
    { const float a_ = e[29], b_ = e[25]; e[29] = fmaxf(a_, b_); e[25] = fminf(a_, b_); }
    { const float a_ = e[30], b_ = e[26]; e[30] = fmaxf(a_, b_); e[26] = fminf(a_, b_); }
    { const float a_ = e[31], b_ = e[27]; e[31] = fmaxf(a_, b_); e[27] = fminf(a_, b_); }
    { const float a_ = e[16], b_ = e[18]; e[16] = fmaxf(a_, b_); e[18] = fminf(a_, b_); }
    { const float a_ = e[17], b_ = e[19]; e[17] = fmaxf(a_, b_); e[19] = fminf(a_, b_); }
    { const float a_ = e[20], b_ = e[22]; e[20] = fmaxf(a_, b_); e[22] = fminf(a_, b_); }
    { const float a_ = e[21], b_ = e[23]; e[21] = fmaxf(a_, b_); e[23] = fminf(a_, b_); }
    { const float a_ = e[26], b_ = e[24]; e[26] = fmaxf(a_, b_); e[24] = fminf(a_, b_); }
    { const float a_ = e[27], b_ = e[25]; e[27] = fmaxf(a_, b_); e[25] = fminf(a_, b_); }
    { const float a_ = e[30], b_ = e[28]; e[30] = fmaxf(a_, b_); e[28] = fminf(a_, b_); }
    { const float a_ = e[31], b_ = e[29]; e[31] = fmaxf(a_, b_); e[29] = fminf(a_, b_); }
    { const float a_ = e[16], b_ = e[17]; e[16] = fmaxf(a_, b_); e[17] = fminf(a_, b_); }
    { const float a_ = e[18], b_ = e[19]; e[18] = fmaxf(a_, b_); e[19] = fminf(a_, b_); }
    { const float a_ = e[20], b_ = e[21]; e[20] = fmaxf(a_, b_); e[21] = fminf(a_, b_); }
    { const float a_ = e[22], b_ = e[23]; e[22] = fmaxf(a_, b_); e[23] = fminf(a_, b_); }
    { const float a_ = e[25], b_ = e[24]; e[25] = fmaxf(a_, b_); e[24] = fminf(a_, b_); }
    { const float a_ = e[27], b_ = e[26]; e[27] = fmaxf(a_, b_); e[26] = fminf(a_, b_); }
    { const float a_ = e[29], b_ = e[28]; e[29] = fmaxf(a_, b_); e[28] = fminf(a_, b_); }
    { const float a_ = e[31], b_ = e[30]; e[31] = fmaxf(a_, b_); e[30] = fminf(a_, b_); }
    { const float a_ = e[16], b_ = e[24]; e[16] = fmaxf(a_, b_); e[24] = fminf(a_, b_); }
    { const float a_ = e[17], b_ = e[25]; e[17] = fmaxf(a_, b_); e[25] = fminf(a_, b_); }
    { const float a_ = e[18], b_ = e[26]; e[18] = fmaxf(a_, b_); e[26] = fminf(a_, b_); }
    { const float a_ = e[19], b_ = e[27]; e[19] = fmaxf(a_, b_); e[27] = fminf(a_, b_); }
    { const float a_ = e[20], b_ = e[28]; e[20] = fmaxf(a_, b_); e[28] = fminf(a_, b_); }
    { const float a_ = e[21], b_ = e[29]; e[21] = fmaxf(a_, b_); e[29] = fminf(a_, b_); }
    { const float a_ = e[22], b_ = e[30]; e[22] = fmaxf(a_, b_); e[30] = fminf(a_, b_); }
    { const float a_ = e[23], b_ = e[31]; e[23] = fmaxf(a_, b_); e[31] = fminf(a_, b_); }
    { const float a_ = e[16], b_ = e[20]; e[16] = fmaxf(a_, b_); e[20] = fminf(a_, b_); }
    { const float a_ = e[17], b_ = e[21]; e[17] = fmaxf(a_, b_); e[21] = fminf(a_, b_); }
    { const float a_ = e[18], b_ = e[22]; e[18] = fmaxf(a_, b_); e[22] = fminf(a_, b_); }
    { const float a_ = e[19], b_ = e[23]; e[19] = fmaxf(a_, b_); e[23] = fminf(a_, b_); }
    { const float a_ = e[24], b_ = e[28]; e[24] = fmaxf(a_, b_); e[28] = fminf(a_, b_); }
    { const float a_ = e[25], b_ = e[29]; e[25] = fmaxf(a_, b_); e[29] = fminf(a_, b_); }
    { const float a_ = e[26], b_ = e[30]; e[26] = fmaxf(a_, b_); e[30] = fminf(a_, b_); }
    { const float a_ = e[27], b_ = e[31]; e[27] = fmaxf(a_, b_); e[31] = fminf(a_, b_); }
    { const float a_ = e[16], b_ = e[18]; e[16] = fmaxf(a_, b_); e[18] = fminf(a_, b_); }
    { const float a_ = e[17], b_ = e[19]; e[17] = fmaxf(a_, b_); e[19] = fminf(a_, b_); }
    { const float a_ = e[20], b_ = e[22]; e[20] = fmaxf(a_, b_); e[22] = fminf(a_, b_); }
    { const float a_ = e[21], b_ = e[23]; e[21] = fmaxf(a_, b_); e[23] = fminf(a_, b_); }
    { const float a_ = e[24], b_ = e[26]; e[24] = fmaxf(a_, b_); e[26] = fminf(a_, b_); }
    { const float a_ = e[25], b_ = e[27]; e[25] = fmaxf(a_, b_); e[27] = fminf(a_, b_); }
    { const float a_ = e[28], b_ = e[30]; e[28] = fmaxf(a_, b_); e[30] = fminf(a_, b_); }
    { const float a_ = e[29], b_ = e[31]; e[29] = fmaxf(a_, b_); e[31] = fminf(a_, b_); }
    { const float a_ = e[16], b_ = e[17]; e[16] = fmaxf(a_, b_); e[17] = fminf(a_, b_); }
    { const float a_ = e[18], b_ = e[19]; e[18] = fmaxf(a_, b_); e[19] = fminf(a_, b_); }
    { const float a_ = e[20], b_ = e[21]; e[20] = fmaxf(a_, b_); e[21] = fminf(a_, b_); }
    { const float a_ = e[22], b_ = e[23]; e[22] = fmaxf(a_, b_); e[23] = fminf(a_, b_); }
    { const float a_ = e[24], b_ = e[25]; e[24] = fmaxf(a_, b_); e[25] = fminf(a_, b_); }
    { const float a_ = e[26], b_ = e[27]; e[26] = fmaxf(a_, b_); e[27] = fminf(a_, b_); }
    { const float a_ = e[28], b_ = e[29]; e[28] = fmaxf(a_, b_); e[29] = fminf(a_, b_); }
    { const float a_ = e[30], b_ = e[31]; e[30] = fmaxf(a_, b_); e[31] = fminf(a_, b_); }
    { const float a_ = e[32], b_ = e[33]; e[32] = fmaxf(a_, b_); e[33] = fminf(a_, b_); }
    { const float a_ = e[35], b_ = e[34]; e[35] = fmaxf(a_, b_); e[34] = fminf(a_, b_); }
    { const float a_ = e[36], b_ = e[37]; e[36] = fmaxf(a_, b_); e[37] = fminf(a_, b_); }
    { const float a_ = e[39], b_ = e[38]; e[39] = fmaxf(a_, b_); e[38] = fminf(a_, b_); }
    { const float a_ = e[40], b_ = e[41]; e[40] = fmaxf(a_, b_); e[41] = fminf(a_, b_); }
    { const float a_ = e[43], b_ = e[42]; e[43] = fmaxf(a_, b_); e[42] = fminf(a_, b_); }
    { const float a_ = e[44], b_ = e[45]; e[44] = fmaxf(a_, b_); e[45] = fminf(a_, b_); }
    { const float a_ = e[47], b_ = e[46]; e[47] = fmaxf(a_, b_); e[46] = fminf(a_, b_); }
    { const float a_ = e[32], b_ = e[34]; e[32] = fmaxf(a_, b_); e[34] = fminf(a_, b_); }
    { const float a_ = e[33], b_ = e[35]; e[33] = fmaxf(a_, b_); e[35] = fminf(a_, b_); }
    { const float a_ = e[38], b_ = e[36]; e[38] = fmaxf(a_, b_); e[36] = fminf(a_, b_); }
    { const float a_ = e[39], b_ = e[37]; e[39] = fmaxf(a_, b_); e[37] = fminf(a_, b_); }
    { const float a_ = e[40], b_ = e[42]; e[40] = fmaxf(a_, b_); e[42] = fminf(a_, b_); }
    { const float a_ = e[41], b_ = e[43]; e[41] = fmaxf(a_, b_); e[43] = fminf(a_, b_); }
    { const float a_ = e[46], b_ = e[44]; e[46] = fmaxf(a_, b_); e[44] = fminf(a_, b_); }
    { const float a_ = e[47], b_ = e[45]; e[47] = fmaxf(a_, b_); e[45] = fminf(a_, b_); }
    { const float a_ = e[32], b_ = e[33]; e[32] = fmaxf(a_, b_); e[33] = fminf(a_, b_); }
    { const float a_ = e[34], b_ = e[35]; e[34] = fmaxf(a_, b_); e[35] = fminf(a_, b_); }
    { const float a_ = e[37], b_ = e[36]; e[37] = fmaxf(a_, b_); e[36] = fminf(a_, b_); }
    { const float a_ = e[39], b_ = e[38]; e[39] = fmaxf(a_, b_); e[38] = fminf(a_, b_); }
    { const float a_ = e[40], b_ = e[41]; e[40] = fmaxf(a_, b_); e[41] = fminf(a_, b_); }
    { const float a_ = e[42], b_ = e[43]; e[42] = fmaxf(a_, b_); e[43] = fminf(a_, b_); }
    { const float a_ = e[45], b_ = e[44]; e[45] = fmaxf(a_, b_); e[44] = fminf(a_, b_); }
    { const float a_ = e[47], b_ = e[46]; e[47] = fmaxf(a_, b_); e[46] = fminf(a_, b_); }
    { const float a_ = e[32], b_ = e[36]; e[32] = fmaxf(a_, b_); e[36] = fminf(a_, b_); }
    { const float a_ = e[33], b_ = e[37]; e[33] = fmaxf(a_, b_); e[37] = fminf(a_, b_); }
    { const float a_ = e[34], b_ = e[38]; e[34] = fmaxf(a_, b_); e[38] = fminf(a_, b_); }
    { const float a_ = e[35], b_ = e[39]; e[35] = fmaxf(a_, b_); e[39] = fminf(a_, b_); }
    { const float a_ = e[44], b_ = e[40]; e[44] = fmaxf(a_, b_); e[40] = fminf(a_, b_); }
    { const float a_ = e[45], b_ = e[41]; e[45] = fmaxf(a_, b_); e[41] = fminf(a_, b_); }
    { const float a_ = e[46], b_ = e[42]; e[46] = fmaxf(a_, b_); e[42] = fminf(a_, b_); }
    { const float a_ = e[47], b_ = e[43]; e[47] = fmaxf(a_, b_); e[43] = fminf(a_, b_); }
    { const float a_ = e[32], b_ = e[34]; e[32] = fmaxf(a_, b_); e[34] = fminf(a_, b_); }
    { const float a_ = e[33], b_ = e[35]; e[33] = fmaxf(a_, b_); e[35] = fminf(a_, b_); }
    { const float a_ = e[36], b_ = e[38]; e[36] = fmaxf(a_, b_); e[38] = fminf(a_, b_); }
    { const float a_ = e[37], b_ = e[39]; e[37] = fmaxf(a_, b_); e[39] = fminf(a_, b_); }
    { const float a_ = e[42], b_ = e[40]; e[42] = fmaxf(a_, b_); e[40] = fminf(a_, b_); }
    { const float a_ = e[43], b_ = e[41]; e[43] = fmaxf(a_, b_); e[41] = fminf(a_, b_); }
    { const float a_ = e[46], b_ = e[44]; e[46] = fmaxf(a_, b_); e[44] = fminf(a_, b_); }
    { const float a_ = e[47], b_ = e[45]; e[47] = fmaxf(a_, b_); e[45] = fminf(a_, b_); }
    { const float a_ = e[32], b_ = e[33]; e[32] = fmaxf(a_, b_); e[33] = fminf(a_, b_); }
    { const float a_ = e[34], b_ = e[35]; e[34] = fmaxf(a_, b_); e[35] = fminf(a_, b_); }
    { const float a_ = e[36], b_ = e[37]; e[36] = fmaxf(a_, b_); e[37] = fminf(a_, b_); }
    { const float a_ = e[38], b_ = e[39]; e[38] = fmaxf(a_, b_); e[39] = fminf(a_, b_); }
    { const float a_ = e[41], b_ = e[40]; e[41] = fmaxf(a_, b_); e[40] = fminf(a_, b_); }
    { const float a_ = e[43], b_ = e[42]; e[43] = fmaxf(a_, b_); e[42] = fminf(a_, b_); }
    { const float a_ = e[45], b_ = e[44]; e[45] = fmaxf(a_, b_); e[44] = fminf(a_, b_); }
    { const float a_ = e[47], b_ = e[46]; e[47] = fmaxf(a_, b_); e[46] = fminf(a_, b_); }
    { const float a_ = e[32], b_ = e[40]; e[32] = fmaxf(a_, b_); e[40] = fminf(a_, b_); }
    { const float a_ = e[33], b_ = e[41]; e[33] = fmaxf(a_, b_); e[41] = fminf(a_, b_); }
    { const float a_ = e[34], b_ = e[42]; e[34] = fmaxf(a_, b_); e[42] = fminf(a_, b_); }
    { const float a_ = e[35], b_ = e[43]; e[35] = fmaxf(a_, b_); e[43] = fminf(a_, b_); }
    { const float a_ = e[36], b_ = e[44]; e[36] = fmaxf(a_, b_); e[44] = fminf(a_, b_); }
    { const float a_ = e[37], b_ = e[45]; e[37] = fmaxf(a_, b_); e[45] = fminf(a_, b_); }
    { const float a_ = e[38], b_ = e[46]; e[38] = fmaxf(a_, b_); e[46] = fminf(a_, b_); }
    { const float a_ = e[39], b_ = e[47]; e[39] = fmaxf(a_, b_); e[47] = fminf(a_, b_); }
    { const float a_ = e[32], b_ = e[36]; e[32] = fmaxf(a_, b_); e[36] = fminf(a_, b_); }
    { const float a_ = e[33], b_ = e[37]; e[33] = fmaxf(a_, b_); e[37] = fminf(a_, b_); }
    { const float a_ = e[34], b_ = e[38]; e[34] = fmaxf(a_, b_); e[38] = fminf(a_, b_); }
    { const float a_ = e[35], b_ = e[39]; e[35] = fmaxf(a_, b_); e[39] = fminf(a_, b_); }
    { const float a_ = e[40], b_ = e[44]; e[40] = fmaxf(a_, b_); e[44] = fminf(a_, b_); }
    { const float a_ = e[41], b_ = e[45]; e[41] = fmaxf(a_, b_); e[45] = fminf(a_, b_); }
    { const float a_ = e[42], b_ = e[46]; e[42] = fmaxf(a_, b_); e[46] = fminf(a_, b_); }
    { const float a_ = e[43], b_ = e[47]; e[43] = fmaxf(a_, b_); e[47] = fminf(a_, b_); }
    { const float a_ = e[32], b_ = e[34]; e[32] = fmaxf(a_, b_); e[34] = fminf(a_, b_); }
    { const float a_ = e[33], b_ = e[35]; e[33] = fmaxf(a_, b_); e[35] = fminf(a_, b_); }
    { const float a_ = e[36], b_ = e[38]; e[36] = fmaxf(a_, b_); e[38] = fminf(a_, b_); }
    { const float a_ = e[37], b_ = e[39]; e[37] = fmaxf(a_, b_); e[39] = fminf(a_, b_); }
    { const float a_ = e[40], b_ = e[42]; e[40] = fmaxf(a_, b_); e[42] = fminf(a_, b_); }
    { const float a_ = e[41], b_ = e[43]; e[41] = fmaxf(a_, b_); e[43] = fminf(a_, b_); }
    { const float a_ = e[44], b_ = e[46]; e[44] = fmaxf(a_, b_); e[46] = fminf(a_, b_); }
    { const float a_ = e[45], b_ = e[47]; e[45] = fmaxf(a_, b_); e[47] = fminf(a_, b_); }
    { const float a_ = e[32], b_ = e[33]; e[32] = fmaxf(a_, b_); e[33] = fminf(a_, b_); }
    { const float a_ = e[34], b_ = e[35]; e[34] = fmaxf(a_, b_); e[35] = fminf(a_, b_); }
    { const float a_ = e[36], b_ = e[37]; e[36] = fmaxf(a_, b_); e[37] = fminf(a_, b_); }
    { const float a_ = e[38], b_ = e[39]; e[38] = fmaxf(a_, b_); e[39] = fminf(a_, b_); }
    { const float a_ = e[40], b_ = e[41]; e[40] = fmaxf(a_, b_); e[41] = fminf(a_, b_); }
    { const float a_ = e[42], b_ = e[43]; e[42] = fmaxf(a_, b_); e[43] = fminf(a_, b_); }
    { const float a_ = e[44], b_ = e[45]; e[44] = fmaxf(a_, b_); e[45] = fminf(a_, b_); }
    { const float a_ = e[46], b_ = e[47]; e[46] = fmaxf(a_, b_); e[47] = fminf(a_, b_); }
    { const float a_ = e[48], b_ = e[49]; e[48] = fmaxf(a_, b_); e[49] = fminf(a_, b_); }
    { const float a_ = e[51], b_ = e[50]; e[51] = fmaxf(a_, b_); e[50] = fminf(a_, b_); }
    { const float a_ = e[52], b_ = e[53]; e[52] = fmaxf(a_, b_); e[53] = fminf(a_, b_); }
    { const float a_ = e[55], b_ = e[54]; e[55] = fmaxf(a_, b_); e[54] = fminf(a_, b_); }
    { const float a_ = e[56], b_ = e[57]; e[56] = fmaxf(a_, b_); e[57] = fminf(a_, b_); }
    { const float a_ = e[59], b_ = e[58]; e[59] = fmaxf(a_, b_); e[58] = fminf(a_, b_); }
    { const float a_ = e[60], b_ = e[61]; e[60] = fmaxf(a_, b_); e[61] = fminf(a_, b_); }
    { const float a_ = e[63], b_ = e[62]; e[63] = fmaxf(a_, b_); e[62] = fminf(a_, b_); }
    { const float a_ = e[48], b_ = e[50]; e[48] = fmaxf(a_, b_); e[50] = fminf(a_, b_); }
    { const float a_ = e[49], b_ = e[51]; e[49] = fmaxf(a_, b_); e[51] = fminf(a_, b_); }
    { const float a_ = e[54], b_ = e[52]; e[54] = fmaxf(a_, b_); e[52] = fminf(a_, b_); }
    { const float a_ = e[55], b_ = e[53]; e[55] = fmaxf(a_, b_); e[53] = fminf(a_, b_); }
    { const float a_ = e[56], b_ = e[58]; e[56] = fmaxf(a_, b_); e[58] = fminf(a_, b_); }
    { const float a_ = e[57], b_ = e[59]; e[57] = fmaxf(a_, b_); e[59] = fminf(a_, b_); }
    { const float a_ = e[62], b_ = e[60]; e[62] = fmaxf(a_, b_); e[60] = fminf(a_, b_); }
    { const float a_ = e[63], b_ = e[61]; e[63] = fmaxf(a_, b_); e[61] = fminf(a_, b_); }
    { const float a_ = e[48], b_ = e[49]; e[48] = fmaxf(a_, b_); e[49] = fminf(a_, b_); }
    { const float a_ = e[50], b_ = e[51]; e[50] = fmaxf(a_, b_); e[51] = fminf(a_, b_); }
    { const float a_ = e[53], b_ = e[52]; e[53] = fmaxf(a_, b_); e[52] = fminf(a_, b_); }
    { const float a_ = e[55], b_ = e[54]; e[55] = fmaxf(a_, b_); e[54] = fminf(a_, b_); }
    { const float a_ = e[56], b_ = e[57]; e[56] = fmaxf(a_, b_); e[57] = fminf(a_, b_); }
    { const float a_ = e[58], b_ = e[59]; e[58] = fmaxf(a_, b_); e[59] = fminf(a_, b_); }
    { const float a_ = e[61], b_ = e[60]; e[61] = fmaxf(a_, b_); e[60] = fminf(a_, b_); }
    { const float a_ = e[63], b_ = e[62]; e[63] = fmaxf(a_, b_); e[62] = fminf(a_, b_); }
    { const float a_ = e[48], b_ = e[52]; e[48] = fmaxf(a_, b_); e[52] = fminf(a_, b_); }
    { const float a_ = e[49], b_ = e[53]; e[49] = fmaxf(a_, b_); e[53] = fminf(a_, b_); }
    { const float a_ = e[50], b_ = e[54]; e[50] = fmaxf(a_, b_); e[54] = fminf(a_, b_); }
    { const float a_ = e[51], b_ = e[55]; e[51] = fmaxf(a_, b_); e[55] = fminf(a_, b_); }
    { const float a_ = e[60], b_ = e[56]; e[60] = fmaxf(a_, b_); e[56] = fminf(a_, b_); }
    { const float a_ = e[61], b_ = e[57]; e[61] = fmaxf(a_, b_); e[57] = fminf(a_, b_); }
    { const float a_ = e[62], b_ = e[58]; e[62] = fmaxf(a_, b_); e[58] = fminf(a_, b_); }
    { const float a_ = e[63], b_ = e[59]; e[63] = fmaxf(a_, b_); e[59] = fminf(a_, b_); }
    { const float a_ = e[48], b_ = e[50]; e[48] = fmaxf(a_, b_); e[50] = fminf(a_, b_); }
    { const float a_ = e[49], b_ = e[51]; e[49] = fmaxf(a_, b_); e[51] = fminf(a_, b_); }
    { const float a_ = e[52], b_ = e[54]; e[52] = fmaxf(a_, b_); e[54] = fminf(a_, b_); }
    { const float a_ = e[53], b_ = e[55]; e[53] = fmaxf(a_, b_); e[55] = fminf(a_, b_); }
    { const float a_ = e[58], b_ = e[56]; e[58] = fmaxf(a_, b_); e[56] = fminf(a_, b_); }
    { const float a_ = e[59], b_ = e[57]; e[59] = fmaxf(a_, b_); e[57] = fminf(a_, b_); }
    { const float a_ = e[62], b_ = e[60]; e[62] = fmaxf(a_, b_); e[60] = fminf(a_, b_); }
    { const float a_ = e[63], b_ = e[61]; e[63] = fmaxf(a_, b_); e[61] = fminf(a_, b_); }
    { const float a_ = e[48], b_ = e[49]; e[48] = fmaxf(a_, b_); e[49] = fminf(a_, b_); }
    { const float a_ = e[50], b_ = e[51]; e[50] = fmaxf(a_, b_); e[51] = fminf(a_, b_); }
    { const float a_ = e[52], b_ = e[53]; e[52] = fmaxf(a_, b_); e[53] = fminf(a_, b_); }
    { const float a_ = e[54], b_ = e[55]; e[54] = fmaxf(a_, b_); e[55] = fminf(a_, b_); }
    { const float a_ = e[57], b_ = e[56]; e[57] = fmaxf(a_, b_); e[56] = fminf(a_, b_); }
    { const float a_ = e[59], b_ = e[58]; e[59] = fmaxf(a_, b_); e[58] = fminf(a_, b_); }
    { const float a_ = e[61], b_ = e[60]; e[61] = fmaxf(a_, b_); e[60] = fminf(a_, b_); }
    { const float a_ = e[63], b_ = e[62]; e[63] = fmaxf(a_, b_); e[62] = fminf(a_, b_); }
    { const float a_ = e[48], b_ = e[56]; e[48] = fmaxf(a_, b_); e[56] = fminf(a_, b_); }
    { const float a_ = e[49], b_ = e[57]; e[49] = fmaxf(a_, b_); e[57] = fminf(a_, b_); }
    { const float a_ = e[50], b_ = e[58]; e[50] = fmaxf(a_, b_); e[58] = fminf(a_, b_); }
    { const float a_ = e[51], b_ = e[59]; e[51] = fmaxf(a_, b_); e[59] = fminf(a_, b_); }
    { const float a_ = e[52], b_ = e[60]; e[52] = fmaxf(a_, b_); e[60] = fminf(a_, b_); }
    { const float a_ = e[53], b_ = e[61]; e[53] = fmaxf(a_, b_); e[61] = fminf(a_, b_); }
    { const float a_ = e[54], b_ = e[62]; e[54] = fmaxf(a_, b_); e[62] = fminf(a_, b_); }
    { const float a_ = e[55], b_ = e[63]; e[55] = fmaxf(a_, b_); e[63] = fminf(a_, b_); }
    { const float a_ = e[48], b_ = e[52]; e[48] = fmaxf(a_, b_); e[52] = fminf(a_, b_); }
    { const float a_ = e[49], b_ = e[53]; e[49] = fmaxf(a_, b_); e[53] = fminf(a_, b_); }
    { const float a_ = e[50], b_ = e[54]; e[50] = fmaxf(a_, b_); e[54] = fminf(a_, b_); }
    { const float a_ = e[51], b_ = e[55]; e[51] = fmaxf(a_, b_); e[55] = fminf(a_, b_); }
    { const float a_ = e[56], b_ = e[60]; e[56] = fmaxf(a_, b_); e[60] = fminf(a_, b_); }
    { const float a_ = e[57], b_ = e[61]; e[57] = fmaxf(a_, b_); e[61] = fminf(a_, b_); }
    { const float a_ = e[58], b_ = e[62]; e[58] = fmaxf(a_, b_); e[62] = fminf(a_, b_); }
    { const float a_ = e[59], b_ = e[63]; e[59] = fmaxf(a_, b_); e[63] = fminf(a_, b_); }
    { const float a_ = e[48], b_ = e[50]; e[48] = fmaxf(a_, b_); e[50] = fminf(a_, b_); }
    { const float a_ = e[49], b_ = e[51]; e[49] = fmaxf(a_, b_); e[51] = fminf(a_, b_); }
    { const float a_ = e[52], b_ = e[54]; e[52] = fmaxf(a_, b_); e[54] = fminf(a_, b_); }
    { const float a_ = e[53], b_ = e[55]; e[53] = fmaxf(a_, b_); e[55] = fminf(a_, b_); }
    { const float a_ = e[56], b_ = e[58]; e[56] = fmaxf(a_, b_); e[58] = fminf(a_, b_); }
    { const float a_ = e[57], b_ = e[59]; e[57] = fmaxf(a_, b_); e[59] = fminf(a_, b_); }
    { const float a_ = e[60], b_ = e[62]; e[60] = fmaxf(a_, b_); e[62] = fminf(a_, b_); }
    { const float a_ = e[61], b_ = e[63]; e[61] = fmaxf(a_, b_); e[63] = fminf(a_, b_); }
    { const float a_ = e[48], b_ = e[49]; e[48] = fmaxf(a_, b_); e[49] = fminf(a_, b_); }
    { const float a_ = e[50], b_ = e[51]; e[50] = fmaxf(a_, b_); e[51] = fminf(a_, b_); }
    { const float a_ = e[52], b_ = e[53]; e[52] = fmaxf(a_, b_); e[53] = fminf(a_, b_); }
    { const float a_ = e[54], b_ = e[55]; e[54] = fmaxf(a_, b_); e[55] = fminf(a_, b_); }
    { const float a_ = e[56], b_ = e[57]; e[56] = fmaxf(a_, b_); e[57] = fminf(a_, b_); }
    { const float a_ = e[58], b_ = e[59]; e[58] = fmaxf(a_, b_); e[59] = fminf(a_, b_); }
    { const float a_ = e[60], b_ = e[61]; e[60] = fmaxf(a_, b_); e[61] = fminf(a_, b_); }
    { const float a_ = e[62], b_ = e[63]; e[62] = fmaxf(a_, b_); e[63] = fminf(a_, b_); }
    float t0[16], t1[16];
    t0[0] = fmaxf(e[0], e[31]); t1[0] = fmaxf(e[32], e[63]);
    t0[1] = fmaxf(e[1], e[30]); t1[1] = fmaxf(e[33], e[62]);
    t0[2] = fmaxf(e[2], e[29]); t1[2] = fmaxf(e[34], e[61]);
    t0[3] = fmaxf(e[3], e[28]); t1[3] = fmaxf(e[35], e[60]);
    t0[4] = fmaxf(e[4], e[27]); t1[4] = fmaxf(e[36], e[59]);
    t0[5] = fmaxf(e[5], e[26]); t1[5] = fmaxf(e[37], e[58]);
    t0[6] = fmaxf(e[6], e[25]); t1[6] = fmaxf(e[38], e[57]);
    t0[7] = fmaxf(e[7], e[24]); t1[7] = fmaxf(e[39], e[56]);
    t0[8] = fmaxf(e[8], e[23]); t1[8] = fmaxf(e[40], e[55]);
    t0[9] = fmaxf(e[9], e[22]); t1[9] = fmaxf(e[41], e[54]);
    t0[10] = fmaxf(e[10], e[21]); t1[10] = fmaxf(e[42], e[53]);
    t0[11] = fmaxf(e[11], e[20]); t1[11] = fmaxf(e[43], e[52]);
    t0[12] = fmaxf(e[12], e[19]); t1[12] = fmaxf(e[44], e[51]);
    t0[13] = fmaxf(e[13], e[18]); t1[13] = fmaxf(e[45], e[50]);
    t0[14] = fmaxf(e[14], e[17]); t1[14] = fmaxf(e[46], e[49]);
    t0[15] = fmaxf(e[15], e[16]); t1[15] = fmaxf(e[47], e[48]);
    { const float a_ = t0[0], b_ = t0[8]; t0[0] = fmaxf(a_, b_); t0[8] = fminf(a_, b_); }
    { const float a_ = t0[1], b_ = t0[9]; t0[1] = fmaxf(a_, b_); t0[9] = fminf(a_, b_); }
    { const float a_ = t0[2], b_ = t0[10]; t0[2] = fmaxf(a_, b_); t0[10] = fminf(a_, b_); }
    { const float a_ = t0[3], b_ = t0[11]; t0[3] = fmaxf(a_, b_); t0[11] = fminf(a_, b_); }
    { const float a_ = t0[4], b_ = t0[12]; t0[4] = fmaxf(a_, b_); t0[12] = fminf(a_, b_); }
    { const float a_ = t0[5], b_ = t0[13]; t0[5] = fmaxf(a_, b_); t0[13] = fminf(a_, b_); }
    { const float a_ = t0[6], b_ = t0[14]; t0[6] = fmaxf(a_, b_); t0[14] = fminf(a_, b_); }
    { const float a_ = t0[7], b_ = t0[15]; t0[7] = fmaxf(a_, b_); t0[15] = fminf(a_, b_); }
    { const float a_ = t0[0], b_ = t0[4]; t0[0] = fmaxf(a_, b_); t0[4] = fminf(a_, b_); }
    { const float a_ = t0[1], b_ = t0[5]; t0[1] = fmaxf(a_, b_); t0[5] = fminf(a_, b_); }
    { const float a_ = t0[2], b_ = t0[6]; t0[2] = fmaxf(a_, b_); t0[6] = fminf(a_, b_); }
    { const float a_ = t0[3], b_ = t0[7]; t0[3] = fmaxf(a_, b_); t0[7] = fminf(a_, b_); }
    { const float a_ = t0[8], b_ = t0[12]; t0[8] = fmaxf(a_, b_); t0[12] = fminf(a_, b_); }
    { const float a_ = t0[9], b_ = t0[13]; t0[9] = fmaxf(a_, b_); t0[13] = fminf(a_, b_); }
    { const float a_ = t0[10], b_ = t0[14]; t0[10] = fmaxf(a_, b_); t0[14] = fminf(a_, b_); }
    { const float a_ = t0[11], b_ = t0[15]; t0[11] = fmaxf(a_, b_); t0[15] = fminf(a_, b_); }
    { const float a_ = t0[0], b_ = t0[2]; t0[0] = fmaxf(a_, b_); t0[2] = fminf(a_, b_); }
    { const float a_ = t0[1], b_ = t0[3]; t0[1] = fmaxf(a_, b_); t0[3] = fminf(a_, b_); }
    { const float a_ = t0[4], b_ = t0[6]; t0[4] = fmaxf(a_, b_); t0[6] = fminf(a_, b_); }
    { const float a_ = t0[5], b_ = t0[7]; t0[5] = fmaxf(a_, b_); t0[7] = fminf(a_, b_); }
    { const float a_ = t0[8], b_ = t0[10]; t0[8] = fmaxf(a_, b_); t0[10] = fminf(a_, b_); }
    { const float a_ = t0[9], b_ = t0[11]; t0[9] = fmaxf(a_, b_); t0[11] = fminf(a_, b_); }
    { const float a_ = t0[12], b_ = t0[14]; t0[12] = fmaxf(a_, b_); t0[14] = fminf(a_, b_); }
    { const float a_ = t0[13], b_ = t0[15]; t0[13] = fmaxf(a_, b_); t0[15] = fminf(a_, b_); }
    { const float a_ = t0[0], b_ = t0[1]; t0[0] = fmaxf(a_, b_); t0[1] = fminf(a_, b_); }
    { const float a_ = t0[2], b_ = t0[3]; t0[2] = fmaxf(a_, b_); t0[3] = fminf(a_, b_); }
    { const float a_ = t0[4], b_ = t0[5]; t0[4] = fmaxf(a_, b_); t0[5] = fminf(a_, b_); }
    { const float a_ = t0[6], b_ = t0[7]; t0[6] = fmaxf(a_, b_); t0[7] = fminf(a_, b_); }
    { const float a_ = t0[8], b_ = t0[9]; t0[8] = fmaxf(a_, b_); t0[9] = fminf(a_, b_); }
    { const float a_ = t0[10], b_ = t0[11]; t0[10] = fmaxf(a_, b_); t0[11] = fminf(a_, b_); }
    { const float a_ = t0[12], b_ = t0[13]; t0[12] = fmaxf(a_, b_); t0[13] = fminf(a_, b_); }
    { const float a_ = t0[14], b_ = t0[15]; t0[14] = fmaxf(a_, b_); t0[15] = fminf(a_, b_); }
    { const float a_ = t1[0], b_ = t1[8]; t1[0] = fmaxf(a_, b_); t1[8] = fminf(a_, b_); }
    { const float a_ = t1[1], b_ = t1[9]; t1[1] = fmaxf(a_, b_); t1[9] = fminf(a_, b_); }
    { const float a_ = t1[2], b_ = t1[10]; t1[2] = fmaxf(a_, b_); t1[10] = fminf(a_, b_); }
    { const float a_ = t1[3], b_ = t1[11]; t1[3] = fmaxf(a_, b_); t1[11] = fminf(a_, b_); }
    { const float a_ = t1[4], b_ = t1[12]; t1[4] = fmaxf(a_, b_); t1[12] = fminf(a_, b_); }
    { const float a_ = t1[5], b_ = t1[13]; t1[5] = fmaxf(a_, b_); t1[13] = fminf(a_, b_); }
    { const float a_ = t1[6], b_ = t1[14]; t1[6] = fmaxf(a_, b_); t1[14] = fminf(a_, b_); }
    { const float a_ = t1[7], b_ = t1[15]; t1[7] = fmaxf(a_, b_); t1[15] = fminf(a_, b_); }
    { const float a_ = t1[0], b_ = t1[4]; t1[0] = fmaxf(a_, b_); t1[4] = fminf(a_, b_); }
    { const float a_ = t1[1], b_ = t1[5]; t1[1] = fmaxf(a_, b_); t1[5] = fminf(a_, b_); }
    { const float a_ = t1[2], b_ = t1[6]; t1[2] = fmaxf(a_, b_); t1[6] = fminf(a_, b_); }
    { const float a_ = t1[3], b_ = t1[7]; t1[3] = fmaxf(a_, b_); t1[7] = fminf(a_, b_); }
    { const float a_ = t1[8], b_ = t1[12]; t1[8] = fmaxf(a_, b_); t1[12] = fminf(a_, b_); }
    { const float a_ = t1[9], b_ = t1[13]; t1[9] = fmaxf(a_, b_); t1[13] = fminf(a_, b_); }
    { const float a_ = t1[10], b_ = t1[14]; t1[10] = fmaxf(a_, b_); t1[14] = fminf(a_, b_); }
    { const float a_ = t1[11], b_ = t1[15]; t1[11] = fmaxf(a_, b_); t1[15] = fminf(a_, b_); }
    { const float a_ = t1[0], b_ = t1[2]; t1[0] = fmaxf(a_, b_); t1[2] = fminf(a_, b_); }
    { const float a_ = t1[1], b_ = t1[3]; t1[1] = fmaxf(a_, b_); t1[3] = fminf(a_, b_); }
    { const float a_ = t1[4], b_ = t1[6]; t1[4] = fmaxf(a_, b_); t1[6] = fminf(a_, b_); }
    { const float a_ = t1[5], b_ = t1[7]; t1[5] = fmaxf(a_, b_); t1[7] = fminf(a_, b_); }
    { const float a_ = t1[8], b_ = t1[10]; t1[8] = fmaxf(a_, b_); t1[10] = fminf(a_, b_); }
    { const float a_ = t1[9], b_ = t1[11]; t1[9] = fmaxf(a_, b_); t1[11] = fminf(a_, b_); }
    { const float a_ = t1[12], b_ = t1[14]; t1[12] = fmaxf(a_, b_); t1[14] = fminf(a_, b_); }
    { const float a_ = t1[13], b_ = t1[15]; t1[13] = fmaxf(a_, b_); t1[15] = fminf(a_, b_); }
    { const float a_ = t1[0], b_ = t1[1]; t1[0] = fmaxf(a_, b_); t1[1] = fminf(a_, b_); }
    { const float a_ = t1[2], b_ = t1[3]; t1[2] = fmaxf(a_, b_); t1[3] = fminf(a_, b_); }
    { const float a_ = t1[4], b_ = t1[5]; t1[4] = fmaxf(a_, b_); t1[5] = fminf(a_, b_); }
    { const float a_ = t1[6], b_ = t1[7]; t1[6] = fmaxf(a_, b_); t1[7] = fminf(a_, b_); }
    { const float a_ = t1[8], b_ = t1[9]; t1[8] = fmaxf(a_, b_); t1[9] = fminf(a_, b_); }
    { const float a_ = t1[10], b_ = t1[11]; t1[10] = fmaxf(a_, b_); t1[11] = fminf(a_, b_); }
    { const float a_ = t1[12], b_ = t1[13]; t1[12] = fmaxf(a_, b_); t1[13] = fminf(a_, b_); }
    { const float a_ = t1[14], b_ = t1[15]; t1[14] = fmaxf(a_, b_); t1[15] = fminf(a_, b_); }
    float u[16];
    u[0] = fmaxf(t0[0], t1[15]);
    u[1] = fmaxf(t0[1], t1[14]);
    u[2] = fmaxf(t0[2], t1[13]);
    u[3] = fmaxf(t0[3], t1[12]);
    u[4] = fmaxf(t0[4], t1[11]);
    u[5] = fmaxf(t0[5], t1[10]);
    u[6] = fmaxf(t0[6], t1[9]);
    u[7] = fmaxf(t0[7], t1[8]);
    u[8] = fmaxf(t0[8], t1[7]);
    u[9] = fmaxf(t0[9], t1[6]);
    u[10] = fmaxf(t0[10], t1[5]);
    u[11] = fmaxf(t0[11], t1[4]);
    u[12] = fmaxf(t0[12], t1[3]);
    u[13] = fmaxf(t0[13], t1[2]);
    u[14] = fmaxf(t0[14], t1[1]);
    u[15] = fmaxf(t0[15], t1[0]);
    { const float a_ = u[0], b_ = u[8]; u[0] = fmaxf(a_, b_); u[8] = fminf(a_, b_); }
    { const float a_ = u[1], b_ = u[9]; u[1] = fmaxf(a_, b_); u[9] = fminf(a_, b_); }
    { const float a_ = u[2], b_ = u[10]; u[2] = fmaxf(a_, b_); u[10] = fminf(a_, b_); }
    { const float a_ = u[3], b_ = u[11]; u[3] = fmaxf(a_, b_); u[11] = fminf(a_, b_); }
    { const float a_ = u[4], b_ = u[12]; u[4] = fmaxf(a_, b_); u[12] = fminf(a_, b_); }
    { const float a_ = u[5], b_ = u[13]; u[5] = fmaxf(a_, b_); u[13] = fminf(a_, b_); }
    { const float a_ = u[6], b_ = u[14]; u[6] = fmaxf(a_, b_); u[14] = fminf(a_, b_); }
    { const float a_ = u[7], b_ = u[15]; u[7] = fmaxf(a_, b_); u[15] = fminf(a_, b_); }
    { const float a_ = u[0], b_ = u[4]; u[0] = fmaxf(a_, b_); u[4] = fminf(a_, b_); }
    { const float a_ = u[1], b_ = u[5]; u[1] = fmaxf(a_, b_); u[5] = fminf(a_, b_); }
    { const float a_ = u[2], b_ = u[6]; u[2] = fmaxf(a_, b_); u[6] = fminf(a_, b_); }
    { const float a_ = u[3], b_ = u[7]; u[3] = fmaxf(a_, b_); u[7] = fminf(a_, b_); }
    { const float a_ = u[8], b_ = u[12]; u[8] = fmaxf(a_, b_); u[12] = fminf(a_, b_); }
    { const float a_ = u[9], b_ = u[13]; u[9] = fmaxf(a_, b_); u[13] = fminf(a_, b_); }
    { const float a_ = u[10], b_ = u[14]; u[10] = fmaxf(a_, b_); u[14] = fminf(a_, b_); }
    { const float a_ = u[11], b_ = u[15]; u[11] = fmaxf(a_, b_); u[15] = fminf(a_, b_); }
    { const float a_ = u[0], b_ = u[2]; u[0] = fmaxf(a_, b_); u[2] = fminf(a_, b_); }
    { const float a_ = u[1], b_ = u[3]; u[1] = fmaxf(a_, b_); u[3] = fminf(a_, b_); }
    { const float a_ = u[4], b_ = u[6]; u[4] = fmaxf(a_, b_); u[6] = fminf(a_, b_); }
    { const float a_ = u[5], b_ = u[7]; u[5] = fmaxf(a_, b_); u[7] = fminf(a_, b_); }
    { const float a_ = u[8], b_ = u[10]; u[8] = fmaxf(a_, b_); u[10] = fminf(a_, b_); }
    { const float a_ = u[9], b_ = u[11]; u[9] = fmaxf(a_, b_); u[11] = fminf(a_, b_); }
    { const float a_ = u[12], b_ = u[14]; u[12] = fmaxf(a_, b_); u[14] = fminf(a_, b_); }
    { const float a_ = u[13], b_ = u[15]; u[13] = fmaxf(a_, b_); u[15] = fminf(a_, b_); }
    { const float a_ = u[0], b_ = u[1]; u[0] = fmaxf(a_, b_); u[1] = fminf(a_, b_); }
    { const float a_ = u[2], b_ = u[3]; u[2] = fmaxf(a_, b_); u[3] = fminf(a_, b_); }
    { const float a_ = u[4], b_ = u[5]; u[4] = fmaxf(a_, b_); u[5] = fminf(a_, b_); }
    { const float a_ = u[6], b_ = u[7]; u[6] = fmaxf(a_, b_); u[7] = fminf(a_, b_); }
    { const float a_ = u[8], b_ = u[9]; u[8] = fmaxf(a_, b_); u[9] = fminf(a_, b_); }
    { const float a_ = u[10], b_ = u[11]; u[10] = fmaxf(a_, b_); u[11] = fminf(a_, b_); }
    { const float a_ = u[12], b_ = u[13]; u[12] = fmaxf(a_, b_); u[13] = fminf(a_, b_); }
    { const float a_ = u[14], b_ = u[15]; u[14] = fmaxf(a_, b_); u[15] = fminf(a_, b_); }
    float w[16];
    { auto r_ = __builtin_amdgcn_permlane32_swap(__float_as_uint(u[15]), __float_as_uint(u[15]), false, false); w[0] = fmaxf(u[0], __uint_as_float(hi ? r_[0] : r_[1])); }
    { auto r_ = __builtin_amdgcn_permlane32_swap(__float_as_uint(u[14]), __float_as_uint(u[14]), false, false); w[1] = fmaxf(u[1], __uint_as_float(hi ? r_[0] : r_[1])); }
    { auto r_ = __builtin_amdgcn_permlane32_swap(__float_as_uint(u[13]), __float_as_uint(u[13]), false, false); w[2] = fmaxf(u[2], __uint_as_float(hi ? r_[0] : r_[1])); }
    { auto r_ = __builtin_amdgcn_permlane32_swap(__float_as_uint(u[12]), __float_as_uint(u[12]), false, false); w[3] = fmaxf(u[3], __uint_as_float(hi ? r_[0] : r_[1])); }
    { auto r_ = __builtin_amdgcn_permlane32_swap(__float_as_uint(u[11]), __float_as_uint(u[11]), false, false); w[4] = fmaxf(u[4], __uint_as_float(hi ? r_[0] : r_[1])); }
    { auto r_ = __builtin_amdgcn_permlane32_swap(__float_as_uint(u[10]), __float_as_uint(u[10]), false, false); w[5] = fmaxf(u[5], __uint_as_float(hi ? r_[0] : r_[1])); }
    { auto r_ = __builtin_amdgcn_permlane32_swap(__float_as_uint(u[9]), __float_as_uint(u[9]), false, false); w[6] = fmaxf(u[6], __uint_as_float(hi ? r_[0] : r_[1])); }
    { auto r_ = __builtin_amdgcn_permlane32_swap(__float_as_uint(u[8]), __float_as_uint(u[8]), false, false); w[7] = fmaxf(u[7], __uint_as_float(hi ? r_[0] : r_[1])); }
    { auto r_ = __builtin_amdgcn_permlane32_swap(__float_as_uint(u[7]), __float_as_uint(u[7]), false, false); w[8] = fmaxf(u[8], __uint_as_float(hi ? r_[0] : r_[1])); }
    { auto r_ = __builtin_amdgcn_permlane32_swap(__float_as_uint(u[6]), __float_as_uint(u[6]), false, false); w[9] = fmaxf(u[9], __uint_as_float(hi ? r_[0] : r_[1])); }
    { auto r_ = __builtin_amdgcn_permlane32_swap(__float_as_uint(u[5]), __float_as_uint(u[5]), false, false); w[10] = fmaxf(u[10], __uint_as_float(hi ? r_[0] : r_[1])); }
    { auto r_ = __builtin_amdgcn_permlane32_swap(__float_as_uint(u[4]), __float_as_uint(u[4]), false, false); w[11] = fmaxf(u[11], __uint_as_float(hi ? r_[0] : r_[1])); }
    { auto r_ = __builtin_amdgcn_permlane32_swap(__float_as_uint(u[3]), __float_as_uint(u[3]), false, false); w[12] = fmaxf(u[12], __uint_as_float(hi ? r_[0] : r_[1])); }
    { auto r_ = __builtin_amdgcn_permlane32_swap(__float_as_uint(u[2]), __float_as_uint(u[2]), false, false); w[13] = fmaxf(u[13], __uint_as_float(hi ? r_[0] : r_[1])); }
    { auto r_ = __builtin_amdgcn_permlane32_swap(__float_as_uint(u[1]), __float_as_uint(u[1]), false, false); w[14] = fmaxf(u[14], __uint_as_float(hi ? r_[0] : r_[1])); }
    { auto r_ = __builtin_amdgcn_permlane32_swap(__float_as_uint(u[0]), __float_as_uint(u[0]), false, false); w[15] = fmaxf(u[15], __uint_as_float(hi ? r_[0] : r_[1])); }
    { const float a_ = w[0], b_ = w[8]; w[0] = fmaxf(a_, b_); w[8] = fminf(a_, b_); }
    { const float a_ = w[1], b_ = w[9]; w[1] = fmaxf(a_, b_); w[9] = fminf(a_, b_); }
    { const float a_ = w[2], b_ = w[10]; w[2] = fmaxf(a_, b_); w[10] = fminf(a_, b_); }
    { const float a_ = w[3], b_ = w[11]; w[3] = fmaxf(a_, b_); w[11] = fminf(a_, b_); }
    { const float a_ = w[4], b_ = w[12]; w[4] = fmaxf(a_, b_); w[12] = fminf(a_, b_); }
    { const float a_ = w[5], b_ = w[13]; w[5] = fmaxf(a_, b_); w[13] = fminf(a_, b_); }
    { const float a_ = w[6], b_ = w[14]; w[6] = fmaxf(a_, b_); w[14] = fminf(a_, b_); }
    { const float a_ = w[7], b_ = w[15]; w[7] = fmaxf(a_, b_); w[15] = fminf(a_, b_); }
    { const float a_ = w[0], b_ = w[4]; w[0] = fmaxf(a_, b_); w[4] = fminf(a_, b_); }
    { const float a_ = w[1], b_ = w[5]; w[1] = fmaxf(a_, b_); w[5] = fminf(a_, b_); }
    { const float a_ = w[2], b_ = w[6]; w[2] = fmaxf(a_, b_); w[6] = fminf(a_, b_); }
    { const float a_ = w[3], b_ = w[7]; w[3] = fmaxf(a_, b_); w[7] = fminf(a_, b_); }
    { const float a_ = w[8], b_ = w[12]; w[8] = fmaxf(a_, b_); w[12] = fminf(a_, b_); }
    { const float a_ = w[9], b_ = w[13]; w[9] = fmaxf(a_, b_); w[13] = fminf(a_, b_); }
    { const float a_ = w[10], b_ = w[14]; w[10] = fmaxf(a_, b_); w[14] = fminf(a_, b_); }
    { const float a_ = w[11], b_ = w[15]; w[11] = fmaxf(a_, b_); w[15] = fminf(a_, b_); }
    { const float a_ = w[0], b_ = w[2]; w[0] = fmaxf(a_, b_); w[2] = fminf(a_, b_); }
    { const float a_ = w[1], b_ = w[3]; w[1] = fmaxf(a_, b_); w[3] = fminf(a_, b_); }
    { const float a_ = w[4], b_ = w[6]; w[4] = fmaxf(a_, b_); w[6] = fminf(a_, b_); }
    { const float a_ = w[5], b_ = w[7]; w[5] = fmaxf(a_, b_); w[7] = fminf(a_, b_); }
    { const float a_ = w[8], b_ = w[10]; w[8] = fmaxf(a_, b_); w[10] = fminf(a_, b_); }
    { const float a_ = w[9], b_ = w[11]; w[9] = fmaxf(a_, b_); w[11] = fminf(a_, b_); }
    { const float a_ = w[12], b_ = w[14]; w[12] = fmaxf(a_, b_); w[14] = fminf(a_, b_); }
    { const float a_ = w[13], b_ = w[15]; w[13] = fmaxf(a_, b_); w[15] = fminf(a_, b_); }
    { const float a_ = w[0], b_ = w[1]; w[0] = fmaxf(a_, b_); w[1] = fminf(a_, b_); }
    { const float a_ = w[2], b_ = w[3]; w[2] = fmaxf(a_, b_); w[3] = fminf(a_, b_); }
    { const float a_ = w[4], b_ = w[5]; w[4] = fmaxf(a_, b_); w[5] = fminf(a_, b_); }
    { const float a_ = w[6], b_ = w[7]; w[6] = fmaxf(a_, b_); w[7] = fminf(a_, b_); }
    { const float a_ = w[8], b_ = w[9]; w[8] = fmaxf(a_, b_); w[9] = fminf(a_, b_); }
    { const float a_ = w[10], b_ = w[11]; w[10] = fmaxf(a_, b_); w[11] = fminf(a_, b_); }
    { const float a_ = w[12], b_ = w[13]; w[12] = fmaxf(a_, b_); w[13] = fminf(a_, b_); }
    { const float a_ = w[14], b_ = w[15]; w[14] = fmaxf(a_, b_); w[15] = fminf(a_, b_); }
    if (hi == 0) {
#pragma unroll
        for (int it = 0; it < 16; ++it) { const unsigned k_ = __float_as_uint(w[it]); vout[it * 32 + r32] = __uint_as_float(k_ & 0xffffff80u); iout[it * 32 + r32] = (int)(k_ & 127u); }
    }
}
__device__ __forceinline__ void peer_retrieve(const bf16* KEYB, const bf16* PQ, LAS char* wbase, int t0, int lane0) {
    LAS int* elist = (LAS int*)wbase; LAS float* glist = (LAS float*)(wbase + 2048); LAS float* vtab = (LAS float*)(wbase + 4608); LAS int* itab = (LAS int*)(wbase + 4608 + 4096);
        {
            int lv = lane0; asm volatile("" : "+v"(lv));
            const int r32 = lv & 31, hi = lv >> 5;
            const int tt = r32 >> 3, hd = r32 & 7;
#pragma unroll 1
            for (int side = 0; side < 2; ++side) {
                bf16x8 qf[8];
#pragma unroll
                for (int ks = 0; ks < 8; ++ks) qf[ks] = *(const bf16x8*)(PQ + (size_t)(t0 + tt) * DM + hd * 256 + side * 128 + 16 * ks + 8 * hi);
                f32x16 acc[4];
                bf16x8 ka[8], kn[8];
#pragma unroll
                for (int ks = 0; ks < 8; ++ks) ka[ks] = *(const bf16x8*)(KEYB + (size_t)(side * 128 + r32) * 128 + ks * 16 + hi * 8);
#pragma unroll
                for (int b = 0; b < 4; ++b) {
#pragma unroll
                    for (int r = 0; r < 16; ++r) acc[b][r] = 0.f;
                    if (b < 3) {
#pragma unroll
                        for (int ks = 0; ks < 8; ++ks) kn[ks] = *(const bf16x8*)(KEYB + (size_t)(side * 128 + 32 * (b + 1) + r32) * 128 + ks * 16 + hi * 8); }
                    __builtin_amdgcn_sched_barrier(0);
#pragma unroll
                    for (int ks = 0; ks < 8; ++ks) acc[b] = MFMA32(ka[ks], qf[ks], acc[b]);
                    __builtin_amdgcn_sched_barrier(0);
                    if (b < 3) {
#pragma unroll
                        for (int ks = 0; ks < 8; ++ks) ka[ks] = kn[ks]; }
                }
                top16_of_128(acc, vtab + side * 512, itab + side * 512, r32, hi);
            }
            asm volatile("s_waitcnt lgkmcnt(0)" ::: "memory"); __builtin_amdgcn_wave_barrier();
            float cs[25]; int ce[25];
    cs[0] = hi ? (vtab[0 + r32] + vtab[544 + r32]) : (vtab[0 + r32] + vtab[512 + r32]); ce[0] = hi ? (itab[0 + r32] * 128 + itab[544 + r32]) : (itab[0 + r32] * 128 + itab[512 + r32]);
    cs[1] = hi ? (vtab[0 + r32] + vtab[608 + r32]) : (vtab[0 + r32] + vtab[576 + r32]); ce[1] = hi ? (itab[0 + r32] * 128 + itab[608 + r32]) : (itab[0 + r32] * 128 + itab[576 + r32]);
    cs[2] = hi ? (vtab[0 + r32] + vtab[672 + r32]) : (vtab[0 + r32] + vtab[640 + r32]); ce[2] = hi ? (itab[0 + r32] * 128 + itab[672 + r32]) : (itab[0 + r32] * 128 + itab[640 + r32]);
    cs[3] = hi ? (vtab[0 + r32] + vtab[736 + r32]) : (vtab[0 + r32] + vtab[704 + r32]); ce[3] = hi ? (itab[0 + r32] * 128 + itab[736 + r32]) : (itab[0 + r32] * 128 + itab[704 + r32]);
    cs[4] = hi ? (vtab[0 + r32] + vtab[800 + r32]) : (vtab[0 + r32] + vtab[768 + r32]); ce[4] = hi ? (itab[0 + r32] * 128 + itab[800 + r32]) : (itab[0 + r32] * 128 + itab[768 + r32]);
    cs[5] = hi ? (vtab[0 + r32] + vtab[864 + r32]) : (vtab[0 + r32] + vtab[832 + r32]); ce[5] = hi ? (itab[0 + r32] * 128 + itab[864 + r32]) : (itab[0 + r32] * 128 + itab[832 + r32]);
    cs[6] = hi ? (vtab[0 + r32] + vtab[928 + r32]) : (vtab[0 + r32] + vtab[896 + r32]); ce[6] = hi ? (itab[0 + r32] * 128 + itab[928 + r32]) : (itab[0 + r32] * 128 + itab[896 + r32]);
    cs[7] = hi ? (vtab[0 + r32] + vtab[992 + r32]) : (vtab[0 + r32] + vtab[960 + r32]); ce[7] = hi ? (itab[0 + r32] * 128 + itab[992 + r32]) : (itab[0 + r32] * 128 + itab[960 + r32]);
    cs[8] = hi ? (vtab[32 + r32] + vtab[544 + r32]) : (vtab[32 + r32] + vtab[512 + r32]); ce[8] = hi ? (itab[32 + r32] * 128 + itab[544 + r32]) : (itab[32 + r32] * 128 + itab[512 + r32]);
    cs[9] = hi ? (vtab[32 + r32] + vtab[608 + r32]) : (vtab[32 + r32] + vtab[576 + r32]); ce[9] = hi ? (itab[32 + r32] * 128 + itab[608 + r32]) : (itab[32 + r32] * 128 + itab[576 + r32]);
    cs[10] = hi ? (vtab[32 + r32] + vtab[672 + r32]) : (vtab[32 + r32] + vtab[640 + r32]); ce[10] = hi ? (itab[32 + r32] * 128 + itab[672 + r32]) : (itab[32 + r32] * 128 + itab[640 + r32]);
    cs[11] = hi ? (vtab[32 + r32] + vtab[736 + r32]) : (vtab[32 + r32] + vtab[704 + r32]); ce[11] = hi ? (itab[32 + r32] * 128 + itab[736 + r32]) : (itab[32 + r32] * 128 + itab[704 + r32]);
    cs[12] = hi ? (vtab[64 + r32] + vtab[544 + r32]) : (vtab[64 + r32] + vtab[512 + r32]); ce[12] = hi ? (itab[64 + r32] * 128 + itab[544 + r32]) : (itab[64 + r32] * 128 + itab[512 + r32]);
    cs[13] = hi ? (vtab[64 + r32] + vtab[608 + r32]) : (vtab[64 + r32] + vtab[576 + r32]); ce[13] = hi ? (itab[64 + r32] * 128 + itab[608 + r32]) : (itab[64 + r32] * 128 + itab[576 + r32]);
    cs[14] = hi ? (vtab[96 + r32] + vtab[512 + r32]) : (vtab[64 + r32] + vtab[640 + r32]); ce[14] = hi ? (itab[96 + r32] * 128 + itab[512 + r32]) : (itab[64 + r32] * 128 + itab[640 + r32]);
    cs[15] = hi ? (vtab[96 + r32] + vtab[576 + r32]) : (vtab[96 + r32] + vtab[544 + r32]); ce[15] = hi ? (itab[96 + r32] * 128 + itab[576 + r32]) : (itab[96 + r32] * 128 + itab[544 + r32]);
    cs[16] = hi ? (vtab[128 + r32] + vtab[512 + r32]) : (vtab[96 + r32] + vtab[608 + r32]); ce[16] = hi ? (itab[128 + r32] * 128 + itab[512 + r32]) : (itab[96 + r32] * 128 + itab[608 + r32]);
    cs[17] = hi ? (vtab[128 + r32] + vtab[576 + r32]) : (vtab[128 + r32] + vtab[544 + r32]); ce[17] = hi ? (itab[128 + r32] * 128 + itab[576 + r32]) : (itab[128 + r32] * 128 + itab[544 + r32]);
    cs[18] = hi ? (vtab[160 + r32] + vtab[544 + r32]) : (vtab[160 + r32] + vtab[512 + r32]); ce[18] = hi ? (itab[160 + r32] * 128 + itab[544 + r32]) : (itab[160 + r32] * 128 + itab[512 + r32]);
    cs[19] = hi ? (vtab[192 + r32] + vtab[544 + r32]) : (vtab[192 + r32] + vtab[512 + r32]); ce[19] = hi ? (itab[192 + r32] * 128 + itab[544 + r32]) : (itab[192 + r32] * 128 + itab[512 + r32]);
    cs[20] = hi ? (vtab[224 + r32] + vtab[544 + r32]) : (vtab[224 + r32] + vtab[512 + r32]); ce[20] = hi ? (itab[224 + r32] * 128 + itab[544 + r32]) : (itab[224 + r32] * 128 + itab[512 + r32]);
    cs[21] = hi ? (vtab[288 + r32] + vtab[512 + r32]) : (vtab[256 + r32] + vtab[512 + r32]); ce[21] = hi ? (itab[288 + r32] * 128 + itab[512 + r32]) : (itab[256 + r32] * 128 + itab[512 + r32]);
    cs[22] = hi ? (vtab[352 + r32] + vtab[512 + r32]) : (vtab[320 + r32] + vtab[512 + r32]); ce[22] = hi ? (itab[352 + r32] * 128 + itab[512 + r32]) : (itab[320 + r32] * 128 + itab[512 + r32]);
    cs[23] = hi ? (vtab[416 + r32] + vtab[512 + r32]) : (vtab[384 + r32] + vtab[512 + r32]); ce[23] = hi ? (itab[416 + r32] * 128 + itab[512 + r32]) : (itab[384 + r32] * 128 + itab[512 + r32]);
    cs[24] = hi ? (vtab[480 + r32] + vtab[512 + r32]) : (vtab[448 + r32] + vtab[512 + r32]); ce[24] = hi ? (itab[480 + r32] * 128 + itab[512 + r32]) : (itab[448 + r32] * 128 + itab[512 + r32]);
            float sum = 0.f, top = 0.f;
#pragma unroll 1
            for (int it = 0; it < 16; ++it) {
                float lm = cs[0];
#pragma unroll
                for (int j = 1; j < 25; ++j) lm = fmaxf(lm, cs[j]);
                float pm; { auto r_ = __builtin_amdgcn_permlane32_swap(__float_as_uint(lm), __float_as_uint(lm), false, false); pm = __uint_as_float(hi ? r_[0] : r_[1]); } const float gm = fmaxf(lm, pm);
                const bool mine = (lm == gm) && !(pm == gm && hi == 1);
                int me = -1; bool found = false;
#pragma unroll
                for (int j = 0; j < 25; ++j) { const bool hit = mine && !found && cs[j] == gm; if (hit) { cs[j] = -INFINITY; me = ce[j]; found = true; } }
                if (it == 0) top = gm;
                const float p = __expf(gm - top); sum += p;
                if (mine) { elist[tt * 128 + hd * 16 + it] = me; glist[tt * 128 + hd * 16 + it] = p; }
            }
            asm volatile("s_waitcnt lgkmcnt(0)" ::: "memory"); __builtin_amdgcn_wave_barrier();
            const float isum = 1.f / sum;
            if (hi == 0) {
#pragma unroll
                for (int k = 0; k < 16; ++k) glist[tt * 128 + hd * 16 + k] *= isum;
            }
            asm volatile("s_waitcnt lgkmcnt(0)" ::: "memory"); __builtin_amdgcn_wave_barrier();
        }
}
__device__ __forceinline__ void quant_row(const float* src, unsigned char* dstbase, int rr, float* scale, int lane, bool uns) {
    f32x4 v[2][4]; float amax = 0.f;
#pragma unroll
    for (int c = 0; c < 2; ++c)
#pragma unroll
        for (int k = 0; k < 4; ++k) { v[c][k] = *(const f32x4*)(src + 1024 * c + 16 * lane + 4 * k); amax = fmaxf(amax, fmaxf(fmaxf(fabsf(v[c][k].x), fabsf(v[c][k].y)), fmaxf(fabsf(v[c][k].z), fabsf(v[c][k].w)))); }
    amax = wave_max(amax); const float s = amax > 0.f ? amax * (1.f / 127.f) : 1.f, is = 1.f / s; const int ofs = uns ? 128 : 0;
#pragma unroll
    for (int c = 0; c < 2; ++c) { u32x4 o; unsigned wv[4];
#pragma unroll
        for (int k = 0; k < 4; ++k) { const int q0 = (int)rintf(v[c][k].x * is) + ofs, q1 = (int)rintf(v[c][k].y * is) + ofs, q2 = (int)rintf(v[c][k].z * is) + ofs, q3 = (int)rintf(v[c][k].w * is) + ofs;
            wv[k] = (unsigned)(q0 & 255) | ((unsigned)(q1 & 255) << 8) | ((unsigned)(q2 & 255) << 16) | ((unsigned)(q3 & 255) << 24); }
        o.x = wv[0]; o.y = wv[1]; o.z = wv[2]; o.w = wv[3];
        unsigned char* d = uns ? dstbase + (WS_VQS - WS_VQ) + (size_t)(4 * c + (lane >> 4)) * (4 * MiB) + (size_t)rr * 256 + 16 * (lane & 15) : dstbase + (size_t)rr * DM + 1024 * c + 16 * lane;
        *(u32x4*)d = o;
    }
    if (lane == 0) *scale = s;
}
__device__ __forceinline__ void cvt_f32_bf16(const float* src, bf16* dst, size_t n, size_t thr, size_t nthr) {
    for (size_t i = thr * 8; i < n; i += nthr * 8) { const f32x4 a = *(const f32x4*)(src + i), b = *(const f32x4*)(src + i + 4); u32x4 o; o.x = pk2(a.x, a.y); o.y = pk2(a.z, a.w); o.z = pk2(b.x, b.y); o.w = pk2(b.z, b.w); *(u32x4*)(dst + i) = o; }
}
constexpr size_t WS_PE = 320 * MiB, WS_PG = 324 * MiB, WS_PW = 328 * MiB, WS_XQ8 = 332 * MiB, WS_SX = 348 * MiB, WS_SSP = 349 * MiB;
#define PEER_LOADG(buf, en, g, TAB) do { _Pragma("unroll") for (int i = 0; i < 4; ++i) { const unsigned e_ = (unsigned)__builtin_amdgcn_readfirstlane((int)list[4 * (g) + i]); en[i] = e_; \
        const unsigned char* row = TAB + (size_t)(e_ & 0x3fffu) * DM + 16 * lane; buf[i][0] = *(const u32x4*)row; buf[i][1] = *(const u32x4*)(row + 1024); } __builtin_amdgcn_sched_barrier(0); } while (0)
#define PEER_SWEEP(gs, ge, LOADM, COMPM) do { const int gs_ = (gs), ge_ = (ge); \
        if (gs_ < ge_) { const int gl_ = ge_ - 1; \
            LOADM(ba, ena, gs_); LOADM(bb, enb, (gs_ + 1 < ge_ ? gs_ + 1 : gl_)); \
            for (int g = gs_; g < ge_; g += 2) { \
                COMPM(ba, ena); LOADM(ba, ena, (g + 2 < ge_ ? g + 2 : gl_)); \
                if (g + 1 < ge_) COMPM(bb, enb); LOADM(bb, enb, (g + 3 < ge_ ? g + 3 : gl_)); } } } while (0)
#define PEER_LOADU(buf, en, g) PEER_LOADG(buf, en, g, UQ)
#define PEER_COMPU(buf, en) do { int dd[4]; \
        _Pragma("unroll") for (int i = 0; i < 4; ++i) { const int tt_ = (int)((en[i] >> 21) & 3u); \
            const u32x4 x0_ = xqL[(tt_ * 2) * 64 + lane], x1_ = xqL[(tt_ * 2 + 1) * 64 + lane]; int d = 0; \
            d = __builtin_amdgcn_sdot4((int)buf[i][0].x, (int)x0_.x, d, false); d = __builtin_amdgcn_sdot4((int)buf[i][0].y, (int)x0_.y, d, false); \
            d = __builtin_amdgcn_sdot4((int)buf[i][0].z, (int)x0_.z, d, false); d = __builtin_amdgcn_sdot4((int)buf[i][0].w, (int)x0_.w, d, false); \
            d = __builtin_amdgcn_sdot4((int)buf[i][1].x, (int)x1_.x, d, false); d = __builtin_amdgcn_sdot4((int)buf[i][1].y, (int)x1_.y, d, false); \
            d = __builtin_amdgcn_sdot4((int)buf[i][1].z, (int)x1_.z, d, false); d = __builtin_amdgcn_sdot4((int)buf[i][1].w, (int)x1_.w, d, false); \
            dd[i] = d; } \
        const int b16 = (lane >> 4) & 1; \
        int ra, rb, r1; \
        { auto q_ = __builtin_amdgcn_permlane32_swap((unsigned)dd[0], (unsigned)dd[2], false, false); ra = (int)q_[0] + (int)q_[1]; } \
        { auto q_ = __builtin_amdgcn_permlane32_swap((unsigned)dd[1], (unsigned)dd[3], false, false); rb = (int)q_[0] + (int)q_[1]; } \
        { auto q_ = __builtin_amdgcn_permlane16_swap((unsigned)ra, (unsigned)rb, false, false); r1 = (int)q_[0] + (int)q_[1]; } \
        r1 += dppi<DPP_X1>(r1); r1 += dppi<DPP_X2>(r1); r1 += dppi<DPP_HMIR>(r1); r1 += dppi<DPP_MIR>(r1); \
        const int ei = 2 * hi + b16; \
        unsigned em = en[0]; em = (ei == 1) ? en[1] : em; em = (ei == 2) ? en[2] : em; em = (ei == 3) ? en[3] : em; \
        if ((lane & 15) == 0 && !((em >> 23) & 1u)) wl4[((em >> 21) & 3u) * 128 + ((em >> 14) & 127u)] = (float)r1; } while (0)
#define PEER_PD(acc, xa, xb, wh, sel) do { unsigned t_; asm volatile("v_perm_b32 %1, %3, %2, %5\n\tv_dot2c_f32_f16 %0, %4, %1" : "+v"(acc), "=&v"(t_) : "v"(xa), "v"(xb), "v"(wh), "s"(sel)); } while (0)
#define PEER_D4(A, c, j, xa, xb, wh) do { \
        PEER_PD(A[c][4 * (j) + 0], xa, xb, wh, 0x0c040c00u); PEER_PD(A[c][4 * (j) + 1], xa, xb, wh, 0x0c050c01u); \
        PEER_PD(A[c][4 * (j) + 2], xa, xb, wh, 0x0c060c02u); PEER_PD(A[c][4 * (j) + 3], xa, xb, wh, 0x0c070c03u); } while (0)
__device__ __forceinline__ void p_peer_a(const Args& P, LAS char* lds, int gw, int NGW) {
    unsigned char* ws = P.ws;
    const int tid = threadIdx.x, lane0 = tid & 63, wave = __builtin_amdgcn_readfirstlane(tid >> 6);
    const bf16* KEYB = (const bf16*)(ws + WS_KEYB); const bf16* PQ = (const bf16*)(ws + WS_PQ);
    const bf16* H2 = (const bf16*)(ws + WS_H2B); const float* R2 = (const float*)(ws + WS_R2);
    unsigned short* PE = (unsigned short*)(ws + WS_PE); float* PG = (float*)(ws + WS_PG); unsigned char* XQ = ws + WS_XQ8; float* SX = (float*)(ws + WS_SX);
    LAS char* wbase = lds + wave * 17920;
    LAS int* elist = (LAS int*)wbase; LAS float* glist = (LAS float*)(wbase + 2048);
    for (int tile = gw; tile < S_ / 4; tile += NGW) {
        const int t0 = tile * 4;
        peer_retrieve(KEYB, PQ, wbase, t0, lane0);
        int lane = lane0; asm volatile("" : "+v"(lane));
#pragma unroll
        for (int i = 0; i < 8; ++i) { const int idx = lane + 64 * i; PE[(size_t)t0 * 128 + idx] = (unsigned short)elist[idx]; PG[(size_t)t0 * 128 + idx] = glist[idx]; }
#pragma unroll 1
        for (int tt = 0; tt < 4; ++tt) { const int t = t0 + tt; const float r2 = R2[t]; const float* gf = P.in[23]; f32x4 xv[2][4]; float amax = 0.f;
#pragma unroll
            for (int c = 0; c < 2; ++c)
#pragma unroll
                for (int k = 0; k < 4; ++k) { const size_t o = (size_t)1024 * c + 16 * lane + 4 * k; const u32x2 hb = *(const u32x2*)(H2 + (size_t)t * DM + o); const f32x4 gg = *(const f32x4*)(gf + o);
                    const f32x4 h = {__uint_as_float(hb.x << 16), __uint_as_float(hb.x & 0xffff0000u), __uint_as_float(hb.y << 16), __uint_as_float(hb.y & 0xffff0000u)};
                    xv[c][k] = h * gg * r2; amax = fmaxf(amax, fmaxf(fmaxf(fabsf(xv[c][k].x), fabsf(xv[c][k].y)), fmaxf(fabsf(xv[c][k].z), fabsf(xv[c][k].w)))); }
            amax = wave_max(amax); const float sxv = amax > 0.f ? amax * (1.f / 127.f) : 1.f; const float ix = 1.f / sxv;
            if (lane == 0) SX[t] = sxv;
#pragma unroll
            for (int c = 0; c < 2; ++c) { unsigned q_[4];
#pragma unroll
                for (int k = 0; k < 4; ++k) { const int q0 = (int)rintf(xv[c][k].x * ix), q1 = (int)rintf(xv[c][k].y * ix), q2 = (int)rintf(xv[c][k].z * ix), q3 = (int)rintf(xv[c][k].w * ix);
                    q_[k] = (unsigned)(q0 & 255) | ((unsigned)(q1 & 255) << 8) | ((unsigned)(q2 & 255) << 16) | ((unsigned)(q3 & 255) << 24); }
                *(u32x4*)(XQ + (size_t)t * DM + 1024 * c + 16 * lane) = (u32x4){q_[0], q_[1], q_[2], q_[3]}; } }
        asm volatile("s_waitcnt lgkmcnt(0)" ::: "memory"); __builtin_amdgcn_wave_barrier();
    }
}

__device__ __forceinline__ void p_peer_b(const Args& P, LAS char* lds) {
    unsigned char* ws = P.ws;
    const int tid = threadIdx.x, lane0 = tid & 63, wave = __builtin_amdgcn_readfirstlane(tid >> 6);
    const int x = blockIdx.x & 7, wi = (int)(blockIdx.x >> 3) * NWAVES + wave, NW = (int)(gridDim.x >> 3) * NWAVES;
    const unsigned char* UQ = ws + WS_UQ; const float* USC = (const float*)(ws + WS_USC); const float* VSC = (const float*)(ws + WS_VSC);
    const unsigned short* PE = (const unsigned short*)(ws + WS_PE); const float* PG = (const float*)(ws + WS_PG); float* PW = (float*)(ws + WS_PW);
    const unsigned char* XQ = ws + WS_XQ8; const float* SX = (const float*)(ws + WS_SX);
    LAS char* wbase = lds + wave * 17920;
    LAS unsigned* listbuf = (LAS unsigned*)wbase;
    LAS float* wl4 = (LAS float*)(wbase + 4224);
    LAS float* sxL = (LAS float*)(wbase + 6272);
    LAS u32x4* xqL = (LAS u32x4*)(wbase + 6400);
    const int NT = (S_ / 4 - wi + NW - 1) / NW;
    int lane = lane0; asm volatile("" : "+v"(lane)); const int hi = lane >> 5;
    u32x4 ev1, ev2, xrn[8]; float sxn;
#define PB_LOADEV(dst, i) do { const int tl_ = wi + ((i) < NT ? (i) : NT - 1) * NW; dst = *(const u32x4*)(PE + (size_t)tl_ * 512 + 8 * lane); } while (0)
#define PB_LOADXQ(i) do { const int t0_ = 4 * (wi + ((i) < NT ? (i) : NT - 1) * NW); sxn = SX[t0_ + (lane & 3)]; \
        _Pragma("unroll") for (int tt = 0; tt < 4; ++tt) _Pragma("unroll") for (int cc = 0; cc < 2; ++cc) xrn[tt * 2 + cc] = *(const u32x4*)(XQ + (size_t)(t0_ + tt) * DM + 1024 * cc + 16 * lane); } while (0)
#define PB_COMPACT(ev, lst, valid, TOT, GG) do { \
        unsigned ee[8]; ee[0] = ev.x & 0xffffu; ee[1] = ev.x >> 16; ee[2] = ev.y & 0xffffu; ee[3] = ev.y >> 16; ee[4] = ev.z & 0xffffu; ee[5] = ev.z >> 16; ee[6] = ev.w & 0xffffu; ee[7] = ev.w >> 16; \
        unsigned mm = 0; \
        _Pragma("unroll") for (int j = 0; j < 8; ++j) mm |= (unsigned)((((ee[j] >> 7) + ee[j]) & 7u) == (unsigned)x) << j; \
        mm = (valid) ? mm : 0u; \
        const int c = __builtin_popcount(mm); int incl = c; \
        _Pragma("unroll") for (int o = 1; o < 64; o <<= 1) { const int tv = __shfl_up(incl, o); if (lane >= o) incl += tv; } \
        TOT = __builtin_amdgcn_readlane(incl, 63); \
        { int off = incl - c; \
          _Pragma("unroll") for (int j = 0; j < 8; ++j) if ((mm >> j) & 1u) { lst[off] = ee[j] | ((unsigned)((8 * lane + j) & 127) << 14) | ((unsigned)(lane >> 4) << 21); ++off; } } \
        const int npad = (TOT == 0) ? 8 : ((-TOT) & 7); GG = (TOT + npad) >> 2; \
        if (lane < npad) lst[TOT + lane] = (1u << 23) | (unsigned)x; \
        asm volatile("s_waitcnt lgkmcnt(0)" ::: "memory"); __builtin_amdgcn_wave_barrier(); } while (0)
#define PB_LOADG(buf, en, lst, gi) do { _Pragma("unroll") for (int i = 0; i < 4; ++i) { const unsigned e_ = (unsigned)__builtin_amdgcn_readfirstlane((int)lst[4 * (gi) + i]); en[i] = e_; \
        const unsigned char* row = UQ + (size_t)(e_ & 0x3fffu) * DM + 16 * lane; buf[i][0] = *(const u32x4*)row; buf[i][1] = *(const u32x4*)(row + 1024); } __builtin_amdgcn_sched_barrier(0); } while (0)
    u32x4 ba[4][2], bb[4][2]; unsigned ena[4], enb[4];
    int tot, G;
    PB_LOADEV(ev1, 0); PB_LOADXQ(0); PB_LOADEV(ev2, 1);
    PB_COMPACT(ev1, listbuf, true, tot, G);
    PB_LOADG(ba, ena, listbuf, 0); PB_LOADG(bb, enb, listbuf, 1);
    ev1 = ev2;
#pragma unroll 1
    for (int it = 0; it < NT; ++it) {
        const int t0 = 4 * (wi + it * NW);
        LAS unsigned* cur = listbuf + (it & 1) * 528; LAS unsigned* nxt = listbuf + ((it + 1) & 1) * 528;
#pragma unroll
        for (int i = 0; i < 8; ++i) xqL[i * 64 + lane] = xrn[i];
        if (lane < 4) sxL[lane] = sxn;
        PB_LOADXQ(it + 1); PB_LOADEV(ev2, it + 2);
        __builtin_amdgcn_sched_barrier(0);
        int totn, Gn;
        PB_COMPACT(ev1, nxt, it + 1 < NT, totn, Gn);
        unsigned en_[2]; float ga_[2], us_[2], vs_[2];
#pragma unroll
        for (int q_ = 0; q_ < 2; ++q_) { const int j = lane + 64 * q_; const unsigned e_ = cur[j < tot ? j : 0]; en_[q_] = e_;
            ga_[q_] = PG[(size_t)(t0 + (int)((e_ >> 21) & 3u)) * 128 + ((e_ >> 14) & 127u)]; us_[q_] = USC[e_ & 0x3fffu]; vs_[q_] = VSC[e_ & 0x3fffu]; }
        __builtin_amdgcn_sched_barrier(0);
        for (int g = 0; g < G; g += 2) {
            PEER_COMPU(ba, ena); { const int r_ = g + 2; const bool in_ = r_ < G; LAS unsigned* l_ = in_ ? cur : nxt; const int gi_ = in_ ? r_ : r_ - G; PB_LOADG(ba, ena, l_, gi_); }
            PEER_COMPU(bb, enb); { const int r_ = g + 3; const bool in_ = r_ < G; LAS unsigned* l_ = in_ ? cur : nxt; const int gi_ = in_ ? r_ : r_ - G; PB_LOADG(bb, enb, l_, gi_); }
        }
        asm volatile("s_waitcnt lgkmcnt(0)" ::: "memory"); __builtin_amdgcn_wave_barrier();
#pragma unroll
        for (int q_ = 0; q_ < 2; ++q_) { const int j = lane + 64 * q_; const unsigned e_ = en_[q_]; const int tt = (int)((e_ >> 21) & 3u), k = (int)((e_ >> 14) & 127u);
            if (j < tot) PW[(size_t)(t0 + tt) * 128 + k] = ga_[q_] * gelu_exact(wl4[tt * 128 + k] * (us_[q_] * sxL[tt])) * vs_[q_]; }
        for (int j = lane + 128; j < tot; j += 64) { const unsigned e_ = cur[j]; const int tt = (int)((e_ >> 21) & 3u), k = (int)((e_ >> 14) & 127u);
            PW[(size_t)(t0 + tt) * 128 + k] = PG[(size_t)(t0 + tt) * 128 + k] * gelu_exact(wl4[tt * 128 + k] * (USC[e_ & 0x3fffu] * sxL[tt])) * VSC[e_ & 0x3fffu]; }
        asm volatile("s_waitcnt lgkmcnt(0)" ::: "memory"); __builtin_amdgcn_wave_barrier();
        tot = totn; G = Gn; ev1 = ev2;
    }
#undef PB_LOADEV
#undef PB_LOADXQ
#undef PB_COMPACT
#undef PB_LOADG
}

#ifndef PD_VALU2
#define PD_VALU2 0
#endif
template <unsigned EMASK> __device__ __forceinline__ void p_peer_d(const Args& P, LAS char* lds) {
    unsigned char* ws = P.ws;
    const int tid = threadIdx.x, lane0 = tid & 63, wave = __builtin_amdgcn_readfirstlane(tid >> 6);
    const int x = blockIdx.x & 7, wi = (int)(blockIdx.x >> 3) * NWAVES + wave;
    const unsigned short* PE = (const unsigned short*)(ws + WS_PE); const float* PW = (const float*)(ws + WS_PW);
    const bf16* H2 = (const bf16*)(ws + WS_H2B); float* SSP = (float*)(ws + WS_SSP);
    LAS char* wbase = lds + wave * 17920;
    LAS unsigned* lb = (LAS unsigned*)(wbase + 16384);
    int lane = lane0; asm volatile("" : "+v"(lane));
    const int g = lane >> 4, l16 = lane & 15;
    const unsigned char* VSu = ws + WS_VQS + (size_t)x * (4 * MiB);
    const unsigned l16b = 16u * (unsigned)l16;
    const int tb = wi * 32;
    float acc[1][16], accz[1][16];
#pragma unroll
    for (int j = 0; j < 16; ++j) { acc[0][j] = 0.f; accz[0][j] = 0.f; }
    unsigned short pe0, pe1; float pw0, pw1; u32x2 ph;
    u32x2 hcur; float sumw_cur, sumw_nxt;
#define PD_LOAD(n) do { const int t_ = tb + ((n) < 32 ? (n) : 31); pe0 = PE[(size_t)t_ * 128 + lane]; pe1 = PE[(size_t)t_ * 128 + 64 + lane]; pw0 = PW[(size_t)t_ * 128 + lane]; pw1 = PW[(size_t)t_ * 128 + 64 + lane]; \
        ph = *(const u32x2*)(H2 + (size_t)t_ * DM + 256 * x + 16 * l16 + 4 * g); } while (0)
#define PD_STORE(b) do { sumw_nxt = wave_sum(pw0 + pw1); const h2_t w2_ = {(_Float16)(pw0 * 256.f), (_Float16)(pw1 * 256.f)}; \
        lb[(b) * 192 + lane] = ((unsigned)pe0 & EMASK) << 8; lb[(b) * 192 + 64 + lane] = ((unsigned)pe1 & EMASK) << 8; lb[(b) * 192 + 128 + lane] = __builtin_bit_cast(unsigned, w2_); \
        asm volatile("s_waitcnt lgkmcnt(0)" ::: "memory"); __builtin_amdgcn_wave_barrier(); } while (0)
    u32x4 ra[8], rb[8]; unsigned rw[8];
#define PD_STEP(s, b, i, DO_CONSUME) do { const int ix_ = (b) * 192 + 4 * (i) + g; const unsigned oa_ = lb[ix_], ob_ = lb[ix_ + 64], wn_ = lb[ix_ + 128]; \
        if (DO_CONSUME && PD_VALU2 && EMASK != 0xffffu) { PEER_D4(accz, 0, 0, ra[s].x, rb[s].x, rw[s]); PEER_D4(accz, 0, 1, ra[s].y, rb[s].y, rw[s]); PEER_D4(accz, 0, 2, ra[s].z, rb[s].z, rw[s]); PEER_D4(accz, 0, 3, ra[s].w, rb[s].w, rw[s]); } \
        if (DO_CONSUME) { PEER_D4(acc, 0, 0, ra[s].x, rb[s].x, rw[s]); PEER_D4(acc, 0, 1, ra[s].y, rb[s].y, rw[s]); PEER_D4(acc, 0, 2, ra[s].z, rb[s].z, rw[s]); PEER_D4(acc, 0, 3, ra[s].w, rb[s].w, rw[s]); } \
        ra[s] = *(const u32x4*)(VSu + (oa_ | l16b)); rb[s] = *(const u32x4*)(VSu + (ob_ | l16b)); rw[s] = wn_; __builtin_amdgcn_sched_barrier(0); } while (0)
    PD_LOAD(0); PD_STORE(0); sumw_cur = sumw_nxt; hcur = ph;
#pragma unroll
    for (int s = 0; s < 8; ++s) PD_STEP(s, 0, s, false);
#pragma unroll 1
    for (int n = 0; n < 32; ++n) {
        const int b = n & 1;
        PD_LOAD(n + 1);
        __builtin_amdgcn_sched_barrier(0);
#pragma unroll
        for (int s = 0; s < 8; ++s) PD_STEP(s, b, 8 + s, true);
        PD_STORE(b ^ 1);
#pragma unroll
        for (int s = 0; s < 8; ++s) PD_STEP(s, b ^ 1, s, true);
        { const int t = tb + n; const float off = 128.f * sumw_cur; float u8[8], v[4];
#pragma unroll
          for (int j = 0; j < 8; ++j) { auto q_ = __builtin_amdgcn_permlane32_swap(__float_as_uint(acc[0][j]), __float_as_uint(acc[0][j + 8]), false, false); u8[j] = __uint_as_float(q_[0]) + __uint_as_float(q_[1]); acc[0][j] = 0.f; acc[0][j + 8] = 0.f; }
#pragma unroll
          for (int j = 0; j < 4; ++j) { auto q_ = __builtin_amdgcn_permlane16_swap(__float_as_uint(u8[j]), __float_as_uint(u8[j + 4]), false, false); v[j] = (__uint_as_float(q_[0]) + __uint_as_float(q_[1])) * 65536.f - off; }
          v[0] += __uint_as_float(hcur.x << 16); v[1] += __uint_as_float(hcur.x & 0xffff0000u); v[2] += __uint_as_float(hcur.y << 16); v[3] += __uint_as_float(hcur.y & 0xffff0000u);
          float ss = (v[0] * v[0] + v[1] * v[1]) + (v[2] * v[2] + v[3] * v[3]);
          ss = wave_sum(ss);
          if (lane == 0) SSP[(size_t)x * S_ + t] = ss;
          const h2_t a_ = {(_Float16)v[0], (_Float16)v[1]}, b_ = {(_Float16)v[2], (_Float16)v[3]};
          *(LAS u32x2*)(wbase + (size_t)(n * 256 + 16 * l16 + 4 * g) * 2) = (u32x2){__builtin_bit_cast(unsigned, a_), __builtin_bit_cast(unsigned, b_)};
          sumw_cur = sumw_nxt; hcur = ph; }
    }
#undef PD_LOAD
#undef PD_STORE
#undef PD_STEP
    asm volatile("s_waitcnt vmcnt(0) lgkmcnt(0)" ::: "memory"); __builtin_amdgcn_wave_barrier();
}

__device__ __forceinline__ void p_peer_e(const Args& P, LAS char* lds) {
    unsigned char* ws = P.ws;
    const int tid = threadIdx.x, lane = tid & 63, wave = __builtin_amdgcn_readfirstlane(tid >> 6);
    const int x = blockIdx.x & 7, wi = (int)(blockIdx.x >> 3) * NWAVES + wave, tb = wi * 32;
    const float* SSP = (const float*)(ws + WS_SSP);
    LAS char* wbase = lds + wave * 17920;
    float s = 0.f;
#pragma unroll
    for (int q = 0; q < 8; ++q) s += SSP[(size_t)q * S_ + tb + (lane & 31)];
    const float rrv = rsqrtf(s * (1.f / DM) + EPS);
    const f32x4 gg = *(const f32x4*)(P.in[29] + 256 * x + 4 * lane);
#pragma unroll 4
    for (int n = 0; n < 32; ++n) { const float rr = __shfl(rrv, n);
        const u32x2 hs = *(const LAS u32x2*)(wbase + (size_t)(n * 256 + 4 * lane) * 2);
        const unsigned s0_ = hs.x, s1_ = hs.y; const h2_t a_ = __builtin_bit_cast(h2_t, s0_); const h2_t b_ = __builtin_bit_cast(h2_t, s1_);
        const f32x4 ov = {(float)a_.x * rr * gg.x, (float)a_.y * rr * gg.y, (float)b_.x * rr * gg.z, (float)b_.y * rr * gg.w};
        *(f32x4*)(P.out + (size_t)(tb + n) * DM + 256 * x + 4 * lane) = ov; }
}
#undef PEER_LOADG
#undef PEER_SWEEP
#undef PEER_LOADU
#undef PEER_COMPU
#undef PEER_PD
#undef PEER_D4
constexpr int NS_KS = 144, NS_VS = 192, NS_VOFF = 64 * NS_KS, NS_BUF = NS_VOFF + 64 * NS_VS;
constexpr int NS_IMP_OFF = 2 * NS_BUF;
constexpr int NS_OACC_OFF = NS_IMP_OFF + 32768;
struct KVStage { u32x4 k, v; };
template <class TileF>
__device__ __forceinline__ void kv_tile_loop(const bf16* Kg, const bf16* Vg, int g, int kt_lo, int kt_hi, LAS char* lds, TileF f) {
    if (kt_lo >= kt_hi) return;
    int tid = threadIdx.x; asm volatile("" : "+v"(tid));
    const int kkey = tid >> 3, kc = tid & 7;
    const size_t soff = (size_t)kkey * 256 + g * 64 + kc * 8; const int kdst = kkey * NS_KS + kc * 16, vdst = NS_VOFF + kkey * NS_VS + kc * 16;
    KVStage sA, sB;
#define KV_LOAD(S, kt) do { S.k = *(const u32x4*)(Kg + (size_t)(kt) * 64 * 256 + soff); S.v = *(const u32x4*)(Vg + (size_t)(kt) * 64 * 256 + soff); } while (0)
#define KV_STORE(S, b) do { LAS char* nb_ = lds + (b) * NS_BUF; *(LAS u32x4*)(nb_ + kdst) = S.k; *(LAS u32x4*)(nb_ + vdst) = S.v; } while (0)
#define KV_ITER(kt, S, nb) do { f((kt), (const LAS char*)(lds + ((nb) ^ 1) * NS_BUF)); if ((kt) + 1 < kt_hi) KV_STORE(S, nb); if ((kt) + 3 < kt_hi) KV_LOAD(S, (kt) + 3); LDS_BARRIER(); } while (0)
    KV_LOAD(sA, kt_lo); KV_STORE(sA, 0);
    if (kt_lo + 1 < kt_hi) KV_LOAD(sB, kt_lo + 1);
    if (kt_lo + 2 < kt_hi) KV_LOAD(sA, kt_lo + 2);
    __syncthreads();
    for (int kt = kt_lo; kt < kt_hi; kt += 2) { KV_ITER(kt, sB, 1); if (kt + 1 < kt_hi) KV_ITER(kt + 1, sA, 0); }
#undef KV_LOAD
#undef KV_STORE
#undef KV_ITER
}
__device__ __forceinline__ void nsa_unit(const Args& a, int g, int qt, LAS char* lds) {
    unsigned char* ws = a.ws;
    const int tid = threadIdx.x, lane = tid & 63, w = __builtin_amdgcn_readfirstlane(tid >> 6), r32 = lane & 31, hi = lane >> 5;
    const int tokl = r32 >> 2, hh = r32 & 3, t = 64 * qt + 8 * w + tokl, cur = qt;
    const bf16* NQ = (const bf16*)(ws + WS_NQ);
    const bf16* KCb = (const bf16*)(ws + WS_KC); const bf16* VCb = (const bf16*)(ws + WS_VC);
    const bf16* KSEL = (const bf16*)(ws + WS_KV6 + 2 * 4 * MiB); const bf16* VSEL = (const bf16*)(ws + WS_KV6 + 3 * 4 * MiB);
    const bf16* KWIN = (const bf16*)(ws + WS_KV6 + 4 * 4 * MiB); const bf16* VWIN = (const bf16*)(ws + WS_KV6 + 5 * 4 * MiB);
    const float* NG = (const float*)(ws + WS_NG) + (size_t)t * 48 + (g * 4 + hh) * 3;
    bf16x8 qf[4];
#pragma unroll
    for (int ks = 0; ks < 4; ++ks) qf[ks] = *(const bf16x8*)(NQ + (size_t)t * 1024 + (g * 4 + hh) * 64 + 16 * ks + 8 * hi);
    LAS float* oaccL = (LAS float*)(lds + NS_OACC_OFF) + w * 2048 + lane;
    LAS float* imp = (LAS float*)(lds + NS_IMP_OFF) + w * 1024 + tokl * 128;

    {
        const int cnt = t >= 31 ? ((t - 31) >> 4) + 1 : 0;
        int cmax = 4 * qt + 3; cmax = cmax > 511 ? 511 : cmax;
        const int ntc = (cmax + 63) >> 6;
        float mc = -INFINITY, lc = 0.f; f32x16 zero16;
#pragma unroll
        for (int r = 0; r < 16; ++r) zero16[r] = 0.f;
        kv_tile_loop(KCb, VCb, g, 0, ntc, lds, [&](int kt, const LAS char* buf) {
            f32x16 p0, p1; qk_scores<64, NS_KS>(qf, buf, lane, zero16, p0, p1);
#pragma unroll
            for (int r = 0; r < 16; ++r) { const int n = 64 * kt + crow(r, hi); if (n >= cnt) p0[r] = -INFINITY; if (n + 32 >= cnt) p1[r] = -INFINITY; }
            const float mx = tile_colmax(p0, p1); const float mnew = fmaxf(mc, mx); const float msafe = (mnew == -INFINITY) ? 0.f : mnew;
            float ps = 0.f;
#pragma unroll
            for (int r = 0; r < 16; ++r) ps += fexp2(p0[r] - msafe) + fexp2(p1[r] - msafe);
            lc = lc * fexp2(mc - msafe) + ps; mc = mnew; });
        lc = sum_x32(lc);
        const float invl = lc > 0.f ? 1.f / lc : 0.f; const float msafe = (mc == -INFINITY) ? 0.f : mc;
#pragma unroll
        for (int i = 0; i < 16; ++i) ((LAS float*)(lds + NS_IMP_OFF) + w * 1024)[lane + 64 * i] = 0.f;
        asm volatile("s_waitcnt lgkmcnt(0)" ::: "memory"); __builtin_amdgcn_wave_barrier();
        f32x16 oc[2];
#pragma unroll
        for (int d = 0; d < 2; ++d)
#pragma unroll
            for (int r = 0; r < 16; ++r) oc[d][r] = 0.f;
        kv_tile_loop(KCb, VCb, g, 0, ntc, lds, [&](int kt, const LAS char* buf) {
            f32x16 p0, p1; qk_scores<64, NS_KS>(qf, buf, lane, zero16, p0, p1);
#pragma unroll
            for (int r = 0; r < 16; ++r) { const int n = 64 * kt + crow(r, hi); p0[r] = (n >= cnt) ? 0.f : fexp2(p0[r] - msafe) * invl; p1[r] = (n + 32 >= cnt) ? 0.f : fexp2(p1[r] - msafe) * invl; }
#pragma unroll
            for (int c = 0; c < 4; ++c) {
                float s0 = (p0[4 * c] + p0[4 * c + 1]) + (p0[4 * c + 2] + p0[4 * c + 3]), s1 = (p1[4 * c] + p1[4 * c + 1]) + (p1[4 * c + 2] + p1[4 * c + 3]);
                s0 += dppf<DPP_X1>(s0); s0 += dppf<DPP_X2>(s0); s1 += dppf<DPP_X1>(s1); s1 += dppf<DPP_X2>(s1);
                if (hh == 0) { imp[16 * kt + 2 * c + hi] = s0; imp[16 * kt + 8 + 2 * c + hi] = s1; } }
            pv_accum<64, NS_VS>(oc, p0, p1, buf + NS_VOFF, lane); });
        const float gc = NG[0];
#pragma unroll
        for (int d = 0; d < 2; ++d)
#pragma unroll
            for (int r = 0; r < 16; ++r) oaccL[(16 * d + r) * 64] = gc * oc[d][r];
    }
    unsigned long long sel_lo = 0ull, sel_hi = 0ull;
    {
        asm volatile("s_waitcnt lgkmcnt(0)" ::: "memory"); __builtin_amdgcn_wave_barrier();
        const int s8 = hh + 4 * hi;
        float vals[16];
#pragma unroll
        for (int i = 0; i < 16; ++i) { const int j = s8 + 8 * i; const bool forced = (j == 0) || (j == cur) || (j == cur - 1);
            vals[i] = (j <= cur) ? imp[j] + (forced ? 100.f : 0.f) : -INFINITY; }
        unsigned lsel = 0u;
#pragma unroll 1
        for (int it = 0; it < 16; ++it) {
            float lm = vals[0];
#pragma unroll
            for (int i = 1; i < 16; ++i) lm = fmaxf(lm, vals[i]);
            float gm = fmaxf(lm, dppf<DPP_X1>(lm)); gm = fmaxf(gm, dppf<DPP_X2>(gm)); gm = max_x32(gm);
            int cand = (lm == gm && gm > -INFINITY) ? s8 : 99;
            int mn = min(cand, dppi<DPP_X1>(cand)); mn = min(mn, dppi<DPP_X2>(mn)); { auto r_ = __builtin_amdgcn_permlane32_swap((unsigned)mn, (unsigned)mn, false, false); mn = min((int)r_[0], (int)r_[1]); }
            const bool win = (s8 == mn); bool found = false;
#pragma unroll
            for (int i = 0; i < 16; ++i) { const bool hit = win && !found && vals[i] == gm; if (hit) { vals[i] = -INFINITY; lsel |= 1u << i; found = true; } }
        }
#pragma unroll
        for (int k = 0; k < 4; ++k) { unsigned wv = 0u;
#pragma unroll
            for (int i = 0; i < 4; ++i) wv |= ((lsel >> (4 * k + i)) & 1u) << (s8 + 8 * i);
            wv |= (unsigned)dppi<DPP_X1>((int)wv); wv |= (unsigned)dppi<DPP_X2>((int)wv); { auto r_ = __builtin_amdgcn_permlane32_swap(wv, wv, false, false); wv = r_[0] | r_[1]; }
            if (k == 0) sel_lo |= (unsigned long long)wv; if (k == 1) sel_lo |= (unsigned long long)wv << 32; if (k == 2) sel_hi |= (unsigned long long)wv; if (k == 3) sel_hi |= (unsigned long long)wv << 32; }
    }
    {
        Flash<64> f; flash_init(f);
        kv_tile_loop(KSEL, VSEL, g, 0, cur + 1, lds, [&](int j, const LAS char* buf) {
            const unsigned long long wsel = j < 64 ? sel_lo : sel_hi;
            const bool sel = (wsel >> (j & 63)) & 1ull;
            if (__ballot(sel) != 0ull) {
                flash_tile<64, 64, NS_KS, NS_VS, true>(f, qf, buf, buf + NS_VOFF, lane, sel, [&](f32x16& p0, f32x16& p1) {
                    if (j == cur) {
#pragma unroll
                        for (int r = 0; r < 16; ++r) { const int key = 64 * j + crow(r, hi); if (key > t) p0[r] = -INFINITY; if (key + 32 > t) p1[r] = -INFINITY; }
                    } });
            } });
        const float l = sum_x32(f.l); const float gs = NG[1] * (l > 0.f ? 1.f / l : 0.f);
#pragma unroll
        for (int d = 0; d < 2; ++d)
#pragma unroll
            for (int r = 0; r < 16; ++r) oaccL[(16 * d + r) * 64] += gs * f.o[d][r];
    }
    {
        Flash<64> f; flash_init(f);
        const int kt_lo = qt >= 8 ? qt - 8 : 0;
        kv_tile_loop(KWIN, VWIN, g, kt_lo, qt + 1, lds, [&](int kt, const LAS char* buf) {
            const bool edge = (kt == qt) || (kt + 8 == qt);
            flash_tile<64, 64, NS_KS, NS_VS, false>(f, qf, buf, buf + NS_VOFF, lane, true, [&](f32x16& p0, f32x16& p1) {
                if (edge) {
#pragma unroll
                    for (int r = 0; r < 16; ++r) { const int key = 64 * kt + crow(r, hi); if (key > t || key + 511 < t) p0[r] = -INFINITY; if (key + 32 > t || key + 32 + 511 < t) p1[r] = -INFINITY; }
                } }); });
        const float l = sum_x32(f.l); const float gw = NG[2] * (l > 0.f ? 1.f / l : 0.f);
        bf16* ONSA = (bf16*)(ws + WS_ONSA);
#pragma unroll
        for (int d = 0; d < 2; ++d)
#pragma unroll
            for (int r4 = 0; r4 < 4; ++r4) { float v[4];
#pragma unroll
                for (int e = 0; e < 4; ++e) v[e] = oaccL[(16 * d + 4 * r4 + e) * 64] + gw * f.o[d][4 * r4 + e];
                u32x2 o; o.x = pk2(v[0], v[1]); o.y = pk2(v[2], v[3]);
                *(u32x2*)(ONSA + (size_t)t * 1024 + (g * 4 + hh) * 64 + 32 * d + 8 * r4 + 4 * hi) = o; }
    }
}
typedef float f32x4v __attribute__((ext_vector_type(4)));
__device__ __forceinline__ void compress_unit(const Args& P, int rg, LAS char* lds) {
    unsigned char* ws = P.ws;
    const int tid = threadIdx.x, lane = tid & 63, w = __builtin_amdgcn_readfirstlane(tid >> 6);
    const int which = rg & 1, g = (rg >> 1) & 3, nb = rg >> 3, n0 = 16 * nb;
    const bf16* src = (const bf16*)(ws + WS_KV6 + (size_t)which * 4 * MiB);
    const bf16* w1t = (const bf16*)(ws + WS_W1C) + (size_t)which * 128 * 2048;
    const float* cpos = (const float*)(ws + WS_CPOS) + which * 128;
    const float* w2 = which ? P.in[14] : P.in[12];
    const int i16 = lane & 15, kg = lane >> 4;
    LAS char* aL = lds + 40960;
    const int iblk = (n0 + i16 > 510) ? 510 - n0 : i16;
    u32x4 ar[5];
#pragma unroll
    for (int r = 0; r < 5; ++r) { const int idx = tid + 512 * r, tau = idx >> 3, ch = idx & 7; int ta = 16 * n0 + tau; ta = ta > S_ - 1 ? S_ - 1 : ta;
        ar[r] = *(const u32x4*)(src + (size_t)ta * 256 + g * 64 + ch * 8); }
    const bf16* brow = w1t + (size_t)(16 * w + i16) * 32 + 8 * kg;
    f32x4 w2r[4];
#pragma unroll
    for (int i = 0; i < 4; ++i) w2r[i] = *(const f32x4*)(w2 + (size_t)(i * 512 + tid) * 4);
    f32x4v acc = {0.f, 0.f, 0.f, 0.f};
    bf16x8 bwA[8], bwB[8];
#define CU_LOAD(BW, bt) do { _Pragma("unroll") for (int i = 0; i < 8; ++i) BW[i] = *(const bf16x8*)(brow + (size_t)(8 * (bt) + i) * 4096); } while (0)
#define CU_MMA(BW, bt) do { _Pragma("unroll") for (int i = 0; i < 8; ++i) { const int ks = 8 * (bt) + i, c = ks >> 1, j = iblk + (c >> 4); \
        const bf16x8 av = *(const LAS bf16x8*)(aL + ((c & 15) * 17 + j) * 128 + 16 * ((4 * (ks & 1) + kg) ^ (j & 7))); \
        acc = __builtin_amdgcn_mfma_f32_16x16x32_bf16(BW[i], av, acc, 0, 0, 0); } } while (0)
    CU_LOAD(bwA, 0);
#pragma unroll
    for (int r = 0; r < 5; ++r) { const int idx = tid + 512 * r, tau = idx >> 3, ch = idx & 7; if (idx < 272 * 8) *(LAS u32x4*)(aL + ((tau & 15) * 17 + (tau >> 4)) * 128 + 16 * (ch ^ ((tau >> 4) & 7))) = ar[r]; }
    __syncthreads();
#pragma unroll
    for (int bt = 0; bt < 8; bt += 2) {
        CU_LOAD(bwB, bt + 1); __builtin_amdgcn_sched_barrier(0); CU_MMA(bwA, bt); __builtin_amdgcn_sched_barrier(0);
        if (bt + 2 < 8) CU_LOAD(bwA, bt + 2);
        __builtin_amdgcn_sched_barrier(0); CU_MMA(bwB, bt + 1); __builtin_amdgcn_sched_barrier(0);
    }
#undef CU_LOAD
#undef CU_MMA
    LAS float* hid = (LAS float*)lds;
    LAS float* w2L = (LAS float*)(lds + 8192);
#pragma unroll
    for (int e = 0; e < 4; ++e) { const int col = 16 * w + 4 * kg + e; hid[i16 * 128 + col] = gelu_exact(acc[e] + cpos[col]); }
#pragma unroll
    for (int i = 0; i < 4; ++i) *(LAS f32x4*)(w2L + (i * 512 + tid) * 4) = w2r[i];
    __syncthreads();
    { const int nl = tid >> 5, d = (tid & 31) * 2; float o0 = 0.f, o1 = 0.f;
#pragma unroll 16
      for (int hh = 0; hh < 128; ++hh) { const float hv = hid[nl * 128 + hh]; const f32x2_t wv = *(const LAS f32x2_t*)(w2L + hh * 64 + d); o0 += hv * wv.x; o1 += hv * wv.y; }
      if (n0 + nl < 511) *(unsigned*)((bf16*)(ws + (which ? WS_VC : WS_KC)) + (size_t)(n0 + nl) * 256 + g * 64 + d) = pk2(o0, o1); }
    __syncthreads();
}

struct EpiZ {
    static constexpr bool PERM = true, AFTER_DRAIN = false; unsigned char* ws;
    __device__ __forceinline__ void operator()(const pg8::f32x4 (&acc)[2][2][4][2], const pg8::Unit& u, int wr, int wc, int fr, int fq) const {
        const int pn = u.pn;
        const float* COS = (const float*)(ws + WS_COS); const float* SIN = (const float*)(ws + WS_SIN);
        bf16* dst; int ld, cbase; bool rope = false, sig = false; float scale = 1.f;
        if (pn < 4) { dst = (bf16*)(ws + WS_QDA); ld = 1024; cbase = 0; rope = true; scale = QSCALE; }
        else if (pn < 8) { dst = (bf16*)(ws + WS_KDA); ld = 1024; cbase = 1024; rope = true; }
        else if (pn < 12) { dst = (bf16*)(ws + WS_VDA); ld = 1024; cbase = 2048; }
        else if (pn < 16) { dst = (bf16*)(ws + WS_NQ); ld = 1024; cbase = 3072; rope = true; scale = QSCALE; }
        else if (pn < 22) { const int j = pn - 16; dst = (bf16*)(ws + WS_KV6 + (size_t)j * 4 * MiB); ld = 256; cbase = 4096 + 256 * j; rope = (j & 1) == 0; }
        else { dst = (bf16*)(ws + WS_BG); ld = 4096; cbase = 5632; sig = true; }
        const bool ropelane = rope && ((wc & 1) == 0) && (fq < 2);
#pragma unroll
        for (int ai = 0; ai < 2; ++ai)
#pragma unroll
            for (int m = 0; m < 4; ++m) { const int row = u.pm * 256 + ai * 128 + wr * 64 + m * 16 + fr;
                f32x4 c0 = {1.f, 1.f, 1.f, 1.f}, c1 = c0, s0 = {0.f, 0.f, 0.f, 0.f}, s1 = s0;
                if (rope) { c0 = *(const f32x4*)(COS + row * 8); c1 = *(const f32x4*)(COS + row * 8 + 4); s0 = *(const f32x4*)(SIN + row * 8); s1 = *(const f32x4*)(SIN + row * 8 + 4); }
#pragma unroll
                for (int bj = 0; bj < 2; ++bj) { f32x4 v0 = acc[ai][bj][m][0], v1 = acc[ai][bj][m][1];
                    const int c8 = pn * 256 + bj * 128 + wc * 32 + 8 * fq;
                    if (rope) {
                        f32x4 o0, o1;
#define XR16(x) ([&]() { auto r_ = __builtin_amdgcn_permlane16_swap(__float_as_uint(x), __float_as_uint(x), false, false); return __uint_as_float((fq & 1) ? r_[0] : r_[1]); }())
                        o0.x = XR16(v0.x); o0.y = XR16(v0.y); o0.z = XR16(v0.z); o0.w = XR16(v0.w);
                        o1.x = XR16(v1.x); o1.y = XR16(v1.y); o1.z = XR16(v1.z); o1.w = XR16(v1.w);
#undef XR16
                        if (ropelane) { const float sg = (fq == 0) ? -1.f : 1.f; v0 = v0 * c0 + o0 * s0 * sg; v1 = v1 * c1 + o1 * s1 * sg; }
                    }
                    if (pn == 38) {
                        const int c = c8 - 9728;
                        if (c < 48) { float* ng = (float*)(ws + WS_NG) + (size_t)row * 48 + c;
                            f32x4 a = {sigmoidf_(v0.x), sigmoidf_(v0.y), sigmoidf_(v0.z), sigmoidf_(v0.w)}, b = {sigmoidf_(v1.x), sigmoidf_(v1.y), sigmoidf_(v1.z), sigmoidf_(v1.w)};
                            *(f32x4*)ng = a; *(f32x4*)(ng + 4) = b; }
                    } else {
                        if (sig) { v0 = (f32x4){sigmoidf_(v0.x), sigmoidf_(v0.y), sigmoidf_(v0.z), sigmoidf_(v0.w)}; v1 = (f32x4){sigmoidf_(v1.x), sigmoidf_(v1.y), sigmoidf_(v1.z), sigmoidf_(v1.w)}; }
                        v0 = v0 * scale; v1 = v1 * scale;
                        u32x4 o; o.x = pk2(v0.x, v0.y); o.y = pk2(v0.z, v0.w); o.z = pk2(v1.x, v1.y); o.w = pk2(v1.z, v1.w);
                        *(u32x4*)(dst + (size_t)row * ld + (c8 - cbase)) = o;
                    } } }
    }
};

constexpr int XA_KS = 272, XA_VS = 320, XA_VOFF = 64 * XA_KS;
__device__ __forceinline__ void xattn_unit(const Args& P, int h, int qb, LAS char* lds) {
    unsigned char* ws = P.ws;
    const int tid = threadIdx.x, lane = tid & 63, w = __builtin_amdgcn_readfirstlane(tid >> 6), r32 = lane & 31, hi = lane >> 5;
    const bf16* QX = (const bf16*)(ws + WS_QX); const bf16* KVM = (const bf16*)(ws + WS_KVM); bf16* OX = (bf16*)(ws + WS_OX);
    const int q = 256 * qb + 32 * w + r32;
    bf16x8 qf[8];
#pragma unroll
    for (int ks = 0; ks < 8; ++ks) qf[ks] = *(const bf16x8*)(QX + (size_t)q * 512 + h * 128 + 16 * ks + 8 * hi);
    Flash<128> f; flash_init(f);
    for (int kt = 0; kt < 4; ++kt) {
#pragma unroll
        for (int i = 0; i < 2; ++i) { const int idx = tid + 512 * i, key = idx >> 4, c = idx & 15; const bf16* r = KVM + (size_t)(64 * kt + key) * 1024 + h * 128 + c * 8;
            *(LAS u32x4*)(lds + key * XA_KS + c * 16) = *(const u32x4*)r; *(LAS u32x4*)(lds + XA_VOFF + key * XA_VS + c * 16) = *(const u32x4*)(r + 512); }
        __syncthreads();
        flash_tile<128, 128, XA_KS, XA_VS, false>(f, qf, lds, lds + XA_VOFF, lane, true, [](f32x16&, f32x16&) {});
        __syncthreads();
    }
    const float l = sum_x32(f.l); const float inv = 1.f / l;
#pragma unroll
    for (int d = 0; d < 4; ++d)
#pragma unroll
        for (int r4 = 0; r4 < 4; ++r4) { u32x2 o; o.x = pk2(f.o[d][4 * r4] * inv, f.o[d][4 * r4 + 1] * inv); o.y = pk2(f.o[d][4 * r4 + 2] * inv, f.o[d][4 * r4 + 3] * inv);
            *(u32x2*)(OX + (size_t)q * 512 + h * 128 + 32 * d + 8 * r4 + 4 * hi) = o; }
}
__device__ __forceinline__ void phase0(const Args& a, LAS char* lds) {
    const int tid = threadIdx.x, lane = tid & 63, wave = __builtin_amdgcn_readfirstlane(tid >> 6); const int G = gridDim.x, bx = blockIdx.x;
    const int gw = bx * NWAVES + wave, NGW = G * NWAVES, gt = bx * 512 + tid, NGT = G * 512; unsigned char* ws = a.ws;
    LAS unsigned char* ring = (LAS unsigned char*)lds; LAS float* rtab = (LAS float*)(lds + RTAB_OFF);
    (void)lane; (void)gw; (void)NGW; (void)gt; (void)NGT; (void)ring; (void)rtab; (void)ws;
 p_prologue(a, lds, gw, NGW, gt, NGT);
        cvt_f32_bf16(a.in[25], (bf16*)(ws + WS_KEYB), 128 * 128, gt, NGT); cvt_f32_bf16(a.in[26], (bf16*)(ws + WS_KEYB) + 128 * 128, 128 * 128, gt, NGT);
}
__device__ __forceinline__ void phase1(const Args& a, LAS char* lds) {
    const int tid = threadIdx.x, lane = tid & 63, wave = __builtin_amdgcn_readfirstlane(tid >> 6); const int G = gridDim.x, bx = blockIdx.x;
    const int gw = bx * NWAVES + wave, NGW = G * NWAVES, gt = bx * 512 + tid, NGT = G * 512; unsigned char* ws = a.ws;
    LAS unsigned char* ring = (LAS unsigned char*)lds; LAS float* rtab = (LAS float*)(lds + RTAB_OFF);
    (void)lane; (void)gw; (void)NGW; (void)gt; (void)NGT; (void)ring; (void)rtab; (void)ws;

        { pg8::Gemm g{(const bf16*)(ws + WS_XN), (const bf16*)(ws + WS_W1T), S_, NZ, 2048}; pg8::StaticOrder S; S.init(S_, NZ, G, bx);
          EpiZ E{ws};
          pg8::gemm_phase<EpiZ, pg8::StaticOrder, true, true>(ring, g, S, E); }
        { pg8::Gemm g{(const bf16*)(ws + WS_MEMN), (const bf16*)(ws + WS_WXKV), MEML, 1024, 2048}; pg8::StaticOrder S; S.init(MEML, 1024, G, (bx + 4) % G);
          EpiFn<FStoreBf16> E{FStoreBf16{(bf16*)(ws + WS_KVM), 1024}};
          pg8::gemm_phase<EpiFn<FStoreBf16>, pg8::StaticOrder, false, true>(ring, g, S, E); }

}
__device__ __forceinline__ void phase2(const Args& a, LAS char* lds) {
    const int tid = threadIdx.x, lane = tid & 63, wave = __builtin_amdgcn_readfirstlane(tid >> 6); const int G = gridDim.x, bx = blockIdx.x;
    const int gw = bx * NWAVES + wave, NGW = G * NWAVES, gt = bx * 512 + tid, NGT = G * 512; unsigned char* ws = a.ws;
    LAS unsigned char* ring = (LAS unsigned char*)lds; LAS float* rtab = (LAS float*)(lds + RTAB_OFF);
    (void)lane; (void)gw; (void)NGW; (void)gt; (void)NGT; (void)ring; (void)rtab; (void)ws;

        for (int u = bx; u < 256; u += G) compress_unit(a, u, lds);
        for (int u = bx; u < 256; u += G) { const int h = u & 7, p = u >> 3; da_unit(a, h, 63 - p, lds); da_unit(a, h, p, lds); }

}
__device__ __forceinline__ void phase3(const Args& a, LAS char* lds) {
    const int tid = threadIdx.x, lane = tid & 63, wave = __builtin_amdgcn_readfirstlane(tid >> 6); const int G = gridDim.x, bx = blockIdx.x;
    const int gw = bx * NWAVES + wave, NGW = G * NWAVES, gt = bx * 512 + tid, NGT = G * 512; unsigned char* ws = a.ws;
    LAS unsigned char* ring = (LAS unsigned char*)lds; LAS float* rtab = (LAS float*)(lds + RTAB_OFF);
    (void)lane; (void)gw; (void)NGW; (void)gt; (void)NGT; (void)ring; (void)rtab; (void)ws;

        for (int u = bx; u < 256; u += G) { const int g = u & 3, p = u >> 2; nsa_unit(a, g, 127 - p, lds); nsa_unit(a, g, p, lds); }

}
__device__ __forceinline__ void phase4(const Args& a, LAS char* lds) {
    const int tid = threadIdx.x, lane = tid & 63, wave = __builtin_amdgcn_readfirstlane(tid >> 6); const int G = gridDim.x, bx = blockIdx.x;
    const int gw = bx * NWAVES + wave, NGW = G * NWAVES, gt = bx * 512 + tid, NGT = G * 512; unsigned char* ws = a.ws;
    LAS unsigned char* ring = (LAS unsigned char*)lds; LAS float* rtab = (LAS float*)(lds + RTAB_OFF);
    (void)lane; (void)gw; (void)NGW; (void)gt; (void)NGT; (void)ring; (void)rtab; (void)ws;

        pg8::StaticOrder S; S.init(S_, 2048, G, bx);
        { pg8::Gemm g{(const bf16*)(ws + WS_ODA), (const bf16*)(ws + WS_WBDA), S_, 2048, 1024};
          EpiFn<FGate0> E{FGate0{(bf16*)(ws + WS_MIX), (const bf16*)(ws + WS_BG)}};
          pg8::gemm_phase<EpiFn<FGate0>, pg8::StaticOrder, false, true>(ring, g, S, E); }
        asm volatile("s_waitcnt vmcnt(0)" ::: "memory"); __syncthreads();
        { pg8::Gemm g{(const bf16*)(ws + WS_ONSA), (const bf16*)(ws + WS_WBNSA), S_, 2048, 1024};
          EpiFn<FGate1> E{FGate1{(bf16*)(ws + WS_MIX), (const bf16*)(ws + WS_BG)}};
          pg8::gemm_phase<EpiFn<FGate1>, pg8::StaticOrder, false, true>(ring, g, S, E); }

}
__device__ __forceinline__ void phase5(const Args& a, LAS char* lds) {
    const int tid = threadIdx.x, lane = tid & 63, wave = __builtin_amdgcn_readfirstlane(tid >> 6); const int G = gridDim.x, bx = blockIdx.x;
    const int gw = bx * NWAVES + wave, NGW = G * NWAVES, gt = bx * 512 + tid, NGT = G * 512; unsigned char* ws = a.ws;
    LAS unsigned char* ring = (LAS unsigned char*)lds; LAS float* rtab = (LAS float*)(lds + RTAB_OFF);
    (void)lane; (void)gw; (void)NGW; (void)gt; (void)NGT; (void)ring; (void)rtab; (void)ws;

        pg8::Gemm g{(const bf16*)(ws + WS_MIX), (const bf16*)(ws + WS_WOUT), S_, 2048, 2048}; pg8::StaticOrder S; S.init(S_, 2048, G, bx);
        EpiResSS<false> E{a.in[0], (bf16*)(ws + WS_H1B), (float*)(ws + WS_SS1)};
        pg8::gemm_phase<EpiResSS<false>, pg8::StaticOrder, false, true>(ring, g, S, E);

}
__device__ __forceinline__ void phase6(const Args& a, LAS char* lds) {
    const int tid = threadIdx.x, lane = tid & 63, wave = __builtin_amdgcn_readfirstlane(tid >> 6); const int G = gridDim.x, bx = blockIdx.x;
    const int gw = bx * NWAVES + wave, NGW = G * NWAVES, gt = bx * 512 + tid, NGT = G * 512; unsigned char* ws = a.ws;
    LAS unsigned char* ring = (LAS unsigned char*)lds; LAS float* rtab = (LAS float*)(lds + RTAB_OFF);
    (void)lane; (void)gw; (void)NGW; (void)gt; (void)NGT; (void)ring; (void)rtab; (void)ws;

        pg8::Gemm g{(const bf16*)(ws + WS_H1B), (const bf16*)(ws + WS_WXQ), S_, 512, 2048}; pg8::StaticOrder S; S.init(S_, 512, G, bx);
        make_rtab(S, (const float*)(ws + WS_SS1), rtab);
        EpiFn<FRowScaleL> E{FRowScaleL{rtab, (bf16*)(ws + WS_QX), XSCALE, 512}};
        pg8::gemm_phase<EpiFn<FRowScaleL>, pg8::StaticOrder, false, true>(ring, g, S, E);
        if (bx >= 64) { const int w0 = (bx - 64) * NWAVES + wave, nw = (G - 64) * NWAVES;
            for (int r = w0; r < 2 * 16384; r += nw) { const int tb = r >= 16384, rr = r & 16383;
                quant_row(a.in[tb ? 28 : 27] + (size_t)rr * DM, ws + (tb ? WS_VQ : WS_UQ), rr, (float*)(ws + (tb ? WS_VSC : WS_USC)) + rr, lane, tb != 0); } }
}
__device__ __forceinline__ void phase7(const Args& a, LAS char* lds) {
    const int tid = threadIdx.x, lane = tid & 63, wave = __builtin_amdgcn_readfirstlane(tid >> 6); const int G = gridDim.x, bx = blockIdx.x;
    const int gw = bx * NWAVES + wave, NGW = G * NWAVES, gt = bx * 512 + tid, NGT = G * 512; unsigned char* ws = a.ws;
    LAS unsigned char* ring = (LAS unsigned char*)lds; LAS float* rtab = (LAS float*)(lds + RTAB_OFF);
    (void)lane; (void)gw; (void)NGW; (void)gt; (void)NGT; (void)ring; (void)rtab; (void)ws;

        for (int u = bx; u < 128; u += G) xattn_unit(a, u & 3, u >> 2, lds);

}
__device__ __forceinline__ void phase8(const Args& a, LAS char* lds) {
    const int tid = threadIdx.x, lane = tid & 63, wave = __builtin_amdgcn_readfirstlane(tid >> 6); const int G = gridDim.x, bx = blockIdx.x;
    const int gw = bx * NWAVES + wave, NGW = G * NWAVES, gt = bx * 512 + tid, NGT = G * 512; unsigned char* ws = a.ws;
    LAS unsigned char* ring = (LAS unsigned char*)lds; LAS float* rtab = (LAS float*)(lds + RTAB_OFF);
    (void)lane; (void)gw; (void)NGW; (void)gt; (void)NGT; (void)ring; (void)rtab; (void)ws;

        pg8::Gemm g{(const bf16*)(ws + WS_OX), (const bf16*)(ws + WS_WXO), S_, 2048, 512}; pg8::StaticOrder S; S.init(S_, 2048, G, bx);
        EpiResSS<true> E{ws + WS_H1B, (bf16*)(ws + WS_H2B), (float*)(ws + WS_SS2)};
        pg8::gemm_phase<EpiResSS<true>, pg8::StaticOrder, false, true>(ring, g, S, E);

}
__device__ __forceinline__ void phase9(const Args& a, LAS char* lds) {
    const int tid = threadIdx.x, lane = tid & 63, wave = __builtin_amdgcn_readfirstlane(tid >> 6); const int G = gridDim.x, bx = blockIdx.x;
    const int gw = bx * NWAVES + wave, NGW = G * NWAVES, gt = bx * 512 + tid, NGT = G * 512; unsigned char* ws = a.ws;
    LAS unsigned char* ring = (LAS unsigned char*)lds; LAS float* rtab = (LAS float*)(lds + RTAB_OFF);
    (void)lane; (void)gw; (void)NGW; (void)gt; (void)NGT; (void)ring; (void)rtab; (void)ws;

        pg8::Gemm g{(const bf16*)(ws + WS_H2B), (const bf16*)(ws + WS_WPQ), S_, 2048, 2048}; pg8::StaticOrder S; S.init(S_, 2048, G, bx);
        make_rtab(S, (const float*)(ws + WS_SS2), rtab);
        { pg8::Unit u; if (S.next(0, u) && tid < 256) ((float*)(ws + WS_R2))[u.pm * 256 + tid] = rtab[tid]; }
        EpiFn<FRowScaleL> E{FRowScaleL{rtab, (bf16*)(ws + WS_PQ), 1.0f, 2048}};
        pg8::gemm_phase<EpiFn<FRowScaleL>, pg8::StaticOrder, false, true>(ring, g, S, E);

}
__device__ __forceinline__ void phase10(const Args& a, LAS char* lds) { const int wave = __builtin_amdgcn_readfirstlane(threadIdx.x >> 6); p_peer_a(a, lds, blockIdx.x * NWAVES + wave, gridDim.x * NWAVES); }
__device__ __forceinline__ void phase11(const Args& a, LAS char* lds) { p_peer_b(a, lds); }
__device__ __forceinline__ void phase12(const Args& a, LAS char* lds) {
#ifdef MK_FAKEMASK
    p_peer_d<MK_FAKEMASK>(a, lds);
#endif
    p_peer_d<0xffffu>(a, lds); }
__device__ __forceinline__ void phase13(const Args& a, LAS char* lds) { p_peer_e(a, lds); }
#ifndef MK_DOUBLE
#define MK_DOUBLE 0
#endif
#ifndef MK_SPLIT
#define MK_SPLIT 0
#endif
constexpr int NPHASE = 14;
__global__ void __launch_bounds__(NWAVES * 64, 2) mk_fwd(Args a) {
    extern __shared__ __attribute__((aligned(16))) unsigned char lds_raw[];
    LAS char* lds = (LAS char*)lds_raw;
    const int tid = threadIdx.x, lane = tid & 63, wave = __builtin_amdgcn_readfirstlane(tid >> 6);
    const int G = gridDim.x, bx = blockIdx.x;
    unsigned char* ws = a.ws;
    for (int u = tid; u < (LDS_BYTES - LDSCTL_OFF) / 4; u += NWAVES * 64) ((LAS unsigned*)(lds + LDSCTL_OFF))[u] = 0u;
    __syncthreads();
    unsigned* ctl = (unsigned*)(ws + WS_CTL);
    XcdBarrier bar; bar.bar = ctl + CW_BAR; bar.x = 0; bar.st = nullptr;
    if (!MK_SPLIT) bar = xcd_barrier_post(ctl + CW_BAR, (volatile LAS unsigned*)(lds + MISC_OFF) + 8);
    const int lo = a.ph_lo, hi = a.ph_hi;
#define IN(k) (lo <= (k) && (k) < hi)
#define SEAM(k) do { if (IN(k) && IN((k) + 1)) xcd_barrier(bar); } while (0)

    if (IN(0)) { phase0(a, lds); if (MK_DOUBLE & (1 << 0)) { xcd_barrier(bar); phase0(a, lds); } }
    SEAM(0);
    if (IN(1)) { phase1(a, lds); if (MK_DOUBLE & (1 << 1)) { xcd_barrier(bar); phase1(a, lds); } }
    SEAM(1);
    if (IN(2)) { phase2(a, lds); if (MK_DOUBLE & (1 << 2)) { xcd_barrier(bar); phase2(a, lds); } }
    SEAM(2);
    if (IN(3)) { phase3(a, lds); if (MK_DOUBLE & (1 << 3)) { xcd_barrier(bar); phase3(a, lds); } }
    SEAM(3);
    if (IN(4)) { phase4(a, lds); if (MK_DOUBLE & (1 << 4)) { xcd_barrier(bar); phase4(a, lds); } }
    SEAM(4);
    if (IN(5)) { phase5(a, lds); if (MK_DOUBLE & (1 << 5)) { xcd_barrier(bar); phase5(a, lds); } }
    SEAM(5);
    if (IN(6)) { phase6(a, lds); if (MK_DOUBLE & (1 << 6)) { xcd_barrier(bar); phase6(a, lds); } }
    SEAM(6);
    if (IN(7)) { phase7(a, lds); if (MK_DOUBLE & (1 << 7)) { xcd_barrier(bar); phase7(a, lds); } }
    SEAM(7);
    if (IN(8)) { phase8(a, lds); if (MK_DOUBLE & (1 << 8)) { xcd_barrier(bar); phase8(a, lds); } }
    SEAM(8);
    if (IN(9)) { phase9(a, lds); if (MK_DOUBLE & (1 << 9)) { xcd_barrier(bar); phase9(a, lds); } }
    SEAM(9);
    if (IN(10)) { phase10(a, lds); if (MK_DOUBLE & (1 << 10)) { xcd_barrier(bar); phase10(a, lds); } }
    SEAM(10);
    if (IN(11)) { phase11(a, lds); if (MK_DOUBLE & (1 << 11)) { xcd_barrier(bar); phase11(a, lds); } }
    SEAM(11);
    if (IN(12)) { phase12(a, lds); if (MK_DOUBLE & (1 << 12)) { xcd_barrier(bar); phase12(a, lds); } }
    SEAM(12);
    if (IN(13)) { phase13(a, lds); if (MK_DOUBLE & (1 << 13)) { xcd_barrier(bar); phase13(a, lds); } }
#undef IN
#undef SEAM
}

extern "C" void kernel_launch(void* const* d_in, const int* in_sizes, int n_in, void* d_out, int out_size, void* d_ws, size_t ws_size, hipStream_t stream) {
    static int grid = 0;
    if (grid == 0) {
        if (n_in != 30 || ws_size < WS_END || out_size != S_ * DM) { fprintf(stderr, "kernel_launch: unexpected n_in %d / ws %zu / out %d\n", n_in, ws_size, out_size); grid = -1; return; }
        int dev = 0, cus = 0, per_cu = 0;
        if (hipGetDevice(&dev) != hipSuccess || hipDeviceGetAttribute(&cus, hipDeviceAttributeMultiprocessorCount, dev) != hipSuccess) { grid = -1; return; }
        if (hipFuncSetAttribute((const void*)mk_fwd, hipFuncAttributeMaxDynamicSharedMemorySize, LDS_BYTES) != hipSuccess) { fprintf(stderr, "kernel_launch: hipFuncSetAttribute failed\n"); grid = -1; return; }
        if (hipOccupancyMaxActiveBlocksPerMultiprocessor(&per_cu, (const void*)mk_fwd, NWAVES * 64, LDS_BYTES) != hipSuccess || per_cu < 1) { fprintf(stderr, "kernel_launch: occupancy query says %d blocks per CU\n", per_cu); }
        (void)hipGetLastError();
        grid = cus;
        if (grid != 256) { fprintf(stderr, "kernel_launch: built for a 256-CU device, found %d CUs\n", cus); grid = -1; return; }
    }
    if (grid < 0) return;
    (void)hipMemsetAsync((char*)d_ws + WS_CTL, 0, 1 * MiB, stream);
    Args a; memset(&a, 0, sizeof(a));
    for (int i = 0; i < 30; ++i) a.in[i] = (const float*)d_in[i];
    a.out = (float*)d_out; a.ws = (unsigned char*)d_ws;
#if MK_SPLIT
    for (int p = 0; p < NPHASE; ++p) { a.ph_lo = p; a.ph_hi = p + 1; hipLaunchKernelGGL(mk_fwd, dim3(grid), dim3(NWAVES * 64), LDS_BYTES, stream, a); }
#else
    a.ph_lo = 0; a.ph_hi = NPHASE;
    hipLaunchKernelGGL(mk_fwd, dim3(grid), dim3(NWAVES * 64), LDS_BYTES, stream, a);
#endif
}
```

```cpp
#include <hip/hip_runtime.h>
#include <cstdio>
#include <cstdint>
#include <cmath>
#include <cstring>
namespace pg8 {
#define PG8_LAS __attribute__((address_space(3)))
typedef unsigned short bf16_t;
typedef short bf16x8 __attribute__((ext_vector_type(8)));
typedef float f32x4 __attribute__((ext_vector_type(4)));
typedef unsigned u32x4 __attribute__((ext_vector_type(4)));
constexpr int BM = 256, BK = 64, HALF = 128, HTB = HALF * BK * 2  , STAGE_BYTES = 8 * HTB, NXCD = 8, WGM = 8;

__host__ __device__ __forceinline__ int lds_byte(int r, int c) { const int st = (r >> 4) * 2 + (c >> 5), rr = r & 15, cc = c & 31, ob = rr * 64 + cc * 2; return st * 1024 + (ob ^ (((ob >> 9) & 1) << 5)); }
__host__ __device__ __forceinline__ void stage_rc(int b, int& R, int& C) { const int st = b / 1024, sb = b % 1024, swz = sb ^ (((sb >> 9) & 1) << 5); R = (st >> 1) * 16 + swz / 64; C = (st & 1) * 32 + (swz % 64) / 2; }
__host__ __device__ __forceinline__ int perm32(int rho) { const int n = rho >> 4, i = rho & 15; return 8 * (i >> 2) + 4 * n + (i & 3); }

struct Unit { int pm, pn, w; };
struct Gemm { const bf16_t* A; const bf16_t* Bt; int M, N, K; const bf16_t* A2 = nullptr; const bf16_t* Bt2 = nullptr; };

struct StaticOrder {
    int nM, nN, nwg, G, c;
    __host__ __device__ __forceinline__ void init(int M, int N, int G_, int c_) { nM = M / BM; nN = N / BM; nwg = nM * nN; G = G_; c = c_; }
    __host__ __device__ __forceinline__ bool next(int i, Unit& u) const {
        const long L = (long)i * G + c; if (L >= nwg) return false;
        int wgid = (int)L; { const int q = nwg / NXCD, r = nwg % NXCD, xcd = wgid % NXCD, off = wgid / NXCD; wgid = (xcd < r ? xcd * (q + 1) : r * (q + 1) + (xcd - r) * q) + off; }
        const int nig = WGM * nN, gid = wgid / nig, fm = gid * WGM, gsz = (nM - fm) < WGM ? (nM - fm) : WGM;
        u.pm = fm + ((wgid % nig) % gsz); u.pn = (wgid % nig) / gsz; u.w = 0; return true;
    }
    __device__ __forceinline__ void a_ready(const Unit&) const {}
    __device__ __forceinline__ void done(const Unit&) const {}
};
struct DualOrder {
    StaticOrder S;
    __host__ __device__ __forceinline__ void init(int M, int N, int G_, int c_) { S.init(M, N, G_, c_); }
    __host__ __device__ __forceinline__ bool next(int i, Unit& u) const { if (i >= 2) return false; const bool ok = S.next(0, u); u.w = i; return ok; }
    __device__ __forceinline__ void a_ready(const Unit&) const {}
    __device__ __forceinline__ void done(const Unit&) const {}
};

__device__ __forceinline__ unsigned cvt_pk_bf16(float lo, float hi) { unsigned r; asm volatile("v_cvt_pk_bf16_f32 %0, %1, %2" : "=v"(r) : "v"(lo), "v"(hi)); return r; }
typedef float f32x2 __attribute__((ext_vector_type(2)));
__device__ __forceinline__ f32x2 gelu_pk(f32x2 v) {
    const f32x2 av = __builtin_elementwise_abs(v), d = av * 0.2316418882f + 1.0f;
    f32x2 t; t.x = __builtin_amdgcn_rcpf(d.x); t.y = __builtin_amdgcn_rcpf(d.y);
    f32x2 q = t * 0.5307027145f + (-0.7265760135f); q = q * t + 0.7107068705f; q = q * t + (-0.142248368f); q = q * t + 0.127414796f; q = q * t;
    const f32x2 s = (v * v) * (-0.72134752044f);
    f32x2 e; e.x = __builtin_amdgcn_exp2f(s.x); e.y = __builtin_amdgcn_exp2f(s.y);
    const f32x2 m = v * (q * e), r = v - m;
    f32x2 o; o.x = v.x < 0.f ? m.x : r.x; o.y = v.y < 0.f ? m.y : r.y; return o;
}

template <class Epi, class Sched, bool ALIGN_EPI = false, bool SP2 = false>
__device__ __forceinline__ void gemm_phase(PG8_LAS unsigned char* lds, const Gemm g, const Sched& S, const Epi& E) {
    const int tid = threadIdx.x, wid = __builtin_amdgcn_readfirstlane(tid >> 6), lane = tid & 63, wr = wid >> 2, wc = wid & 3, fr = lane & 15, fq = lane >> 4;
    const int K = g.K, nt = K / BK;
    unsigned voffA[2], voffB[2];
#pragma unroll
    for (int i = 0; i < 2; ++i) { int R, C; stage_rc(tid * 16 + i * 8192, R, C); const int Rb = Epi::PERM ? ((R & ~31) + perm32(R & 31)) : R;
        voffA[i] = (unsigned)(R * K + C) * 2u; voffB[i] = (unsigned)(Rb * K + C) * 2u; }
    const size_t kstep = (size_t)(BK * 2);
    const size_t hstep = (size_t)HALF * K * 2;
    const size_t tstep = 2 * hstep;
    const unsigned ldsw = (unsigned)wid * 1024u;
    const int aoff = lds_byte(wr * 64 + fr, fq * 8), boff = lds_byte(wc * 32 + fr, fq * 8);
#define PG8_SA(b, h) (((b) * 2 + (h)) * HTB)
#define PG8_SB(b, h) ((4 + (b) * 2 + (h)) * HTB)
#define PG8_STAGE(bufoff, gbase, voff) do { _Pragma("unroll") for (int _i = 0; _i < 2; ++_i) \
        __builtin_amdgcn_global_load_lds((const unsigned*)((const char*)(gbase) + (voff)[_i]), (PG8_LAS unsigned*)(lds + (bufoff) + ldsw + _i * 8192), 16, 0, 0); } while (0)
#define PG8_LDA(dst, b, h) do { _Pragma("unroll") for (int m = 0; m < 4; ++m) _Pragma("unroll") for (int k = 0; k < 2; ++k) dst[m][k] = *(const PG8_LAS bf16x8*)(lds + PG8_SA(b, h) + aoff + m * 2048 + k * 1024); } while (0)
#define PG8_LDB(dst, b, h) do { _Pragma("unroll") for (int n = 0; n < 2; ++n) _Pragma("unroll") for (int k = 0; k < 2; ++k) dst[n][k] = *(const PG8_LAS bf16x8*)(lds + PG8_SB(b, h) + boff + n * 2048 + k * 1024); } while (0)
#define PG8_MMA(ai, bj, At, Bt) do { __builtin_amdgcn_s_setprio(1); _Pragma("unroll") for (int m = 0; m < 4; ++m) _Pragma("unroll") for (int n = 0; n < 2; ++n) _Pragma("unroll") for (int k = 0; k < 2; ++k) \
        acc[ai][bj][m][n] = __builtin_amdgcn_mfma_f32_16x16x32_bf16(Bt[n][k], At[m][k], acc[ai][bj][m][n], 0, 0, 0); __builtin_amdgcn_s_setprio(0); } while (0)
#define PG8_WAIT_V(n) asm volatile("s_waitcnt vmcnt(" #n ")" ::: "memory")
#define PG8_WAIT_L(n) asm volatile("s_waitcnt lgkmcnt(" #n ")" ::: "memory")
#define PG8_BAR __builtin_amdgcn_s_barrier()
#define PG8_SCHED __builtin_amdgcn_sched_barrier(0)
    Unit cur, nxt; int ui = 0;
    if (!S.next(0, cur)) return;
    f32x4 acc[2][2][4][2];
#pragma unroll
    for (int a = 0; a < 2; ++a)
#pragma unroll
        for (int b = 0; b < 2; ++b)
#pragma unroll
            for (int m = 0; m < 4; ++m)
#pragma unroll
                for (int n = 0; n < 2; ++n) acc[a][b][m][n] = (f32x4){0.f, 0.f, 0.f, 0.f};
    bf16x8 At[4][2], B0[2][2], B1[2][2];
    const char* cA = (const char*)(cur.w ? g.A2 : g.A) + (size_t)cur.pm * tstep; const char* cB = (const char*)(cur.w ? g.Bt2 : g.Bt) + (size_t)cur.pn * tstep;
    S.a_ready(cur);
    if constexpr (SP2) {
        PG8_STAGE(PG8_SB(0, 0), cB, voffB); PG8_STAGE(PG8_SB(0, 1), cB + hstep, voffB); PG8_STAGE(PG8_SA(0, 0), cA, voffA); PG8_STAGE(PG8_SA(0, 1), cA + hstep, voffA);
        if (wr == 1) PG8_BAR;
        PG8_WAIT_V(2); PG8_BAR;
        PG8_STAGE(PG8_SB(1, 0), cB + kstep, voffB); PG8_STAGE(PG8_SA(1, 0), cA + kstep, voffA); PG8_STAGE(PG8_SB(1, 1), cB + hstep + kstep, voffB);
        PG8_WAIT_V(6); PG8_BAR;
    } else {
        PG8_STAGE(PG8_SB(0, 0), cB, voffB); PG8_STAGE(PG8_SA(0, 0), cA, voffA); PG8_STAGE(PG8_SB(0, 1), cB + hstep, voffB); PG8_STAGE(PG8_SA(0, 1), cA + hstep, voffA);
        if (wr == 1) PG8_BAR;
        PG8_WAIT_V(4); PG8_BAR;
        PG8_STAGE(PG8_SB(1, 0), cB + kstep, voffB); PG8_STAGE(PG8_SA(1, 0), cA + kstep, voffA); PG8_STAGE(PG8_SB(1, 1), cB + hstep + kstep, voffB);
        PG8_WAIT_V(6); PG8_BAR;
    }
    for (;;) {
        const bool has_next = S.next(ui + 1, nxt);
        const char* nA = has_next ? (const char*)(nxt.w ? g.A2 : g.A) + (size_t)nxt.pm * tstep : cA; const char* nB = has_next ? (const char*)(nxt.w ? g.Bt2 : g.Bt) + (size_t)nxt.pn * tstep : cB;
        for (int t = 0; t < nt; t += 2) {
            const bool last = (t == nt - 2);
            const char* a1 = cA + (size_t)(t + 1) * kstep;
            const char* a2 = last ? nA : cA + (size_t)(t + 2) * kstep; const char* b2 = last ? nB : cB + (size_t)(t + 2) * kstep;
            const char* a3 = a2 + kstep; const char* b3 = b2 + kstep;
            if (last && has_next) S.a_ready(nxt);
            if constexpr (SP2) {
            PG8_LDB(B0, 0, 0); PG8_LDB(B1, 0, 1); PG8_SCHED; PG8_LDA(At, 0, 0); PG8_STAGE(PG8_SA(1, 1), a1 + hstep, voffA);
            PG8_WAIT_V(8); PG8_WAIT_L(0); PG8_BAR; PG8_MMA(0, 0, At, B0); PG8_MMA(0, 1, At, B1); PG8_BAR; PG8_SCHED;
            PG8_LDA(At, 0, 1); PG8_STAGE(PG8_SB(0, 0), b2, voffB); PG8_STAGE(PG8_SB(0, 1), b2 + hstep, voffB); PG8_STAGE(PG8_SA(0, 0), a2, voffA);
            PG8_WAIT_V(8); PG8_WAIT_L(0); PG8_BAR; PG8_MMA(1, 0, At, B0); PG8_MMA(1, 1, At, B1); PG8_BAR; PG8_SCHED;
            PG8_LDB(B0, 1, 0); PG8_LDB(B1, 1, 1); PG8_SCHED; PG8_LDA(At, 1, 0); PG8_STAGE(PG8_SA(0, 1), a2 + hstep, voffA);
            PG8_WAIT_V(8); PG8_WAIT_L(0); PG8_BAR; PG8_MMA(0, 0, At, B0); PG8_MMA(0, 1, At, B1); PG8_BAR; PG8_SCHED;
            PG8_LDA(At, 1, 1); PG8_STAGE(PG8_SB(1, 0), b3, voffB); PG8_STAGE(PG8_SB(1, 1), b3 + hstep, voffB); PG8_STAGE(PG8_SA(1, 0), a3, voffA);
            PG8_WAIT_V(8); PG8_WAIT_L(0); PG8_BAR; PG8_MMA(1, 0, At, B0); PG8_MMA(1, 1, At, B1); PG8_BAR; PG8_SCHED;
            } else {
            PG8_LDB(B0, 0, 0); PG8_SCHED; PG8_LDA(At, 0, 0); PG8_STAGE(PG8_SA(1, 1), a1 + hstep, voffA);
            PG8_WAIT_L(8); PG8_BAR; PG8_WAIT_L(0); PG8_MMA(0, 0, At, B0); PG8_BAR; PG8_SCHED;
            PG8_LDB(B1, 0, 1); PG8_STAGE(PG8_SB(0, 0), b2, voffB);
            PG8_BAR; PG8_WAIT_L(0); PG8_MMA(0, 1, At, B1); PG8_BAR;
            PG8_LDA(At, 0, 1); PG8_STAGE(PG8_SA(0, 0), a2, voffA);
            PG8_BAR; PG8_WAIT_L(0); PG8_MMA(1, 0, At, B0); PG8_BAR; PG8_SCHED;
            PG8_STAGE(PG8_SB(0, 1), b2 + hstep, voffB);
            PG8_WAIT_V(6); PG8_BAR; PG8_MMA(1, 1, At, B1); PG8_BAR;
            PG8_LDB(B0, 1, 0); PG8_SCHED; PG8_LDA(At, 1, 0); PG8_STAGE(PG8_SA(0, 1), a2 + hstep, voffA);
            PG8_WAIT_L(8); PG8_BAR; PG8_WAIT_L(0); PG8_MMA(0, 0, At, B0); PG8_BAR; PG8_SCHED;
            PG8_LDB(B1, 1, 1); PG8_STAGE(PG8_SB(1, 0), b3, voffB);
            PG8_BAR; PG8_WAIT_L(0); PG8_MMA(0, 1, At, B1); PG8_BAR;
            PG8_LDA(At, 1, 1); PG8_STAGE(PG8_SA(1, 0), a3, voffA);
            PG8_BAR; PG8_WAIT_L(0); PG8_MMA(1, 0, At, B0); PG8_BAR; PG8_SCHED;
            PG8_STAGE(PG8_SB(1, 1), b3 + hstep, voffB);
            PG8_WAIT_V(6); PG8_BAR; PG8_MMA(1, 1, At, B1); PG8_BAR;
            }
        }
        if constexpr (ALIGN_EPI) { if (wr == 0) PG8_BAR; }
        if constexpr (Epi::CHAIN) { if (cur.w == 0) E.mid(acc, cur, wr, wc, fr, fq); else E(acc, cur, wr, wc, fr, fq); }
        else if constexpr (!Epi::AFTER_DRAIN) { E(acc, cur, wr, wc, fr, fq); S.done(cur); }
        if (!has_next) break;
        if (!(Epi::CHAIN && cur.w == 0)) {
#pragma unroll
        for (int a = 0; a < 2; ++a)
#pragma unroll
            for (int b = 0; b < 2; ++b)
#pragma unroll
                for (int m = 0; m < 4; ++m)
#pragma unroll
                    for (int n = 0; n < 2; ++n) acc[a][b][m][n] = (f32x4){0.f, 0.f, 0.f, 0.f};
        }
        cur = nxt; cA = nA; cB = nB; ++ui;
        if constexpr (ALIGN_EPI) { if (wr == 1) PG8_BAR; }
    }
    PG8_WAIT_V(0);
    if constexpr (!ALIGN_EPI) { if (wr == 0) PG8_BAR; }
    PG8_BAR;
    if constexpr (Epi::AFTER_DRAIN) { E.fused(acc, cur, wr, wc, fr, fq, lds, wid, lane); S.done(cur); }
#undef PG8_SA
#undef PG8_SB
#undef PG8_STAGE
#undef PG8_LDA
#undef PG8_LDB
#undef PG8_MMA
#undef PG8_WAIT_V
#undef PG8_WAIT_L
#undef PG8_BAR
#undef PG8_SCHED
}
}
typedef unsigned short bf16;
typedef float f32x4 __attribute__((ext_vector_type(4)));
typedef unsigned u32x4 __attribute__((ext_vector_type(4)));
typedef unsigned u32x2 __attribute__((ext_vector_type(2)));
#define LAS __attribute__((address_space(3)))
constexpr int S_ = 8192, DM = 2048, MEML = 256;
constexpr int NZ = 9984;
constexpr float EPS = 1e-6f;
constexpr float LOG2E = 1.4426950408889634f;
constexpr float QSCALE = 0.125f * LOG2E;
constexpr float XSCALE = 0.08838834764831845f * LOG2E;
constexpr float LAMBDA_INIT = 0.2f;

constexpr size_t MiB = 1u << 20;
constexpr size_t WS_CTL = 0;
constexpr size_t WS_COS = 1 * MiB, WS_SIN = WS_COS + 256 * 1024, WS_SCAL = WS_SIN + 256 * 1024, WS_CPOS = WS_SCAL + 1024, WS_R1 = WS_SCAL + 4096, WS_R2 = WS_R1 + 32768;
constexpr size_t WS_SS1 = 2 * MiB, WS_SS2 = WS_SS1 + 256 * 1024, WS_KC = WS_SS2 + 256 * 1024, WS_VC = WS_KC + 256 * 1024;
constexpr size_t WS_KVM = 3 * MiB, WS_MEMN = WS_KVM + 512 * 1024;
constexpr size_t WS_NG = 5 * MiB, WS_KEYB = 7 * MiB, WS_USC = WS_KEYB + 128 * 1024, WS_VSC = WS_USC + 64 * 1024;
constexpr size_t WS_W1T = 8 * MiB, WS_WBDA = 47 * MiB, WS_WBNSA = 51 * MiB, WS_WOUT = 55 * MiB, WS_WXQ = 63 * MiB, WS_WXKV = 65 * MiB, WS_WXO = 69 * MiB, WS_WPQ = 71 * MiB, WS_W1C = 79 * MiB;
constexpr size_t WS_XN = 80 * MiB, WS_ODA = 80 * MiB, WS_ONSA = 96 * MiB;
constexpr size_t WS_Z = 112 * MiB, WS_UQ = 112 * MiB, WS_VQ = 144 * MiB, WS_MIX = 240 * MiB, WS_H1 = 420 * MiB;
constexpr size_t WS_QDA = 268 * MiB, WS_KDA = 284 * MiB, WS_VDA = 300 * MiB, WS_NQ = 316 * MiB, WS_KV6 = 332 * MiB, WS_BG = 356 * MiB;
constexpr size_t WS_H1B = 272 * MiB, WS_QX = 304 * MiB, WS_OX = 312 * MiB, WS_H2 = 320 * MiB, WS_H2B = 384 * MiB, WS_PQ = 416 * MiB, WS_END = 484 * MiB;

__device__ __forceinline__ float bf2f(unsigned short v) { return __uint_as_float(((unsigned)v) << 16); }
__device__ __forceinline__ unsigned short f2bf(float f) { unsigned u = __float_as_uint(f); return (unsigned short)((u + 0x7fffu + ((u >> 16) & 1u)) >> 16); }
typedef float pk2_f2 __attribute__((ext_vector_type(2)));
typedef __bf16 pk2_b2 __attribute__((ext_vector_type(2)));
__device__ __forceinline__ unsigned pk2(float lo, float hi) { const pk2_f2 v = {lo, hi}; const pk2_b2 b = __builtin_convertvector(v, pk2_b2); return __builtin_bit_cast(unsigned, b); }
__device__ __forceinline__ u32x4 t21_pair(u32x2 a, u32x2 b) {
    auto rx = __builtin_amdgcn_permlane32_swap(a.x, b.x, false, false); auto ry = __builtin_amdgcn_permlane32_swap(a.y, b.y, false, false);
    return (u32x4){rx[0], ry[0], rx[1], ry[1]};
}
template <int CTRL> __device__ __forceinline__ float dppf(float v) { return __uint_as_float(__builtin_amdgcn_mov_dpp(__float_as_uint(v), CTRL, 0xF, 0xF, true)); }
template <int CTRL> __device__ __forceinline__ int dppi(int v) { return __builtin_amdgcn_mov_dpp(v, CTRL, 0xF, 0xF, true); }
constexpr int DPP_X1 = 0xB1, DPP_X2 = 0x4E, DPP_HMIR = 0x141, DPP_MIR = 0x140;
__device__ __forceinline__ float sum_x32(float v) { auto r = __builtin_amdgcn_permlane32_swap(__float_as_uint(v), __float_as_uint(v), false, false); return __uint_as_float(r[0]) + __uint_as_float(r[1]); }
__device__ __forceinline__ float max_x32(float v) { auto r = __builtin_amdgcn_permlane32_swap(__float_as_uint(v), __float_as_uint(v), false, false); return __builtin_elementwise_maximum(__uint_as_float(r[0]), __uint_as_float(r[1])); }
__device__ __forceinline__ float sum_x16(float v) { auto r = __builtin_amdgcn_permlane16_swap(__float_as_uint(v), __float_as_uint(v), false, false); return __uint_as_float(r[0]) + __uint_as_float(r[1]); }
__device__ __forceinline__ float max_x16(float v) { auto r = __builtin_amdgcn_permlane16_swap(__float_as_uint(v), __float_as_uint(v), false, false); return __builtin_elementwise_maximum(__uint_as_float(r[0]), __uint_as_float(r[1])); }
__device__ __forceinline__ float wave_sum(float v) {
    v += dppf<DPP_X1>(v); v += dppf<DPP_X2>(v); v += dppf<DPP_HMIR>(v); v += dppf<DPP_MIR>(v);
    return sum_x32(sum_x16(v));
}
__device__ __forceinline__ float wave_max(float v) {
    v = __builtin_elementwise_maximum(v, dppf<DPP_X1>(v)); v = __builtin_elementwise_maximum(v, dppf<DPP_X2>(v)); v = __builtin_elementwise_maximum(v, dppf<DPP_HMIR>(v)); v = __builtin_elementwise_maximum(v, dppf<DPP_MIR>(v));
    return max_x32(max_x16(v));
}
__device__ __forceinline__ float gelu_exact(float x) { return 0.5f * x * (1.0f + erff(x * 0.70710678118654752f)); }
__device__ __forceinline__ float sigmoidf_(float x) { return __builtin_amdgcn_rcpf(1.0f + __expf(-x)); }

struct Ptrs { const float* in[30]; float* out; unsigned char* ws; };

__device__ __forceinline__ int zmap(int n) { return n < 5632 ? n : (n < 9728 ? n + 48 : (n < 9776 ? n - 9728 + 5632 : -1)); }

struct TrItem { const float* W; bf16* WT; const float* gk; int K, Nsrc, kb, nb; bool zmap, kblk; };
__device__ __forceinline__ void tr_load(const TrItem& t, int lane, f32x4 (&v)[8]) {
    const int k0 = 64 * t.kb, n0 = 32 * t.nb, r8 = lane >> 3, c4 = (lane & 7) * 4;
    const int sc = t.zmap ? zmap(n0 + c4) : n0 + c4;
#pragma unroll
    for (int i = 0; i < 8; ++i) { const int kk = 8 * i + r8; v[i] = (f32x4){0.f, 0.f, 0.f, 0.f}; if (sc >= 0) { v[i] = *(const f32x4*)(t.W + (size_t)(k0 + kk) * t.Nsrc + sc); if (t.gk) v[i] = v[i] * t.gk[k0 + kk]; } }
}
__device__ __forceinline__ void tr_finish(const TrItem& t, int lane, const f32x4 (&v)[8], LAS float* scr) {
    const int k0 = 64 * t.kb, n0 = 32 * t.nb, r8 = lane >> 3, c4 = (lane & 7) * 4;
#pragma unroll
    for (int i = 0; i < 8; ++i) { const int kk = 8 * i + r8; scr[kk * 33 + c4] = v[i].x; scr[kk * 33 + c4 + 1] = v[i].y; scr[kk * 33 + c4 + 2] = v[i].z; scr[kk * 33 + c4 + 3] = v[i].w; }
    asm volatile("s_waitcnt lgkmcnt(0)" ::: "memory");
    const int c = lane & 7;
#pragma unroll
    for (int j = 0; j < 4; ++j) { const int n = (lane >> 3) + 8 * j; const LAS float* s = scr + (8 * c) * 33 + n;
        u32x4 o; o.x = pk2(s[0 * 33], s[1 * 33]); o.y = pk2(s[2 * 33], s[3 * 33]); o.z = pk2(s[4 * 33], s[5 * 33]); o.w = pk2(s[6 * 33], s[7 * 33]);
        const int kq = k0 + 8 * c; bf16* dp = t.kblk ? t.WT + ((size_t)(kq >> 5) * 128 + (n0 + n)) * 32 + (kq & 31) : t.WT + (size_t)(n0 + n) * t.K + kq;
        *(u32x4*)dp = o; }
    asm volatile("s_waitcnt lgkmcnt(0)" ::: "memory");
}
__device__ __forceinline__ void rms_row_load(const float* xrow, int lane, f32x4 (&v)[8]) {
#pragma unroll
    for (int j = 0; j < 4; ++j) { const f32x4* p = (const f32x4*)(xrow + 512 * j + 8 * lane); v[2 * j] = p[0]; v[2 * j + 1] = p[1]; }
}
__device__ __forceinline__ void rms_row_finish(const f32x4 (&v)[8], const float* g, bf16* orow, int lane) {
    float s = 0.f;
#pragma unroll
    for (int j = 0; j < 8; ++j) s += (v[j].x * v[j].x + v[j].y * v[j].y) + (v[j].z * v[j].z + v[j].w * v[j].w);
    const float r = rsqrtf(wave_sum(s) * (1.f / DM) + EPS);
#pragma unroll
    for (int j = 0; j < 4; ++j) { const f32x4* gp = (const f32x4*)(g + 512 * j + 8 * lane); const f32x4 g0 = gp[0], g1 = gp[1]; const f32x4 a = v[2 * j], b = v[2 * j + 1]; u32x4 w;
        w.x = pk2(a.x * r * g0.x, a.y * r * g0.y); w.y = pk2(a.z * r * g0.z, a.w * r * g0.w); w.z = pk2(b.x * r * g1.x, b.y * r * g1.y); w.w = pk2(b.z * r * g1.z, b.w * r * g1.w);
        *(u32x4*)(orow + 512 * j + 8 * lane) = w; }
}
__device__ __forceinline__ void rms_row_to_bf16(const float* xrow, const float* g, bf16* orow, int lane) { f32x4 v[8]; rms_row_load(xrow, lane, v); rms_row_finish(v, g, orow, lane); }
#define XB_TMO      128
#define XB_XCNT(j)  (256  + 64 * (j))
#define XB_XSUB(j)  (1280 + 64 * (j))
#define XB_XGEN(j)  (2304 + 64 * (j))
#define XB_TOP      3328
#define XB_TOPGEN   3392
#define XCD_BAR_WORDS 3456
#define XB_SPIN_CAP (1u << 18)

__device__ __forceinline__ unsigned xb_ld(unsigned* p)              { return __hip_atomic_load(p, __ATOMIC_RELAXED, __HIP_MEMORY_SCOPE_AGENT); }
__device__ __forceinline__ unsigned xb_add(unsigned* p, unsigned v) { return __hip_atomic_fetch_add(p, v, __ATOMIC_RELAXED, __HIP_MEMORY_SCOPE_AGENT); }
__device__ __forceinline__ unsigned xb_xcc_id() { return (unsigned)__builtin_amdgcn_s_getreg((3 << 11) | 20) & 0xFu; }
#define XB_SPIN(cond, bar) do { unsigned _sp = 0; while (cond) { __builtin_amdgcn_s_sleep(1); \
    if ((++_sp & 255u) == 0u) { if (xb_ld(&(bar)[XB_TMO])) break; if (_sp > XB_SPIN_CAP) { atomicAdd(&(bar)[XB_TMO], 1u); break; } } } } while (0)

struct XcdBarrier {
    unsigned* bar; unsigned x;
    volatile LAS unsigned* st;
};

__device__ __forceinline__ XcdBarrier xcd_barrier_post(unsigned* bar, volatile LAS unsigned* st) {
    XcdBarrier b; b.bar = bar; b.x = xb_xcc_id(); b.st = st;
    if (threadIdx.x == 0) (void)xb_add(&bar[XB_XCNT(b.x)], 1u);
    return b;
}
__device__ __forceinline__ void xcd_barrier_complete(unsigned* bar, unsigned x, unsigned& nloc, unsigned& nx) {
    const unsigned G = gridDim.x * gridDim.y * gridDim.z;
    unsigned sum, cnt, mine, sp = 0u;
    for (;;) {
        sum = 0u; cnt = 0u; mine = 0u;
#pragma unroll
        for (unsigned j = 0; j < 16; ++j) { const unsigned c = xb_ld(&bar[XB_XCNT(j)]); sum += c; cnt += (c > 0u) ? 1u : 0u; mine = (j == x) ? c : mine; }
        if (sum == G) break;
        __builtin_amdgcn_s_sleep(1);
        if ((++sp & 255u) == 0u) { if (xb_ld(&bar[XB_TMO])) break; if (sp > XB_SPIN_CAP) { atomicAdd(&bar[XB_TMO], 1u); break; } }
    }
    nloc = mine > 0u ? mine : 1u; nx = cnt > 0u ? cnt : 1u;
}

__device__ __forceinline__ void xcd_barrier(const XcdBarrier& b) {
    asm volatile("s_waitcnt vmcnt(0)" ::: "memory");
    __syncthreads();
    if (threadIdx.x == 0) {
        unsigned* bar = b.bar;
        __builtin_amdgcn_s_waitcnt(0);
        unsigned nloc = b.st[0], nx = b.st[1];
        if (nloc == 0u) { xcd_barrier_complete(bar, b.x, nloc, nx); b.st[0] = nloc; b.st[1] = nx; }
        const unsigned old = xb_add(&bar[XB_XSUB(b.x)], 1u);
        const unsigned gen = old / nloc;
        if (old + 1u == (gen + 1u) * nloc) {
            __builtin_amdgcn_fence(__ATOMIC_RELEASE, "agent");
            asm volatile("s_waitcnt vmcnt(0)" ::: "memory");
            const unsigned og = xb_add(&bar[XB_TOP], 1u);
            const unsigned tg = og / nx;
            if (og + 1u == (tg + 1u) * nx) xb_add(&bar[XB_TOPGEN], 1u);
            else XB_SPIN(xb_ld(&bar[XB_TOPGEN]) == tg, bar);
            __builtin_amdgcn_fence(__ATOMIC_ACQUIRE, "agent");
            xb_add(&bar[XB_XGEN(b.x)], 1u);
            asm volatile("s_waitcnt vmcnt(0)" ::: "memory");
        } else {
            XB_SPIN(xb_ld(&bar[XB_XGEN(b.x)]) == gen, bar);
            __builtin_amdgcn_fence(__ATOMIC_ACQUIRE, "agent");
            asm volatile("s_waitcnt vmcnt(0)" ::: "memory");
        }
    }
    __syncthreads();
}

constexpr int NWAVES = 8;
constexpr int RING_BYTES = 131072;
constexpr int LDSCTL_OFF = 144384, MISC_OFF = LDSCTL_OFF + 320, RTAB_OFF = LDSCTL_OFF + 1024;
constexpr int LDS_BYTES = 147456;
constexpr int CW_BAR = 4096;
typedef short bf16x8 __attribute__((ext_vector_type(8)));
typedef short s16x4 __attribute__((ext_vector_type(4)));
typedef float f32x16 __attribute__((ext_vector_type(16)));
typedef float f32x2_t __attribute__((ext_vector_type(2)));
typedef __bf16 bf16x2_t __attribute__((ext_vector_type(2)));
#define MFMA32(a, b, c) __builtin_amdgcn_mfma_f32_32x32x16_bf16((a), (b), (c), 0, 0, 0)
__device__ __forceinline__ unsigned cvtpk(float lo, float hi) { f32x2_t v = {lo, hi}; bf16x2_t b = __builtin_convertvector(v, bf16x2_t); return __builtin_bit_cast(unsigned, b); }
__device__ __forceinline__ int crow(int r, int hi) { return (r & 3) + 8 * (r >> 2) + 4 * hi; }
__device__ __forceinline__ float fexp2(float x) { return __builtin_amdgcn_exp2f(x); }
typedef short v4i16_t __attribute__((ext_vector_type(4)));
__device__ __forceinline__ s16x4 tr_read(const LAS char* p) { return __builtin_bit_cast(s16x4, __builtin_amdgcn_ds_read_tr16_b64_v4i16((LAS v4i16_t*)p)); }

struct Args { const float* in[30]; float* out; unsigned char* ws; int ph_lo, ph_hi; };

template <int DV> struct Flash { f32x16 o[DV / 32]; f32x16 negm; float mref, l; bool started; };
template <int DV> __device__ __forceinline__ void flash_init(Flash<DV>& f) {
#pragma unroll
    for (int d = 0; d < DV / 32; ++d)
#pragma unroll
        for (int r = 0; r < 16; ++r) f.o[d][r] = 0.f;
#pragma unroll
    for (int r = 0; r < 16; ++r) f.negm[r] = 0.f;
    f.mref = 0.f; f.l = 0.f; f.started = false;
}
constexpr float FLASH_THR = 6.0f;
template <int DK, int KS>
__device__ __forceinline__ void qk_scores(const bf16x8 (&qf)[DK / 16], const LAS char* kt, int lane, const f32x16& c, f32x16& p0, f32x16& p1) {
    const int r32 = lane & 31, hi = lane >> 5;
    const LAS char* kp = kt + r32 * KS + hi * 16;
    bf16x8 a0[DK / 16], a1[DK / 16];
#pragma unroll
    for (int ks = 0; ks < DK / 16; ++ks) { a0[ks] = *(const LAS bf16x8*)(kp + ks * 32); a1[ks] = *(const LAS bf16x8*)(kp + 32 * KS + ks * 32); }
    __builtin_amdgcn_sched_barrier(0);
#pragma unroll
    for (int ks = 0; ks < DK / 16; ++ks) {
        if (ks == 0) { p0 = MFMA32(a0[0], qf[0], c); p1 = MFMA32(a1[0], qf[0], c); }
        else { p0 = MFMA32(a0[ks], qf[ks], p0); p1 = MFMA32(a1[ks], qf[ks], p1); }
    }
}
__device__ __forceinline__ float tile_colmax(const f32x16& p0, const f32x16& p1) {
    float mx = __builtin_elementwise_maximum(p0[0], p1[0]);
#pragma unroll
    for (int r = 1; r < 16; ++r) mx = __builtin_elementwise_maximum(mx, __builtin_elementwise_maximum(p0[r], p1[r]));
    return max_x32(mx);
}
template <int DV, int VS>
__device__ __forceinline__ void pv_accum(f32x16 (&o)[DV / 32], const f32x16& p0, const f32x16& p1, const LAS char* vt, int lane) {
    const int hi = lane >> 5;
    const LAS char* vb = vt + (4 * hi + ((lane & 15) >> 2)) * VS + (((lane >> 4) & 1) * 16 + (lane & 3) * 4) * 2;
#pragma unroll
    for (int k4 = 0; k4 < 4; ++k4) {
        u32x4 pw;
        if (k4 < 2) { pw.x = cvtpk(p0[8 * (k4 & 1) + 0], p0[8 * (k4 & 1) + 1]); pw.y = cvtpk(p0[8 * (k4 & 1) + 2], p0[8 * (k4 & 1) + 3]); pw.z = cvtpk(p0[8 * (k4 & 1) + 4], p0[8 * (k4 & 1) + 5]); pw.w = cvtpk(p0[8 * (k4 & 1) + 6], p0[8 * (k4 & 1) + 7]); }
        else        { pw.x = cvtpk(p1[8 * (k4 & 1) + 0], p1[8 * (k4 & 1) + 1]); pw.y = cvtpk(p1[8 * (k4 & 1) + 2], p1[8 * (k4 & 1) + 3]); pw.z = cvtpk(p1[8 * (k4 & 1) + 4], p1[8 * (k4 & 1) + 5]); pw.w = cvtpk(p1[8 * (k4 & 1) + 6], p1[8 * (k4 & 1) + 7]); }
        const bf16x8 pf = __builtin_bit_cast(bf16x8, pw);
#pragma unroll
        for (int d = 0; d < DV / 32; ++d) {
            const s16x4 lo = tr_read(vb + (16 * k4) * VS + d * 64);
            const s16x4 hh = tr_read(vb + (16 * k4 + 8) * VS + d * 64);
            const bf16x8 a = {lo[0], lo[1], lo[2], lo[3], hh[0], hh[1], hh[2], hh[3]};
            o[d] = MFMA32(a, pf, o[d]);
        }
    }
}
typedef __bf16 bf16x2d __attribute__((ext_vector_type(2)));
__device__ __forceinline__ float dot2ones(unsigned a, float c) { return __builtin_amdgcn_fdot2_f32_bf16(__builtin_bit_cast(bf16x2d, a), __builtin_bit_cast(bf16x2d, 0x3f803f80u), c, false); }
struct PTile { u32x4 k[4]; };
__device__ __forceinline__ void pack_ptile(const f32x16& p0, const f32x16& p1, PTile& P) {
#pragma unroll
    for (int s = 0; s < 2; ++s) {
        P.k[s].x = cvtpk(p0[8 * s + 0], p0[8 * s + 1]); P.k[s].y = cvtpk(p0[8 * s + 2], p0[8 * s + 3]); P.k[s].z = cvtpk(p0[8 * s + 4], p0[8 * s + 5]); P.k[s].w = cvtpk(p0[8 * s + 6], p0[8 * s + 7]);
        P.k[2 + s].x = cvtpk(p1[8 * s + 0], p1[8 * s + 1]); P.k[2 + s].y = cvtpk(p1[8 * s + 2], p1[8 * s + 3]); P.k[2 + s].z = cvtpk(p1[8 * s + 4], p1[8 * s + 5]); P.k[2 + s].w = cvtpk(p1[8 * s + 6], p1[8 * s + 7]);
    }
}
template <int DV, int VS>
__device__ __forceinline__ void flash_pv(f32x16 (&o)[DV / 32], const PTile& P, const LAS char* vt, int lane) {
    const int hi = lane >> 5;
    const LAS char* vb = vt + (4 * hi + ((lane & 15) >> 2)) * VS + (((lane >> 4) & 1) * 16 + (lane & 3) * 4) * 2;
    s16x4 lo[2][DV / 32], hh[2][DV / 32];
#pragma unroll
    for (int d = 0; d < DV / 32; ++d) { lo[0][d] = tr_read(vb + d * 64); hh[0][d] = tr_read(vb + 8 * VS + d * 64); }
#pragma unroll
    for (int k4 = 0; k4 < 4; ++k4) {
        const int cur = k4 & 1, nxt = cur ^ 1;
        if (k4 < 3) {
#pragma unroll
            for (int d = 0; d < DV / 32; ++d) { lo[nxt][d] = tr_read(vb + (16 * (k4 + 1)) * VS + d * 64); hh[nxt][d] = tr_read(vb + (16 * (k4 + 1) + 8) * VS + d * 64); }
        }
        __builtin_amdgcn_sched_barrier(0);
        const bf16x8 pf = __builtin_bit_cast(bf16x8, P.k[k4]);
#pragma unroll
        for (int d = 0; d < DV / 32; ++d) {
            const bf16x8 a = {lo[cur][d][0], lo[cur][d][1], lo[cur][d][2], lo[cur][d][3], hh[cur][d][0], hh[cur][d][1], hh[cur][d][2], hh[cur][d][3]};
            o[d] = MFMA32(a, pf, o[d]);
        }
        __builtin_amdgcn_sched_barrier(0);
    }
}
template <int DK, int DV, int KS, bool HASCOL, class MaskF>
__device__ __forceinline__ void flash_qk_sm(Flash<DV>& f, const bf16x8 (&qf)[DK / 16], const LAS char* kt, int lane, bool colsel, MaskF mask, PTile& P) {
    f32x16 p0, p1;
    if (HASCOL) { f32x16 c;
#pragma unroll
        for (int r = 0; r < 16; ++r) c[r] = colsel ? f.negm[r] : -INFINITY;
        qk_scores<DK, KS>(qf, kt, lane, c, p0, p1);
    } else qk_scores<DK, KS>(qf, kt, lane, f.negm, p0, p1);
    mask(p0, p1);
    const float cm = tile_colmax(p0, p1);
    const bool fin = cm > -INFINITY;
    const float delta = f.started ? (cm > FLASH_THR ? cm : 0.f) : (fin ? cm : 0.f);
    if (__any(delta != 0.f)) {
        const float fac = f.started ? fexp2(-delta) : 1.f;
#pragma unroll
        for (int r = 0; r < 16; ++r) { p0[r] -= delta; p1[r] -= delta; }
#pragma unroll
        for (int d = 0; d < DV / 32; ++d)
#pragma unroll
            for (int r = 0; r < 16; ++r) f.o[d][r] *= fac;
        f.l *= fac; f.mref += delta;
#pragma unroll
        for (int r = 0; r < 16; ++r) f.negm[r] = -f.mref;
    }
    f.started = f.started || fin;
#pragma unroll
    for (int r = 0; r < 16; ++r) { p0[r] = fexp2(p0[r]); p1[r] = fexp2(p1[r]); }
    pack_ptile(p0, p1, P);
    float ps = 0.f;
#pragma unroll
    for (int k = 0; k < 4; ++k) { ps = dot2ones(P.k[k].x, ps); ps = dot2ones(P.k[k].y, ps); ps = dot2ones(P.k[k].z, ps); ps = dot2ones(P.k[k].w, ps); }
    f.l += ps;
}
template <int DK, int DV, int KS, int VS, bool HASCOL, class MaskF>
__device__ __forceinline__ void flash_tile(Flash<DV>& f, const bf16x8 (&qf)[DK / 16], const LAS char* kt, const LAS char* vt, int lane, bool colsel, MaskF mask) {
    PTile P; flash_qk_sm<DK, DV, KS, HASCOL>(f, qf, kt, lane, colsel, mask, P); flash_pv<DV, VS>(f.o, P, vt, lane);
}

#define LDS_BARRIER() do { asm volatile("s_waitcnt lgkmcnt(0)" ::: "memory"); __builtin_amdgcn_s_barrier(); asm volatile("" ::: "memory"); } while (0)
constexpr int DA_KS = 144, DA_VS = 320, DA_K1OFF = 64 * DA_KS, DA_KBUF = 2 * 64 * DA_KS, DA_VBUF = 64 * DA_VS, DA_VBASE = 2 * DA_KBUF;
__device__ __forceinline__ void da_unit(const Args& a, int h, int qb, LAS char* lds) {
    unsigned char* ws = a.ws;
    const bf16* QDA = (const bf16*)(ws + WS_QDA); const bf16* KDA = (const bf16*)(ws + WS_KDA); const bf16* VDA = (const bf16*)(ws + WS_VDA);
    bf16* ODA = (bf16*)(ws + WS_ODA);
    const int tid = threadIdx.x, lane = tid & 63, w = __builtin_amdgcn_readfirstlane(tid >> 6), m = w >> 2, wq = w & 3;
    const int r32 = lane & 31, hi = lane >> 5;
    const int qrow0 = 128 * qb + 32 * wq, q = qrow0 + r32;
    bf16x8 qf[4];
#pragma unroll
    for (int ks = 0; ks < 4; ++ks) qf[ks] = *(const bf16x8*)(QDA + (size_t)q * 1024 + h * 128 + m * 64 + 16 * ks + 8 * hi);
    Flash<128> f; flash_init(f);
    const int ntiles = 2 * qb + 2;
    const int nmine = (qrow0 + 31) / 64 + 1;
    const int kkey = tid >> 3, kc = tid & 7;
    const bf16* k0src = KDA + (size_t)kkey * 1024 + h * 128 + kc * 8;
    const bf16* vsrc0 = VDA + (size_t)(tid >> 4) * 1024 + h * 128 + (tid & 15) * 8;
    const int kdst = kkey * DA_KS + kc * 16, vdst0 = DA_VBASE + (tid >> 4) * DA_VS + (tid & 15) * 16, vdst1 = vdst0 + 32 * DA_VS;
    u32x4 sA[4], sB[4];
#define DA_LOAD(S, kt) do { const size_t o_ = (size_t)(kt) * 64 * 1024; S[0] = *(const u32x4*)(k0src + o_); S[1] = *(const u32x4*)(k0src + o_ + 64); S[2] = *(const u32x4*)(vsrc0 + o_); S[3] = *(const u32x4*)(vsrc0 + o_ + 32 * 1024); } while (0)
#define DA_STORE(S, kt) do { LAS char* kb_ = lds + ((kt) & 1) * DA_KBUF; const int vo_ = ((kt) % 3) * DA_VBUF; *(LAS u32x4*)(kb_ + kdst) = S[0]; *(LAS u32x4*)(kb_ + DA_K1OFF + kdst) = S[1]; *(LAS u32x4*)(lds + vo_ + vdst0) = S[2]; *(LAS u32x4*)(lds + vo_ + vdst1) = S[3]; } while (0)
#define DA_QKSM(kt) do { const int key0 = 64 * (kt); const bool need_mask = key0 + 63 > qrow0; \
            flash_qk_sm<64, 128, DA_KS, false>(f, qf, lds + ((kt) & 1) * DA_KBUF + m * DA_K1OFF, lane, true, [&](f32x16& p0, f32x16& p1) { \
                if (need_mask) { \
                    _Pragma("unroll") for (int r = 0; r < 16; ++r) { const int key = key0 + crow(r, hi); if (key > q) p0[r] = -INFINITY; if (key + 32 > q) p1[r] = -INFINITY; } \
                } }, P); } while (0)
#define DA_PV(kt) flash_pv<128, DA_VS>(f.o, P, lds + DA_VBASE + ((kt) % 3) * DA_VBUF, lane)
#define DA_STEP(kt, S) do { \
        if (m == 1 && (kt) >= 1 && (kt) - 1 < nmine) DA_PV((kt) - 1); \
        if ((kt) < nmine) DA_QKSM(kt); \
        if (m == 0 && (kt) < nmine) DA_PV(kt); \
        if ((kt) + 1 < ntiles) DA_STORE(S, (kt) + 1); if ((kt) + 3 < ntiles) DA_LOAD(S, (kt) + 3); LDS_BARRIER(); } while (0)
    PTile P;
    DA_LOAD(sA, 0); DA_STORE(sA, 0);
    DA_LOAD(sB, 1);
    if (ntiles > 2) DA_LOAD(sA, 2);
    LDS_BARRIER();
    for (int kt = 0; kt < ntiles; kt += 2) { DA_STEP(kt, sB); DA_STEP(kt + 1, sA); }
    if (m == 1 && ntiles - 1 < nmine) DA_PV(ntiles - 1);
    __syncthreads();
#undef DA_LOAD
#undef DA_STORE
#undef DA_QKSM
#undef DA_PV
#undef DA_STEP
    const float l = sum_x32(f.l);
    const float inv = 1.f / l;
    LAS float* o1s = (LAS float*)lds;
    if (m == 1) {
#pragma unroll
        for (int d = 0; d < 4; ++d)
#pragma unroll
            for (int r = 0; r < 16; ++r) o1s[(d * 16 + r) * 256 + wq * 64 + lane] = f.o[d][r] * inv;
    }
    __syncthreads();
    if (m == 0) {
        const float lam = ((const float*)(ws + WS_SCAL))[0];
        float ss = 0.f;
#pragma unroll
        for (int d = 0; d < 4; ++d)
#pragma unroll
            for (int r = 0; r < 16; ++r) { const float v = f.o[d][r] * inv - lam * o1s[(d * 16 + r) * 256 + wq * 64 + lane]; f.o[d][r] = v; ss += v * v; }
        ss = sum_x32(ss);
        const float rr = rsqrtf(ss * (1.f / 128.f) + EPS) * (1.f - LAMBDA_INIT);
        const float* sg = a.in[9];
#pragma unroll
        for (int d = 0; d < 4; ++d)
#pragma unroll
            for (int r4 = 0; r4 < 4; r4 += 2) { u32x2 o2[2];
#pragma unroll
                for (int p2 = 0; p2 < 2; ++p2) { const int dv = 32 * d + 8 * (r4 + p2) + 4 * hi; const f32x4 g4 = *(const f32x4*)(sg + dv);
                    o2[p2].x = pk2(f.o[d][4 * (r4 + p2)] * rr * g4.x, f.o[d][4 * (r4 + p2) + 1] * rr * g4.y); o2[p2].y = pk2(f.o[d][4 * (r4 + p2) + 2] * rr * g4.z, f.o[d][4 * (r4 + p2) + 3] * rr * g4.w); }
                *(u32x4*)(ODA + (size_t)q * 1024 + h * 128 + 32 * d + 8 * r4 + 8 * hi) = t21_pair(o2[0], o2[1]); }
    }
    __syncthreads();
}
template <class F> struct EpiFn {
    static constexpr bool PERM = false, AFTER_DRAIN = false, CHAIN = false; F f;
    __device__ __forceinline__ void operator()(const pg8::f32x4 (&acc)[2][2][4][2], const pg8::Unit& u, int wr, int wc, int fr, int fq) const {
#pragma unroll
        for (int ai = 0; ai < 2; ++ai)
#pragma unroll
            for (int m = 0; m < 4; ++m) { const int row = u.pm * 256 + ai * 128 + wr * 64 + m * 16 + fr;
#pragma unroll
                for (int bj = 0; bj < 2; ++bj)
#pragma unroll
                    for (int n = 0; n < 2; ++n) f(row, u.pn * 256 + bj * 128 + wc * 32 + n * 16 + fq * 4, acc[ai][bj][m][n]); }
    }
};
struct FStoreBf16 { bf16* O; int ldc; __device__ __forceinline__ void operator()(int row, int col, f32x4 v) const { u32x2 w; w.x = pk2(v.x, v.y); w.y = pk2(v.z, v.w); *(u32x2*)(O + (size_t)row * ldc + col) = w; } };
struct FGate0 { bf16* MIX; const bf16* BG; __device__ __forceinline__ void operator()(int row, int col, f32x4 v) const {
    const u32x2 g = *(const u32x2*)(BG + (size_t)row * 4096 + col); u32x2 w;
    w.x = pk2(v.x * __uint_as_float(g.x << 16), v.y * __uint_as_float(g.x & 0xffff0000u)); w.y = pk2(v.z * __uint_as_float(g.y << 16), v.w * __uint_as_float(g.y & 0xffff0000u));
    *(u32x2*)(MIX + (size_t)row * 2048 + col) = w; } };
struct FGate1 { bf16* MIX; const bf16* BG; __device__ __forceinline__ void operator()(int row, int col, f32x4 v) const {
    const u32x2 g = *(const u32x2*)(BG + (size_t)row * 4096 + 2048 + col); const u32x2 o = *(const u32x2*)(MIX + (size_t)row * 2048 + col); u32x2 w;
    w.x = pk2(__uint_as_float(o.x << 16) + v.x * __uint_as_float(g.x << 16), __uint_as_float(o.x & 0xffff0000u) + v.y * __uint_as_float(g.x & 0xffff0000u));
    w.y = pk2(__uint_as_float(o.y << 16) + v.z * __uint_as_float(g.y << 16), __uint_as_float(o.y & 0xffff0000u) + v.w * __uint_as_float(g.y & 0xffff0000u));
    *(u32x2*)(MIX + (size_t)row * 2048 + col) = w; } };
struct EpiGateChain {
    static constexpr bool PERM = true, AFTER_DRAIN = false, CHAIN = true; bf16* MIX; const bf16* BG;
    static __device__ __forceinline__ void unp(const u32x4 t, f32x4& a, f32x4& c) {
        a = (f32x4){__uint_as_float(t.x << 16), __uint_as_float(t.x & 0xffff0000u), __uint_as_float(t.y << 16), __uint_as_float(t.y & 0xffff0000u)};
        c = (f32x4){__uint_as_float(t.z << 16), __uint_as_float(t.z & 0xffff0000u), __uint_as_float(t.w << 16), __uint_as_float(t.w & 0xffff0000u)}; }
    static __device__ __forceinline__ f32x4 rcp4(f32x4 g) { return (f32x4){__builtin_amdgcn_rcpf(g.x), __builtin_amdgcn_rcpf(g.y), __builtin_amdgcn_rcpf(g.z), __builtin_amdgcn_rcpf(g.w)}; }
    static __device__ __forceinline__ f32x4 clampg(f32x4 g) { return (f32x4){__builtin_elementwise_maximum(g.x, 1e-30f), __builtin_elementwise_maximum(g.y, 1e-30f), __builtin_elementwise_maximum(g.z, 1e-30f), __builtin_elementwise_maximum(g.w, 1e-30f)}; }
    __device__ __forceinline__ void mid(pg8::f32x4 (&acc)[2][2][4][2], const pg8::Unit& u, int wr, int wc, int fr, int fq) const {
#pragma unroll
        for (int ai = 0; ai < 2; ++ai)
#pragma unroll
            for (int m = 0; m < 4; ++m) { const int row = u.pm * 256 + ai * 128 + wr * 64 + m * 16 + fr;
#pragma unroll
                for (int bj = 0; bj < 2; ++bj) { const int col = u.pn * 256 + bj * 128 + wc * 32 + 8 * fq;
                    f32x4 g00, g01, g10, g11; unp(*(const u32x4*)(BG + (size_t)row * 4096 + col), g00, g01); unp(*(const u32x4*)(BG + (size_t)row * 4096 + 2048 + col), g10, g11);
                    acc[ai][bj][m][0] = acc[ai][bj][m][0] * (g00 * rcp4(clampg(g10))); acc[ai][bj][m][1] = acc[ai][bj][m][1] * (g01 * rcp4(clampg(g11))); } }
    }
    __device__ __forceinline__ void operator()(const pg8::f32x4 (&acc)[2][2][4][2], const pg8::Unit& u, int wr, int wc, int fr, int fq) const {
#pragma unroll
        for (int ai = 0; ai < 2; ++ai)
#pragma unroll
            for (int m = 0; m < 4; ++m) { const int row = u.pm * 256 + ai * 128 + wr * 64 + m * 16 + fr;
#pragma unroll
                for (int bj = 0; bj < 2; ++bj) { const int col = u.pn * 256 + bj * 128 + wc * 32 + 8 * fq;
                    f32x4 g10, g11; unp(*(const u32x4*)(BG + (size_t)row * 4096 + 2048 + col), g10, g11);
                    const f32x4 v0 = acc[ai][bj][m][0] * clampg(g10), v1 = acc[ai][bj][m][1] * clampg(g11);
                    u32x4 w; w.x = pk2(v0.x, v0.y); w.y = pk2(v0.z, v0.w); w.z = pk2(v1.x, v1.y); w.w = pk2(v1.z, v1.w);
                    *(u32x4*)(MIX + (size_t)row * 2048 + col) = w; } }
    }
};
template <bool BB> struct EpiResSS {
    static constexpr bool PERM = true, AFTER_DRAIN = false, CHAIN = false; const void* base; bf16* outb; float* ss;
    __device__ __forceinline__ void operator()(const pg8::f32x4 (&acc)[2][2][4][2], const pg8::Unit& u, int wr, int wc, int fr, int fq) const {
#pragma unroll
        for (int ai = 0; ai < 2; ++ai)
#pragma unroll
            for (int m = 0; m < 4; ++m) { const int row = u.pm * 256 + ai * 128 + wr * 64 + m * 16 + fr; float sq = 0.f;
#pragma unroll
                for (int bj = 0; bj < 2; ++bj) { const size_t o = (size_t)row * 2048 + u.pn * 256 + bj * 128 + wc * 32 + 8 * fq;
                    f32x4 b0, b1;
                    if (BB) { const u32x4 t = *(const u32x4*)((const bf16*)base + o);
                        b0 = (f32x4){__uint_as_float(t.x << 16), __uint_as_float(t.x & 0xffff0000u), __uint_as_float(t.y << 16), __uint_as_float(t.y & 0xffff0000u)};
                        b1 = (f32x4){__uint_as_float(t.z << 16), __uint_as_float(t.z & 0xffff0000u), __uint_as_float(t.w << 16), __uint_as_float(t.w & 0xffff0000u)}; }
                    else { b0 = *(const f32x4*)((const float*)base + o); b1 = *(const f32x4*)((const float*)base + o + 4); }
                    const f32x4 v0 = acc[ai][bj][m][0] + b0, v1 = acc[ai][bj][m][1] + b1;
                    u32x4 w; w.x = pk2(v0.x, v0.y); w.y = pk2(v0.z, v0.w); w.z = pk2(v1.x, v1.y); w.w = pk2(v1.z, v1.w); *(u32x4*)(outb + o) = w;
                    sq += ((v0.x * v0.x + v0.y * v0.y) + (v0.z * v0.z + v0.w * v0.w)) + ((v1.x * v1.x + v1.y * v1.y) + (v1.z * v1.z + v1.w * v1.w)); }
                sq = sum_x32(sum_x16(sq));
                if (fq == 0) ss[(size_t)(u.pn * 4 + wc) * S_ + row] = sq; }
    }
};
struct FRowScaleL { const LAS float* rtab; bf16* O; float scale; int ldc;
    __device__ __forceinline__ void operator()(int row, int col, f32x4 v) const { const float s = rtab[row & 255] * scale; u32x2 w; w.x = pk2(v.x * s, v.y * s); w.y = pk2(v.z * s, v.w * s); *(u32x2*)(O + (size_t)row * ldc + col) = w; } };
template <class F> struct EpiFn8 {
    static constexpr bool PERM = true, AFTER_DRAIN = false, CHAIN = false; F f;
    __device__ __forceinline__ void operator()(const pg8::f32x4 (&acc)[2][2][4][2], const pg8::Unit& u, int wr, int wc, int fr, int fq) const {
#pragma unroll
        for (int ai = 0; ai < 2; ++ai)
#pragma unroll
            for (int m = 0; m < 4; ++m) { const int row = u.pm * 256 + ai * 128 + wr * 64 + m * 16 + fr;
#pragma unroll
                for (int bj = 0; bj < 2; ++bj) f(row, u.pn * 256 + bj * 128 + wc * 32 + 8 * fq, acc[ai][bj][m][0], acc[ai][bj][m][1]); }
    }
};
struct FStoreBf16x8 { bf16* O; int ldc; __device__ __forceinline__ void operator()(int row, int col, f32x4 v0, f32x4 v1) const { u32x4 w; w.x = pk2(v0.x, v0.y); w.y = pk2(v0.z, v0.w); w.z = pk2(v1.x, v1.y); w.w = pk2(v1.z, v1.w); *(u32x4*)(O + (size_t)row * ldc + col) = w; } };
struct FRowScaleL8 { const LAS float* rtab; bf16* O; float scale; int ldc;
    __device__ __forceinline__ void operator()(int row, int col, f32x4 v0, f32x4 v1) const { const float s = rtab[row & 255] * scale;
        u32x4 w; w.x = pk2(v0.x * s, v0.y * s); w.y = pk2(v0.z * s, v0.w * s); w.z = pk2(v1.x * s, v1.y * s); w.w = pk2(v1.z * s, v1.w * s); *(u32x4*)(O + (size_t)row * ldc + col) = w; } };
__device__ __forceinline__ void make_rtab(const pg8::StaticOrder& S, const float* ss, LAS float* rtab) {
    pg8::Unit u;
    if (S.next(0, u) && threadIdx.x < 256) { const int row = u.pm * 256 + threadIdx.x; float s = 0.f;
#pragma unroll
        for (int k = 0; k < 32; ++k) s += ss[(size_t)k * S_ + row];
        rtab[threadIdx.x] = rsqrtf(s * (1.f / DM) + EPS); }
    __syncthreads();
}

constexpr int TR_I0 = 32 * (NZ / 32), TR_I1 = 16 * 64, TR_I2 = 16 * 64, TR_I3 = 32 * 64, TR_I4 = 32 * 16, TR_I5 = 32 * 32, TR_I6 = 8 * 64, TR_I7 = 32 * 64, TR_I8 = 32 * 4;
constexpr int TR_NEARLY = TR_I0 + TR_I5, TR_NIT = TR_I0 + TR_I1 + TR_I2 + TR_I3 + TR_I4 + TR_I5 + TR_I6 + TR_I7 + 2 * TR_I8;
__device__ __forceinline__ TrItem tr_item_of(const Args& P, int it) {
    unsigned char* ws = P.ws;
    int r = it; TrItem t; t.gk = nullptr; t.zmap = false; t.kblk = false;
    if (r < TR_I0) { t.W = P.in[4]; t.K = 2048; t.Nsrc = 9776; t.WT = (bf16*)(ws + WS_W1T); t.zmap = true; t.kb = r / (NZ / 32); t.nb = r % (NZ / 32); return t; } r -= TR_I0;
    if (r < TR_I5) { t.W = P.in[21]; t.K = 2048; t.Nsrc = 1024; t.WT = (bf16*)(ws + WS_WXKV); t.kb = r / 32; t.nb = r % 32; return t; } r -= TR_I5;
    if (r < TR_I1) { t.W = P.in[15]; t.K = 1024; t.Nsrc = 2048; t.WT = (bf16*)(ws + WS_WBDA); t.kb = r / 64; t.nb = r % 64; return t; } r -= TR_I1;
    if (r < TR_I2) { t.W = P.in[16]; t.K = 1024; t.Nsrc = 2048; t.WT = (bf16*)(ws + WS_WBNSA); t.kb = r / 64; t.nb = r % 64; return t; } r -= TR_I2;
    if (r < TR_I3) { t.W = P.in[17]; t.K = 2048; t.Nsrc = 2048; t.WT = (bf16*)(ws + WS_WOUT); t.kb = r / 64; t.nb = r % 64; return t; } r -= TR_I3;
    if (r < TR_I4) { t.W = P.in[20]; t.K = 2048; t.Nsrc = 512; t.WT = (bf16*)(ws + WS_WXQ); t.gk = P.in[18]; t.kb = r / 16; t.nb = r % 16; return t; } r -= TR_I4;
    if (r < TR_I6) { t.W = P.in[22]; t.K = 512; t.Nsrc = 2048; t.WT = (bf16*)(ws + WS_WXO); t.kb = r / 64; t.nb = r % 64; return t; } r -= TR_I6;
    if (r < TR_I7) { t.W = P.in[24]; t.K = 2048; t.Nsrc = 2048; t.WT = (bf16*)(ws + WS_WPQ); t.gk = P.in[23]; t.kb = r / 64; t.nb = r % 64; return t; } r -= TR_I7;
    const int wh = r / TR_I8; r %= TR_I8; t.W = P.in[wh ? 13 : 11]; t.K = 2048; t.Nsrc = 128; t.WT = (bf16*)(ws + WS_W1C) + (size_t)wh * 128 * 2048; t.kb = r / 4; t.nb = r % 4; t.kblk = true; return t;
}
__device__ __forceinline__ void tr_items(const Args& P, LAS float* scr, int lane, int lo, int hi, int w, int nw) {
    const int first = lo + w;
    if (first < hi) {
        f32x4 va[8], vb[8]; TrItem ta = tr_item_of(P, first), tb; tr_load(ta, lane, va);
        for (int it = first; it < hi; it += 2 * nw) {
            const bool hb = it + nw < hi;
            if (hb) { tb = tr_item_of(P, it + nw); tr_load(tb, lane, vb); }
            tr_finish(ta, lane, va, scr);
            if (it + 2 * nw < hi) { ta = tr_item_of(P, it + 2 * nw); tr_load(ta, lane, va); }
            if (hb) tr_finish(tb, lane, vb, scr);
        }
    }
}
__device__ __forceinline__ void p_prologue(const Args& P, LAS char* lds, int gw, int NGW, int gt, int NGT) {
    const int tid = threadIdx.x, lane = tid & 63, wave = tid >> 6;
    LAS float* scr = (LAS float*)lds + wave * 64 * 33;
    unsigned char* ws = P.ws;
    tr_items(P, scr, lane, 0, TR_NIT, gw, NGW);
    for (int m = gw; m < S_ + MEML; m += 2 * NGW) {
        const int m2 = m + NGW; const bool v2 = m2 < S_ + MEML; const int mb = v2 ? m2 : m;
        f32x4 va[8], vb[8];
        rms_row_load(m < S_ ? P.in[0] + (size_t)m * DM : P.in[1] + (size_t)(m - S_) * DM, lane, va);
        rms_row_load(mb < S_ ? P.in[0] + (size_t)mb * DM : P.in[1] + (size_t)(mb - S_) * DM, lane, vb);
        if (m < S_) rms_row_finish(va, P.in[3], (bf16*)(ws + WS_XN) + (size_t)m * DM, lane); else rms_row_finish(va, P.in[19], (bf16*)(ws + WS_MEMN) + (size_t)(m - S_) * DM, lane);
        if (v2) { if (m2 < S_) rms_row_finish(vb, P.in[3], (bf16*)(ws + WS_XN) + (size_t)m2 * DM, lane); else rms_row_finish(vb, P.in[19], (bf16*)(ws + WS_MEMN) + (size_t)(m2 - S_) * DM, lane); }
    }
    for (int i = gt; i < S_ * 8; i += NGT) {
        const int t = i >> 3, j = i & 7;
        float iv = 1.0f;
        iv = (j == 1) ? 0.19392274f : iv; iv = (j == 2) ? 0.037606031f : iv; iv = (j == 3) ? 0.0072926646f : iv; iv = (j == 4) ? 0.0014142136f : iv;
        iv = (j == 5) ? 0.00027424819f : iv; iv = (j == 6) ? 5.3182957e-05f : iv; iv = (j == 7) ? 1.0313385e-05f : iv;
        const float ang = (float)((const int*)P.in[2])[t] * iv;
        const double ad = (double)ang; const double k = rint(ad * 0.15915494309189535); const float rr = (float)(ad - k * 6.283185307179586);
        ((float*)(ws + WS_COS))[i] = cosf(rr); ((float*)(ws + WS_SIN))[i] = sinf(rr);
    }
    if (gt < 64) {
        float a = P.in[5][lane] * P.in[6][lane], b = P.in[7][lane] * P.in[8][lane];
        a = wave_sum(a); b = wave_sum(b);
        if (lane == 0) ((float*)(ws + WS_SCAL))[0] = expf(a) - expf(b) + LAMBDA_INIT;
    }
    if (gt < 256) { ((bf16*)(ws + WS_KC))[511 * 256 + gt] = 0; ((bf16*)(ws + WS_VC))[511 * 256 + gt] = 0; }
    if (gw >= 256 && gw < 512) { const int o = gw - 256, wh = o >> 7, hcol = o & 127; const float* w1 = wh ? P.in[13] : P.in[11]; const float* pos = P.in[10]; float s = 0.f;
#pragma unroll
        for (int j = 0; j < 32; ++j) { const int i = lane + 64 * j; s += pos[i] * w1[(size_t)i * 128 + hcol]; }
        s = wave_sum(s); if (lane == 0) ((float*)(ws + WS_CPOS))[wh * 128 + hcol] = s; }
}

typedef __bf16 bf16x2v __attribute__((ext_vector_type(2)));
typedef _Float16 h2_t __attribute__((ext_vector_type(2)));
constexpr size_t WS_VQS = 176 * MiB;
__device__ __forceinline__ float ub0(unsigned x) { return (float)(x & 0xffu); }
__device__ __forceinline__ float ub1(unsigned x) { return (float)((x >> 8) & 0xffu); }
__device__ __forceinline__ float ub2(unsigned x) { return (float)((x >> 16) & 0xffu); }
__device__ __forceinline__ float ub3(unsigned x) { return (float)(x >> 24); }
__device__ __forceinline__ float dot2bf(unsigned a, unsigned b, float c) { return __builtin_amdgcn_fdot2_f32_bf16(__builtin_bit_cast(bf16x2v, a), __builtin_bit_cast(bf16x2v, b), c, false); }
__device__ __forceinline__ void top16_of_128(f32x16 (&acc)[4], LAS float* vout, LAS int* iout, int r32, int hi) {
    float e[64];
#pragma unroll
    for (int b = 0; b < 4; ++b)
#pragma unroll
        for (int r = 0; r < 16; ++r) e[16 * b + r] = __uint_as_float((__float_as_uint(acc[b][r]) & 0xffffff80u) | (unsigned)(32 * b + crow(r, hi)));
    { const float a_ = e[0], b_ = e[1]; e[0] = __builtin_elementwise_maximum(a_, b_); e[1] = __builtin_elementwise_minimum(a_, b_); }
    { const float a_ = e[3], b_ = e[2]; e[3] = __builtin_elementwise_maximum(a_, b_); e[2] = __builtin_elementwise_minimum(a_, b_); }
    { const float a_ = e[4], b_ = e[5]; e[4] = __builtin_elementwise_maximum(a_, b_); e[5] = __builtin_elementwise_minimum(a_, b_); }
    { const float a_ = e[7], b_ = e[6]; e[7] = __builtin_elementwise_maximum(a_, b_); e[6] = __builtin_elementwise_minimum(a_, b_); }
    { const float a_ = e[8], b_ = e[9]; e[8] = __builtin_elementwise_maximum(a_, b_); e[9] = __builtin_elementwise_minimum(a_, b_); }
    { const float a_ = e[11], b_ = e[10]; e[11] = __builtin_elementwise_maximum(a_, b_); e[10] = __builtin_elementwise_minimum(a_, b_); }
    { const float a_ = e[12], b_ = e[13]; e[12] = __builtin_elementwise_maximum(a_, b_); e[13] = __builtin_elementwise_minimum(a_, b_); }
    { const float a_ = e[15], b_ = e[14]; e[15] = __builtin_elementwise_maximum(a_, b_); e[14] = __builtin_elementwise_minimum(a_, b_); }
    { const float a_ = e[0], b_ = e[2]; e[0] = __builtin_elementwise_maximum(a_, b_); e[2] = __builtin_elementwise_minimum(a_, b_); }
    { const float a_ = e[1], b_ = e[3]; e[1] = __builtin_elementwise_maximum(a_, b_); e[3] = __builtin_elementwise_minimum(a_, b_); }
    { const float a_ = e[6], b_ = e[4]; e[6] = __builtin_elementwise_maximum(a_, b_); e[4] = __builtin_elementwise_minimum(a_, b_); }
    { const float a_ = e[7], b_ = e[5]; e[7] = __builtin_elementwise_maximum(a_, b_); e[5] = __builtin_elementwise_minimum(a_, b_); }
    { const float a_ = e[8], b_ = e[10]; e[8] = __builtin_elementwise_maximum(a_, b_); e[10] = __builtin_elementwise_minimum(a_, b_); }
    { const float a_ = e[9], b_ = e[11]; e[9] = __builtin_elementwise_maximum(a_, b_); e[11] = __builtin_elementwise_minimum(a_, b_); }
    { const float a_ = e[14], b_ = e[12]; e[14] = __builtin_elementwise_maximum(a_, b_); e[12] = __builtin_elementwise_minimum(a_, b_); }
    { const float a_ = e[15], b_ = e[13]; e[15] = __builtin_elementwise_maximum(a_, b_); e[13] = __builtin_elementwise_minimum(a_, b_); }
    { const float a_ = e[0], b_ = e[1]; e[0] = __builtin_elementwise_maximum(a_, b_); e[1] = __builtin_elementwise_minimum(a_, b_); }
    { const float a_ = e[2], b_ = e[3]; e[2] = __builtin_elementwise_maximum(a_, b_); e[3] = __builtin_elementwise_minimum(a_, b_); }
    { const float a_ = e[5], b_ = e[4]; e[5] = __builtin_elementwise_maximum(a_, b_); e[4] = __builtin_elementwise_minimum(a_, b_); }
    { const float a_ = e[7], b_ = e[6]; e[7] = __builtin_elementwise_maximum(a_, b_); e[6] = __builtin_elementwise_minimum(a_, b_); }
    { const float a_ = e[8], b_ = e[9]; e[8] = __builtin_elementwise_maximum(a_, b_); e[9] = __builtin_elementwise_minimum(a_, b_); }
    { const float a_ = e[10], b_ = e[11]; e[10] = __builtin_elementwise_maximum(a_, b_); e[11] = __builtin_elementwise_minimum(a_, b_); }
    { const float a_ = e[13], b_ = e[12]; e[13] = __builtin_elementwise_maximum(a_, b_); e[12] = __builtin_elementwise_minimum(a_, b_); }
    { const float a_ = e[15], b_ = e[14]; e[15] = __builtin_elementwise_maximum(a_, b_); e[14] = __builtin_elementwise_minimum(a_, b_); }
    { const float a_ = e[0], b_ = e[4]; e[0] = __builtin_elementwise_maximum(a_, b_); e[4] = __builtin_elementwise_minimum(a_, b_); }
    { const float a_ = e[1], b_ = e[5]; e[1] = __builtin_elementwise_maximum(a_, b_); e[5] = __builtin_elementwise_minimum(a_, b_); }
    { const float a_ = e[2], b_ = e[6]; e[2] = __builtin_elementwise_maximum(a_, b_); e[6] = __builtin_elementwise_minimum(a_, b_); }
    { const float a_ = e[3], b_ = e[7]; e[3] = __builtin_elementwise_maximum(a_, b_); e[7] = __builtin_elementwise_minimum(a_, b_); }
    { const float a_ = e[12], b_ = e[8]; e[12] = __builtin_elementwise_maximum(a_, b_); e[8] = __builtin_elementwise_minimum(a_, b_); }
    { const float a_ = e[13], b_ = e[9]; e[13] = __builtin_elementwise_maximum(a_, b_); e[9] = __builtin_elementwise_minimum(a_, b_); }
    { const float a_ = e[14], b_ = e[10]; e[14] = __builtin_elementwise_maximum(a_, b_); e[10] = __builtin_elementwise_minimum(a_, b_); }
    { const float a_ = e[15], b_ = e[11]; e[15] = __builtin_elementwise_maximum(a_, b_); e[11] = __builtin_elementwise_minimum(a_, b_); }
    { const float a_ = e[0], b_ = e[2]; e[0] = __builtin_elementwise_maximum(a_, b_); e[2] = __builtin_elementwise_minimum(a_, b_); }
    { const float a_ = e[1], b_ = e[3]; e[1] = __builtin_elementwise_maximum(a_, b_); e[3] = __builtin_elementwise_minimum(a_, b_); }
    { const float a_ = e[4], b_ = e[6]; e[4] = __builtin_elementwise_maximum(a_, b_); e[6] = __builtin_elementwise_minimum(a_, b_); }
    { const float a_ = e[5], b_ = e[7]; e[5] = __builtin_elementwise_maximum(a_, b_); e[7] = __builtin_elementwise_minimum(a_, b_); }
    { const float a_ = e[10], b_ = e[8]; e[10] = __builtin_elementwise_maximum(a_, b_); e[8] = __builtin_elementwise_minimum(a_, b_); }
    { const float a_ = e[11], b_ = e[9]; e[11] = __builtin_elementwise_maximum(a_, b_); e[9] = __builtin_elementwise_minimum(a_, b_); }
    { const float a_ = e[14], b_ = e[12]; e[14] = __builtin_elementwise_maximum(a_, b_); e[12] = __builtin_elementwise_minimum(a_, b_); }
    { const float a_ = e[15], b_ = e[13]; e[15] = __builtin_elementwise_maximum(a_, b_); e[13] = __builtin_elementwise_minimum(a_, b_); }
    { const float a_ = e[0], b_ = e[1]; e[0] = __builtin_elementwise_maximum(a_, b_); e[1] = __builtin_elementwise_minimum(a_, b_); }
    { const float a_ = e[2], b_ = e[3]; e[2] = __builtin_elementwise_maximum(a_, b_); e[3] = __builtin_elementwise_minimum(a_, b_); }
    { const float a_ = e[4], b_ = e[5]; e[4] = __builtin_elementwise_maximum(a_, b_); e[5] = __builtin_elementwise_minimum(a_, b_); }
    { const float a_ = e[6], b_ = e[7]; e[6] = __builtin_elementwise_maximum(a_, b_); e[7] = __builtin_elementwise_minimum(a_, b_); }
    { const float a_ = e[9], b_ = e[8]; e[9] = __builtin_elementwise_maximum(a_, b_); e[8] = __builtin_elementwise_minimum(a_, b_); }
    { const float a_ = e[11], b_ = e[10]; e[11] = __builtin_elementwise_maximum(a_, b_); e[10] = __builtin_elementwise_minimum(a_, b_); }
    { const float a_ = e[13], b_ = e[12]; e[13] = __builtin_elementwise_maximum(a_, b_); e[12] = __builtin_elementwise_minimum(a_, b_); }
    { const float a_ = e[15], b_ = e[14]; e[15] = __builtin_elementwise_maximum(a_, b_); e[14] = __builtin_elementwise_minimum(a_, b_); }
    { const float a_ = e[0], b_ = e[8]; e[0] = __builtin_elementwise_maximum(a_, b_); e[8] = __builtin_elementwise_minimum(a_, b_); }
    { const float a_ = e[1], b_ = e[9]; e[1] = __builtin_elementwise_maximum(a_, b_); e[9] = __builtin_elementwise_minimum(a_, b_); }
    { const float a_ = e[2], b_ = e[10]; e[2] = __builtin_elementwise_maximum(a_, b_); e[10] = __builtin_elementwise_minimum(a_, b_); }
    { const float a_ = e[3], b_ = e[11]; e[3] = __builtin_elementwise_maximum(a_, b_); e[11] = __builtin_elementwise_minimum(a_, b_); }
    { const float a_ = e[4], b_ = e[12]; e[4] = __builtin_elementwise_maximum(a_, b_); e[12] = __builtin_elementwise_minimum(a_, b_); }
    { const float a_ = e[5], b_ = e[13]; e[5] = __builtin_elementwise_maximum(a_, b_); e[13] = __builtin_elementwise_minimum(a_, b_); }
    { const float a_ = e[6], b_ = e[14]; e[6] = __builtin_elementwise_maximum(a_, b_); e[14] = __builtin_elementwise_minimum(a_, b_); }
    { const float a_ = e[7], b_ = e[15]; e[7] = __builtin_elementwise_maximum(a_, b_); e[15] = __builtin_elementwise_minimum(a_, b_); }
    { const float a_ = e[0], b_ = e[4]; e[0] = __builtin_elementwise_maximum(a_, b_); e[4] = __builtin_elementwise_minimum(a_, b_); }
    { const float a_ = e[1], b_ = e[5]; e[1] = __builtin_elementwise_maximum(a_, b_); e[5] = __builtin_elementwise_minimum(a_, b_); }
    { const float a_ = e[2], b_ = e[6]; e[2] = __builtin_elementwise_maximum(a_, b_); e[6] = __builtin_elementwise_minimum(a_, b_); }
    { const float a_ = e[3], b_ = e[7]; e[3] = __builtin_elementwise_maximum(a_, b_); e[7] = __builtin_elementwise_minimum(a_, b_); }
    { const float a_ = e[8], b_ = e[12]; e[8] = __builtin_elementwise_maximum(a_, b_); e[12] = __builtin_elementwise_minimum(a_, b_); }
    { const float a_ = e[9], b_ = e[13]; e[9] = __builtin_elementwise_maximum(a_, b_); e[13] = __builtin_elementwise_minimum(a_, b_); }
    { const float a_ = e[10], b_ = e[14]; e[10] = __builtin_elementwise_maximum(a_, b_); e[14] = __builtin_elementwise_minimum(a_, b_); }
    { const float a_ = e[11], b_ = e[15]; e[11] = __builtin_elementwise_maximum(a_, b_); e[15] = __builtin_elementwise_minimum(a_, b_); }
    { const float a_ = e[0], b_ = e[2]; e[0] = __builtin_elementwise_maximum(a_, b_); e[2] = __builtin_elementwise_minimum(a_, b_); }
    { const float a_ = e[1], b_ = e[3]; e[1] = __builtin_elementwise_maximum(a_, b_); e[3] = __builtin_elementwise_minimum(a_, b_); }
    { const float a_ = e[4], b_ = e[6]; e[4] = __builtin_elementwise_maximum(a_, b_); e[6] = __builtin_elementwise_minimum(a_, b_); }
    { const float a_ = e[5], b_ = e[7]; e[5] = __builtin_elementwise_maximum(a_, b_); e[7] = __builtin_elementwise_minimum(a_, b_); }
    { const float a_ = e[8], b_ = e[10]; e[8] = __builtin_elementwise_maximum(a_, b_); e[10] = __builtin_elementwise_minimum(a_, b_); }
    { const float a_ = e[9], b_ = e[11]; e[9] = __builtin_elementwise_maximum(a_, b_); e[11] = __builtin_elementwise_minimum(a_, b_); }
    { const float a_ = e[12], b_ = e[14]; e[12] = __builtin_elementwise_maximum(a_, b_); e[14] = __builtin_elementwise_minimum(a_, b_); }
    { const float a_ = e[13], b_ = e[15]; e[13] = __builtin_elementwise_maximum(a_, b_); e[15] = __builtin_elementwise_minimum(a_, b_); }
    { const float a_ = e[0], b_ = e[1]; e[0] = __builtin_elementwise_maximum(a_, b_); e[1] = __builtin_elementwise_minimum(a_, b_); }
    { const float a_ = e[2], b_ = e[3]; e[2] = __builtin_elementwise_maximum(a_, b_); e[3] = __builtin_elementwise_minimum(a_, b_); }
    { const float a_ = e[4], b_ = e[5]; e[4] = __builtin_elementwise_maximum(a_, b_); e[5] = __builtin_elementwise_minimum(a_, b_); }
    { const float a_ = e[6], b_ = e[7]; e[6] = __builtin_elementwise_maximum(a_, b_); e[7] = __builtin_elementwise_minimum(a_, b_); }
    { const float a_ = e[8], b_ = e[9]; e[8] = __builtin_elementwise_maximum(a_, b_); e[9] = __builtin_elementwise_minimum(a_, b_); }
    { const float a_ = e[10], b_ = e[11]; e[10] = __builtin_elementwise_maximum(a_, b_); e[11] = __builtin_elementwise_minimum(a_, b_); }
    { const float a_ = e[12], b_ = e[13]; e[12] = __builtin_elementwise_maximum(a_, b_); e[13] = __builtin_elementwise_minimum(a_, b_); }
    { const float a_ = e[14], b_ = e[15]; e[14] = __builtin_elementwise_maximum(a_, b_); e[15] = __builtin_elementwise_minimum(a_, b_); }
    { const float a_ = e[16], b_ = e[17]; e[16] = __builtin_elementwise_maximum(a_, b_); e[17] = __builtin_elementwise_minimum(a_, b_); }
    { const float a_ = e[19], b_ = e[18]; e[19] = __builtin_elementwise_maximum(a_, b_); e[18] = __builtin_elementwise_minimum(a_, b_); }
    { const float a_ = e[20], b_ = e[21]; e[20] = __builtin_elementwise_maximum(a_, b_); e[21] = __builtin_elementwise_minimum(a_, b_); }
    { const float a_ = e[23], b_ = e[22]; e[23] = __builtin_elementwise_maximum(a_, b_); e[22] = __builtin_elementwise_minimum(a_, b_); }
    { const float a_ = e[24], b_ = e[25]; e[24] = __builtin_elementwise_maximum(a_, b_); e[25] = __builtin_elementwise_minimum(a_, b_); }
    { const float a_ = e[27], b_ = e[26]; e[27] = __builtin_elementwise_maximum(a_, b_); e[26] = __builtin_elementwise_minimum(a_, b_); }
    { const float a_ = e[28], b_ = e[29]; e[28] = __builtin_elementwise_maximum(a_, b_); e[29] = __builtin_elementwise_minimum(a_, b_); }
    { const float a_ = e[31], b_ = e[30]; e[31] = __builtin_elementwise_maximum(a_, b_); e[30] = __builtin_elementwise_minimum(a_, b_); }
    { const float a_ = e[16], b_ = e[18]; e[16] = __builtin_elementwise_maximum(a_, b_); e[18] = __builtin_elementwise_minimum(a_, b_); }
    { const float a_ = e[17], b_ = e[19]; e[17] = __builtin_elementwise_maximum(a_, b_); e[19] = __builtin_elementwise_minimum(a_, b_); }
    { const float a_ = e[22], b_ = e[20]; e[22] = __builtin_elementwise_maximum(a_, b_); e[20] = __builtin_elementwise_minimum(a_, b_); }
    { const float a_ = e[23], b_ = e[21]; e[23] = __builtin_elementwise_maximum(a_, b_); e[21] = __builtin_elementwise_minimum(a_, b_); }
    { const float a_ = e[24], b_ = e[26]; e[24] = __builtin_elementwise_maximum(a_, b_); e[26] = __builtin_elementwise_minimum(a_, b_); }
    { const float a_ = e[25], b_ = e[27]; e[25] = __builtin_elementwise_maximum(a_, b_); e[27] = __builtin_elementwise_minimum(a_, b_); }
    { const float a_ = e[30], b_ = e[28]; e[30] = __builtin_elementwise_maximum(a_, b_); e[28] = __builtin_elementwise_minimum(a_, b_); }
    { const float a_ = e[31], b_ = e[29]; e[31] = __builtin_elementwise_maximum(a_, b_); e[29] = __builtin_elementwise_minimum(a_, b_); }
    { const float a_ = e[16], b_ = e[17]; e[16] = __builtin_elementwise_maximum(a_, b_); e[17] = __builtin_elementwise_minimum(a_, b_); }
    { const float a_ = e[18], b_ = e[19]; e[18] = __builtin_elementwise_maximum(a_, b_); e[19] = __builtin_elementwise_minimum(a_, b_); }
    { const float a_ = e[21], b_ = e[20]; e[21] = __builtin_elementwise_maximum(a_, b_); e[20] = __builtin_elementwise_minimum(a_, b_); }
    { const float a_ = e[23], b_ = e[22]; e[23] = __builtin_elementwise_maximum(a_, b_); e[22] = __builtin_elementwise_minimum(a_, b_); }
    { const float a_ = e[24], b_ = e[25]; e[24] = __builtin_elementwise_maximum(a_, b_); e[25] = __builtin_elementwise_minimum(a_, b_); }
    { const float a_ = e[26], b_ = e[27]; e[26] = __builtin_elementwise_maximum(a_, b_); e[27] = __builtin_elementwise_minimum(a_, b_); }
    { const float a_ = e[29], b_ = e[28]; e[29] = __builtin_elementwise_maximum(a_, b_); e[28] = __builtin_elementwise_minimum(a_, b_); }
    { const float a_ = e[31], b_ = e[30]; e[31] = __builtin_elementwise_maximum(a_, b_); e[30] = __builtin_elementwise_minimum(a_, b_); }
    { const float a_ = e[16], b_ = e[20]; e[16] = __builtin_elementwise_maximum(a_, b_); e[20] = __builtin_elementwise_minimum(a_, b_); }
    { const float a_ = e[17], b_ = e[21]; e[17] = __builtin_elementwise_maximum(a_, b_); e[21] = __builtin_elementwise_minimum(a_, b_); }
    { const float a_ = e[18], b_ = e[22]; e[18] = __builtin_elementwise_maximum(a_, b_); e[22] = __builtin_elementwise_minimum(a_, b_); }
    { const float a_ = e[19], b_ = e[23]; e[19] = __builtin_elementwise_maximum(a_, b_); e[23] = __builtin_elementwise_minimum(a_, b_); }
    { const float a_ = e[28], b_ = e[24]; e[28] = __builtin_elementwise_maximum(a_, b_); e[24] = __builtin_elementwise_minimum(a_, b_); }
    { const float a_ = e[29], b_ = e[25]; e[29] = __builtin_elementwise_maximum(a_, b_); e[25] = __builtin_elementwise_minimum(a_, b_); }
    { const float a_ = e[30], b_ = e[26]; e[30] = __builtin_elementwise_maximum(a_, b_); e[26] = __builtin_elementwise_minimum(a_, b_); }
    { const float a_ = e[31], b_ = e[27]; e[31] = __builtin_elementwise_maximum(a_, b_); e[27] = __builtin_elementwise_minimum(a_, b_); }
    { const float a_ = e[16], b_ = e[18]; e[16] = __builtin_elementwise_maximum(a_, b_); e[18] = __builtin_elementwise_minimum(a_, b_); }
    { const float a_ = e[17], b_ = e[19]; e[17] = __builtin_elementwise_maximum(a_, b_); e[19] = __builtin_elementwise_minimum(a_, b_); }
    { const float a_ = e[20], b_ = e[22]; e[20] = __builtin_elementwise_maximum(a_, b_); e[22] = __builtin_elementwise_minimum(a_, b_); }
    { const float a_ = e[21], b_ = e[23]; e[21] = __builtin_elementwise_maximum(a_, b_); e[23] = __builtin_elementwise_minimum(a_, b_); }
    { const float a_ = e[26], b_ = e[24]; e[26] = __builtin_elementwise_maximum(a_, b_); e[24] = __builtin_elementwise_minimum(a_, b_); }
    { const float a_ = e[27], b_ = e[25]; e[27] = __builtin_elementwise_maximum(a_, b_); e[25] = __builtin_elementwise_minimum(a_, b_); }
    { const float a_ = e[30], b_ = e[28]; e[30] = __builtin_elementwise_maximum(a_, b_); e[28] = __builtin_elementwise_minimum(a_, b_); }
    { const float a_ = e[31], b_ = e[29]; e[31] = __builtin_elementwise_maximum(a_, b_); e[29] = __builtin_elementwise_minimum(a_, b_); }
    { const float a_ = e[16], b_ = e[17]; e[16] = __builtin_elementwise_maximum(a_, b_); e[17] = __builtin_elementwise_minimum(a_, b_); }
    { const float a_ = e[18], b_ = e[19]; e[18] = __builtin_elementwise_maximum(a_, b_); e[19] = __builtin_elementwise_minimum(a_, b_); }
    { const float a_ = e[20], b_ = e[21]; e[20] = __builtin_elementwise_maximum(a_, b_); e[21] = __builtin_elementwise_minimum(a_, b_); }
    { const float a_ = e[22], b_ = e[23]; e[22] = __builtin_elementwise_maximum(a_, b_); e[23] = __builtin_elementwise_minimum(a_, b_); }
    { const float a_ = e[25], b_ = e[24]; e[25] = __builtin_elementwise_maximum(a_, b_); e[24] = __builtin_elementwise_minimum(a_, b_); }
    { const float a_ = e[27], b_ = e[26]; e[27] = __builtin_elementwise_maximum(a_, b_); e[26] = __builtin_elementwise_minimum(a_, b_); }
    { const float a_ = e[29], b_ = e[28]; e[29] = __builtin_elementwise_maximum(a_, b_); e[28] = __builtin_elementwise_minimum(a_, b_); }
    { const float a_ = e[31], b_ = e[30]; e[31] = __builtin_elementwise_maximum(a_, b_); e[30] = __builtin_elementwise_minimum(a_, b_); }
    { const float a_ = e[16], b_ = e[24]; e[16] = __builtin_elementwise_maximum(a_, b_); e[24] = __builtin_elementwise_minimum(a_, b_); }
    { const float a_ = e[17], b_ = e[25]; e[17] = __builtin_elementwise_maximum(a_, b_); e[25] = __builtin_elementwise_minimum(a_, b_); }
    { const float a_ = e[18], b_ = e[26]; e[18] = __builtin_elementwise_maximum(a_, b_); e[26] = __builtin_elementwise_minimum(a_, b_); }
    { const float a_ = e[19], b_ = e[27]; e[19] = __builtin_elementwise_maximum(a_, b_); e[27] = __builtin_elementwise_minimum(a_, b_); }
    { const float a_ = e[20], b_ = e[28]; e[20] = __builtin_elementwise_maximum(a_, b_); e[28] = __builtin_elementwise_minimum(a_, b_); }
    { const float a_ = e[21], b_ = e[29]; e[21] = __builtin_elementwise_maximum(a_, b_); e[29] = __builtin_elementwise_minimum(a_, b_); }
    { const float a_ = e[22], b_ = e[30]; e[22] = __builtin_elementwise_maximum(a_, b_); e[30] = __builtin_elementwise_minimum(a_, b_); }
    { const float a_ = e[23], b_ = e[31]; e[23] = __builtin_elementwise_maximum(a_, b_); e[31] = __builtin_elementwise_minimum(a_, b_); }
    { const float a_ = e[16], b_ = e[20]; e[16] = __builtin_elementwise_maximum(a_, b_); e[20] = __builtin_elementwise_minimum(a_, b_); }
    { const float a_ = e[17], b_ = e[21]; e[17] = __builtin_elementwise_maximum(a_, b_); e[21] = __builtin_elementwise_minimum(a_, b_); }
    { const float a_ = e[18], b_ = e[22]; e[18] = __builtin_elementwise_maximum(a_, b_); e[22] = __builtin_elementwise_minimum(a_, b_); }
    { const float a_ = e[19], b_ = e[23]; e[19] = __builtin_elementwise_maximum(a_, b_); e[23] = __builtin_elementwise_minimum(a_, b_); }
    { const float a_ = e[24], b_ = e[28]; e[24] = __builtin_elementwise_maximum(a_, b_); e[28] = __builtin_elementwise_minimum(a_, b_); }
    { const float a_ = e[25], b_ = e[29]; e[25] = __builtin_elementwise_maximum(a_, b_); e[29] = __builtin_elementwise_minimum(a_, b_); }
    { const float a_ = e[26], b_ = e[30]; e[26] = __builtin_elementwise_maximum(a_, b_); e[30] = __builtin_elementwise_minimum(a_, b_); }
    { const float a_ = e[27], b_ = e[31]; e[27] = __builtin_elementwise_maximum(a_, b_); e[31] = __builtin_elementwise_minimum(a_, b_); }
    { const float a_ = e[16], b_ = e[18]; e[16] = __builtin_elementwise_maximum(a_, b_); e[18] = __builtin_elementwise_minimum(a_, b_); }
    { const float a_ = e[17], b_ = e[19]; e[17] = __builtin_elementwise_maximum(a_, b_); e[19] = __builtin_elementwise_minimum(a_, b_); }
    { const float a_ = e[20], b_ = e[22]; e[20] = __builtin_elementwise_maximum(a_, b_); e[22] = __builtin_elementwise_minimum(a_, b_); }
    { const float a_ = e[21], b_ = e[23]; e[21] = __builtin_elementwise_maximum(a_, b_); e[23] = __builtin_elementwise_minimum(a_, b_); }
    { const float a_ = e[24], b_ = e[26]; e[24] = __builtin_elementwise_maximum(a_, b_); e[26] = __builtin_elementwise_minimum(a_, b_); }
    { const float a_ = e[25], b_ = e[27]; e[25] = __builtin_elementwise_maximum(a_, b_); e[27] = __builtin_elementwise_minimum(a_, b_); }
    { const float a_ = e[28], b_ = e[30]; e[28] = __builtin_elementwise_maximum(a_, b_); e[30] = __builtin_elementwise_minimum(a_, b_); }
    { const float a_ = e[29], b_ = e[31]; e[29] = __builtin_elementwise_maximum(a_, b_); e[31] = __builtin_elementwise_minimum(a_, b_); }
    { const float a_ = e[16], b_ = e[17]; e[16] = __builtin_elementwise_maximum(a_, b_); e[17] = __builtin_elementwise_minimum(a_, b_); }
    { const float a_ = e[18], b_ = e[19]; e[18] = __builtin_elementwise_maximum(a_, b_); e[19] = __builtin_elementwise_minimum(a_, b_); }
    { const float a_ = e[20], b_ = e[21]; e[20] = __builtin_elementwise_maximum(a_, b_); e[21] = __builtin_elementwise_minimum(a_, b_); }
    { const float a_ = e[22], b_ = e[23]; e[22] = __builtin_elementwise_maximum(a_, b_); e[23] = __builtin_elementwise_minimum(a_, b_); }
    { const float a_ = e[24], b_ = e[25]; e[24] = __builtin_elementwise_maximum(a_, b_); e[25] = __builtin_elementwise_minimum(a_, b_); }
    { const float a_ = e[26], b_ = e[27]; e[26] = __builtin_elementwise_maximum(a_, b_); e[27] = __builtin_elementwise_minimum(a_, b_); }
    { const float a_ = e[28], b_ = e[29]; e[28] = __builtin_elementwise_maximum(a_, b_); e[29] = __builtin_elementwise_minimum(a_, b_); }
    { const float a_ = e[30], b_ = e[31]; e[30] = __builtin_elementwise_maximum(a_, b_); e[31] = __builtin_elementwise_minimum(a_, b_); }
    { const float a_ = e[32], b_ = e[33]; e[32] = __builtin_elementwise_maximum(a_, b_); e[33] = __builtin_elementwise_minimum(a_, b_); }
    { const float a_ = e[35], b_ = e[34]; e[35] = __builtin_elementwise_maximum(a_, b_); e[34] = __builtin_elementwise_minimum(a_, b_); }
    { const float a_ = e[36], b_ = e[37]; e[36] = __builtin_elementwise_maximum(a_, b_); e[37] = __builtin_elementwise_minimum(a_, b_); }
    { const float a_ = e[39], b_ = e[38]; e[39] = __builtin_elementwise_maximum(a_, b_); e[38] = __builtin_elementwise_minimum(a_, b_); }
    { const float a_ = e[40], b_ = e[41]; e[40] = __builtin_elementwise_maximum(a_, b_); e[41] = __builtin_elementwise_minimum(a_, b_); }
    { const float a_ = e[43], b_ = e[42]; e[43] = __builtin_elementwise_maximum(a_, b_); e[42] = __builtin_elementwise_minimum(a_, b_); }
    { const float a_ = e[44], b_ = e[45]; e[44] = __builtin_elementwise_maximum(a_, b_); e[45] = __builtin_elementwise_minimum(a_, b_); }
    { const float a_ = e[47], b_ = e[46]; e[47] = __builtin_elementwise_maximum(a_, b_); e[46] = __builtin_elementwise_minimum(a_, b_); }
    { const float a_ = e[32], b_ = e[34]; e[32] = __builtin_elementwise_maximum(a_, b_); e[34] = __builtin_elementwise_minimum(a_, b_); }
    { const float a_ = e[33], b_ = e[35]; e[33] = __builtin_elementwise_maximum(a_, b_); e[35] = __builtin_elementwise_minimum(a_, b_); }
    { const float a_ = e[38], b_ = e[36]; e[38] = __builtin_elementwise_maximum(a_, b_); e[36] = __builtin_elementwise_minimum(a_, b_); }
    { const float a_ = e[39], b_ = e[37]; e[39] = __builtin_elementwise_maximum(a_, b_); e[37] = __builtin_elementwise_minimum(a_, b_); }
    { const float a_ = e[40], b_ = e[42]; e[40] = __builtin_elementwise_maximum(a_, b_); e[42] = __builtin_elementwise_minimum(a_, b_); }
    { const float a_ = e[41], b_ = e[43]; e[41] = __builtin_elementwise_maximum(a_, b_); e[43] = __builtin_elementwise_minimum(a_, b_); }
    { const float a_ = e[46], b_ = e[44]; e[46] = __builtin_elementwise_maximum(a_, b_); e[44] = __builtin_elementwise_minimum(a_, b_); }
    { const float a_ = e[47], b_ = e[45]; e[47] = __builtin_elementwise_maximum(a_, b_); e[45] = __builtin_elementwise_minimum(a_, b_); }
    { const float a_ = e[32], b_ = e[33]; e[32] = __builtin_elementwise_maximum(a_, b_); e[33] = __builtin_elementwise_minimum(a_, b_); }
    { const float a_ = e[34], b_ = e[35]; e[34] = __builtin_elementwise_maximum(a_, b_); e[35] = __builtin_elementwise_minimum(a_, b_); }
    { const float a_ = e[37], b_ = e[36]; e[37] = __builtin_elementwise_maximum(a_, b_); e[36] = __builtin_elementwise_minimum(a_, b_); }
    { const float a_ = e[39], b_ = e[38]; e[39] = __builtin_elementwise_maximum(a_, b_); e[38] = __builtin_elementwise_minimum(a_, b_); }
    { const float a_ = e[40], b_ = e[41]; e[40] = __builtin_elementwise_maximum(a_, b_); e[41] = __builtin_elementwise_minimum(a_, b_); }
    { const float a_ = e[42], b_ = e[43]; e[42] = __builtin_elementwise_maximum(a_, b_); e[43] = __builtin_elementwise_minimum(a_, b_); }
    { const float a_ = e[45], b_ = e[44]; e[45] = __builtin_elementwise_maximum(a_, b_); e[44] = __builtin_elementwise_minimum(a_, b_); }
    { const float a_ = e[47], b_ = e[46]; e[47] = __builtin_elementwise_maximum(a_, b_); e[46] = __builtin_elementwise_minimum(a_, b_); }
    { const float a_ = e[32], b_ = e[36]; e[32] = __builtin_elementwise_maximum(a_, b_); e[36] = __builtin_elementwise_minimum(a_, b_); }
    { const float a_ = e[33], b_ = e[37]; e[33] = __builtin_elementwise_maximum(a_, b_); e[37] = __builtin_elementwise_minimum(a_, b_); }
    { const float a_ = e[34], b_ = e[38]; e[34] = __builtin_elementwise_maximum(a_, b_); e[38] = __builtin_elementwise_minimum(a_, b_); }
    { const float a_ = e[35], b_ = e[39]; e[35] = __builtin_elementwise_maximum(a_, b_); e[39] = __builtin_elementwise_minimum(a_, b_); }
    { const float a_ = e[44], b_ = e[40]; e[44] = __builtin_elementwise_maximum(a_, b_); e[40] = __builtin_elementwise_minimum(a_, b_); }
    { const float a_ = e[45], b_ = e[41]; e[45] = __builtin_elementwise_maximum(a_, b_); e[41] = __builtin_elementwise_minimum(a_, b_); }
    { const float a_ = e[46], b_ = e[42]; e[46] = __builtin_elementwise_maximum(a_, b_); e[42] = __builtin_elementwise_minimum(a_, b_); }
    { const float a_ = e[47], b_ = e[43]; e[47] = __builtin_elementwise_maximum(a_, b_); e[43] = __builtin_elementwise_minimum(a_, b_); }
    { const float a_ = e[32], b_ = e[34]; e[32] = __builtin_elementwise_maximum(a_, b_); e[34] = __builtin_elementwise_minimum(a_, b_); }
    { const float a_ = e[33], b_ = e[35]; e[33] = __builtin_elementwise_maximum(a_, b_); e[35] = __builtin_elementwise_minimum(a_, b_); }
    { const float a_ = e[36], b_ = e[38]; e[36] = __builtin_elementwise_maximum(a_, b_); e[38] = __builtin_elementwise_minimum(a_, b_); }
    { const float a_ = e[37], b_ = e[39]; e[37] = __builtin_elementwise_maximum(a_, b_); e[39] = __builtin_elementwise_minimum(a_, b_); }
    { const float a_ = e[42], b_ = e[40]; e[42] = __builtin_elementwise_maximum(a_, b_); e[40] = __builtin_elementwise_minimum(a_, b_); }
    { const float a_ = e[43], b_ = e[41]; e[43] = __builtin_elementwise_maximum(a_, b_); e[41] = __builtin_elementwise_minimum(a_, b_); }
    { const float a_ = e[46], b_ = e[44]; e[46] = __builtin_elementwise_maximum(a_, b_); e[44] = __builtin_elementwise_minimum(a_, b_); }
    { const float a_ = e[47], b_ = e[45]; e[47] = __builtin_elementwise_maximum(a_, b_); e[45] = __builtin_elementwise_minimum(a_, b_); }
    { const float a_ = e[32], b_ = e[33]; e[32] = __builtin_elementwise_maximum(a_, b_); e[33] = __builtin_elementwise_minimum(a_, b_); }
    { const float a_ = e[34], b_ = e[35]; e[34] = __builtin_elementwise_maximum(a_, b_); e[35] = __builtin_elementwise_minimum(a_, b_); }
    { const float a_ = e[36], b_ = e[37]; e[36] = __builtin_elementwise_maximum(a_, b_); e[37] = __builtin_elementwise_minimum(a_, b_); }
    { const float a_ = e[38], b_ = e[39]; e[38] = __builtin_elementwise_maximum(a_, b_); e[39] = __builtin_elementwise_minimum(a_, b_); }
    { const float a_ = e[41], b_ = e[40]; e[41] = __builtin_elementwise_maximum(a_, b_); e[40] = __builtin_elementwise_minimum(a_, b_); }
    { const float a_ = e[43], b_ = e[42]; e[43] = __builtin_elementwise_maximum(a_, b_); e[42] = __builtin_elementwise_minimum(a_, b_); }
    { const float a_ = e[45], b_ = e[44]; e[45] = __builtin_elementwise_maximum(a_, b_); e[44] = __builtin_elementwise_minimum(a_, b_); }
    { const float a_ = e[47], b_ = e[46]; e[47] = __builtin_elementwise_maximum(a_, b_); e[46] = __builtin_elementwise_minimum(a_, b_); }
    { const float a_ = e[32], b_ = e[40]; e[32] = __builtin_elementwise_maximum(a_, b_); e[40] = __builtin_elementwise_minimum(a_, b_); }
    { const float a_ = e[33], b_ = e[41]; e[33] = __builtin_elementwise_maximum(a_, b_); e[41] = __builtin_elementwise_minimum(a_, b_); }
    { const float a_ = e[34], b_ = e[42]; e[34] = __builtin_elementwise_maximum(a_, b_); e[42] = __builtin_elementwise_minimum(a_, b_); }
    { const float a_ = e[35], b_ = e[43]; e[35] = __builtin_elementwise_maximum(a_, b_); e[43] = __builtin_elementwise_minimum(a_, b_); }
    { const float a_ = e[36], b_ = e[44]; e[36] = __builtin_elementwise_maximum(a_, b_); e[44] = __builtin_elementwise_minimum(a_, b_); }
    { const float a_ = e[37], b_ = e[45]; e[37] = __builtin_elementwise_maximum(a_, b_); e[45] = __builtin_elementwise_minimum(a_, b_); }
    { const float a_ = e[38], b_ = e[46]; e[38] = __builtin_elementwise_maximum(a_, b_); e[46] = __builtin_elementwise_minimum(a_, b_); }
    { const float a_ = e[39], b_ = e[47]; e[39] = __builtin_elementwise_maximum(a_, b_); e[47] = __builtin_elementwise_minimum(a_, b_); }
    { const float a_ = e[32], b_ = e[36]; e[32] = __builtin_elementwise_maximum(a_, b_); e[36] = __builtin_elementwise_minimum(a_, b_); }
    { const float a_ = e[33], b_ = e[37]; e[33] = __builtin_elementwise_maximum(a_, b_); e[37] = __builtin_elementwise_minimum(a_, b_); }
    { const float a_ = e[34], b_ = e[38]; e[34] = __builtin_elementwise_maximum(a_, b_); e[38] = __builtin_elementwise_minimum(a_, b_); }
    { const float a_ = e[35], b_ = e[39]; e[35] = __builtin_elementwise_maximum(a_, b_); e[39] = __builtin_elementwise_minimum(a_, b_); }
    { const float a_ = e[40], b_ = e[44]; e[40] = __builtin_elementwise_maximum(a_, b_); e[44] = __builtin_elementwise_minimum(a_, b_); }
    { const float a_ = e[41], b_ = e[45]; e[41] = __builtin_elementwise_maximum(a_, b_); e[45] = __builtin_elementwise_minimum(a_, b_); }
    { const float a_ = e[42], b_ = e[46]; e[42] = __builtin_elementwise_maximum(a_, b_); e[46] = __builtin_elementwise_minimum(a_, b_); }
    { const float a_ = e[43], b_ = e[47]; e[43] = __builtin_elementwise_maximum(a_, b_); e[47] = __builtin_elementwise_minimum(a_, b_); }
    { const float a_ = e[32], b_ = e[34]; e[32] = __builtin_elementwise_maximum(a_, b_); e[34] = __builtin_elementwise_minimum(a_, b_); }
    { const float a_ = e[33], b_ = e[35]; e[33] = __builtin_elementwise_maximum(a_, b_); e[35] = __builtin_elementwise_minimum(a_, b_); }
    { const float a_ = e[36], b_ = e[38]; e[36] = __builtin_elementwise_maximum(a_, b_); e[38] = __builtin_elementwise_minimum(a_, b_); }
    { const float a_ = e[37], b_ = e[39]; e[37] = __builtin_elementwise_maximum(a_, b_); e[39] = __builtin_elementwise_minimum(a_, b_); }
    { const float a_ = e[40], b_ = e[42]; e[40] = __builtin_elementwise_maximum(a_, b_); e[42] = __builtin_elementwise_minimum(a_, b_); }
    { const float a_ = e[41], b_ = e[43]; e[41] = __builtin_elementwise_maximum(a_, b_); e[43] = __builtin_elementwise_minimum(a_, b_); }
    { const float a_ = e[44], b_ = e[46]; e[44] = __builtin_elementwise_maximum(a_, b_); e[46] = __builtin_elementwise_minimum(a_, b_); }
    { const float a_ = e[45], b_ = e[47]; e[45] = __builtin_elementwise_maximum(a_, b_); e[47] = __builtin_elementwise_minimum(a_, b_); }
    { const float a_ = e[32], b_ = e[33]; e[32] = __builtin_elementwise_maximum(a_, b_); e[33] = __builtin_elementwise_minimum(a_, b_); }
    { const float a_ = e[34], b_ = e[35]; e[34] = __builtin_elementwise_maximum(a_, b_); e[35] = __builtin_elementwise_minimum(a_, b_); }
    { const float a_ = e[36], b_ = e[37]; e[36] = __builtin_elementwise_maximum(a_, b_); e[37] = __builtin_elementwise_minimum(a_, b_); }
    { const float a_ = e[38], b_ = e[39]; e[38] = __builtin_elementwise_maximum(a_, b_); e[39] = __builtin_elementwise_minimum(a_, b_); }
    { const float a_ = e[40], b_ = e[41]; e[40] = __builtin_elementwise_maximum(a_, b_); e[41] = __builtin_elementwise_minimum(a_, b_); }
    { const float a_ = e[42], b_ = e[43]; e[42] = __builtin_elementwise_maximum(a_, b_); e[43] = __builtin_elementwise_minimum(a_, b_); }
    { const float a_ = e[44], b_ = e[45]; e[44] = __builtin_elementwise_maximum(a_, b_); e[45] = __builtin_elementwise_minimum(a_, b_); }
    { const float a_ = e[46], b_ = e[47]; e[46] = __builtin_elementwise_maximum(a_, b_); e[47] = __builtin_elementwise_minimum(a_, b_); }
    { const float a_ = e[48], b_ = e[49]; e[48] = __builtin_elementwise_maximum(a_, b_); e[49] = __builtin_elementwise_minimum(a_, b_); }
    { const float a_ = e[51], b_ = e[50]; e[51] = __builtin_elementwise_maximum(a_, b_); e[50] = __builtin_elementwise_minimum(a_, b_); }
    { const float a_ = e[52], b_ = e[53]; e[52] = __builtin_elementwise_maximum(a_, b_); e[53] = __builtin_elementwise_minimum(a_, b_); }
    { const float a_ = e[55], b_ = e[54]; e[55] = __builtin_elementwise_maximum(a_, b_); e[54] = __builtin_elementwise_minimum(a_, b_); }
    { const float a_ = e[56], b_ = e[57]; e[56] = __builtin_elementwise_maximum(a_, b_); e[57] = __builtin_elementwise_minimum(a_, b_); }
    { const float a_ = e[59], b_ = e[58]; e[59] = __builtin_elementwise_maximum(a_, b_); e[58] = __builtin_elementwise_minimum(a_, b_); }
    { const float a_ = e[60], b_ = e[61]; e[60] = __builtin_elementwise_maximum(a_, b_); e[61] = __builtin_elementwise_minimum(a_, b_); }
    { const float a_ = e[63], b_ = e[62]; e[63] = __builtin_elementwise_maximum(a_, b_); e[62] = __builtin_elementwise_minimum(a_, b_); }
    { const float a_ = e[48], b_ = e[50]; e[48] = __builtin_elementwise_maximum(a_, b_); e[50] = __builtin_elementwise_minimum(a_, b_); }
    { const float a_ = e[49], b_ = e[51]; e[49] = __builtin_elementwise_maximum(a_, b_); e[51] = __builtin_elementwise_minimum(a_, b_); }
    { const float a_ = e[54], b_ = e[52]; e[54] = __builtin_elementwise_maximum(a_, b_); e[52] = __builtin_elementwise_minimum(a_, b_); }
    { const float a_ = e[55], b_ = e[53]; e[55] = __builtin_elementwise_maximum(a_, b_); e[53] = __builtin_elementwise_minimum(a_, b_); }
    { const float a_ = e[56], b_ = e[58]; e[56] = __builtin_elementwise_maximum(a_, b_); e[58] = __builtin_elementwise_minimum(a_, b_); }
    { const float a_ = e[57], b_ = e[59]; e[57] = __builtin_elementwise_maximum(a_, b_); e[59] = __builtin_elementwise_minimum(a_, b_); }
    { const float a_ = e[62], b_ = e[60]; e[62] = __builtin_elementwise_maximum(a_, b_); e[60] = __builtin_elementwise_minimum(a_, b_); }
    { const float a_ = e[63], b_ = e[61]; e[63] = __builtin_elementwise_maximum(a_, b_); e[61] = __builtin_elementwise_minimum(a_, b_); }
    { const float a_ = e[48], b_ = e[49]; e[48] = __builtin_elementwise_maximum(a_, b_); e[49] = __builtin_elementwise_minimum(a_, b_); }
    { const float a_ = e[50], b_ = e[51]; e[50] = __builtin_elementwise_maximum(a_, b_); e[51] = __builtin_elementwise_minimum(a_, b_); }
    { const float a_ = e[53], b_ = e[52]; e[53] = __builtin_elementwise_maximum(a_, b_); e[52] = __builtin_elementwise_minimum(a_, b_); }
    { const float a_ = e[55], b_ = e[54]; e[55] = __builtin_elementwise_maximum(a_, b_); e[54] = __builtin_elementwise_minimum(a_, b_); }
    { const float a_ = e[56], b_ = e[57]; e[56] = __builtin_elementwise_maximum(a_, b_); e[57] = __builtin_elementwise_minimum(a_, b_); }
    { const float a_ = e[58], b_ = e[59]; e[58] = __builtin_elementwise_maximum(a_, b_); e[59] = __builtin_elementwise_minimum(a_, b_); }
    { const float a_ = e[61], b_ = e[60]; e[61] = __builtin_elementwise_maximum(a_, b_); e[60] = __builtin_elementwise_minimum(a_, b_); }
    { const float a_ = e[63], b_ = e[62]; e[63] = __builtin_elementwise_maximum(a_, b_); e[62] = __builtin_elementwise_minimum(a_, b_); }
    { const float a_ = e[48], b_ = e[52]; e[48] = __builtin_elementwise_maximum(a_, b_); e[52] = __builtin_elementwise_minimum(a_, b_); }
    { const float a_ = e[49], b_ = e[53]; e[49] = __builtin_elementwise_maximum(a_, b_); e[53] = __builtin_elementwise_minimum(a_, b_); }
    { const float a_ = e[50], b_ = e[54]; e[50] = __builtin_elementwise_maximum(a_, b_); e[54] = __builtin_elementwise_minimum(a_, b_); }
    { const float a_ = e[51], b_ = e[55]; e[51] = __builtin_elementwise_maximum(a_, b_); e[55] = __builtin_elementwise_minimum(a_, b_); }
    { const float a_ = e[60], b_ = e[56]; e[60] = __builtin_elementwise_maximum(a_, b_); e[56] = __builtin_elementwise_minimum(a_, b_); }
    { const float a_ = e[61], b_ = e[57]; e[61] = __builtin_elementwise_maximum(a_, b_); e[57] = __builtin_elementwise_minimum(a_, b_); }
    { const float a_ = e[62], b_ = e[58]; e[62] = __builtin_elementwise_maximum(a_, b_); e[58] = __builtin_elementwise_minimum(a_, b_); }
    { const float a_ = e[63], b_ = e[59]; e[63] = __builtin_elementwise_maximum(a_, b_); e[59] = __builtin_elementwise_minimum(a_, b_); }
    { const float a_ = e[48], b_ = e[50]; e[48] = __builtin_elementwise_maximum(a_, b_); e[50] = __builtin_elementwise_minimum(a_, b_); }
    { const float a_ = e[49], b_ = e[51]; e[49] = __builtin_elementwise_maximum(a_, b_); e[51] = __builtin_elementwise_minimum(a_, b_); }
    { const float a_ = e[52], b_ = e[54]; e[52] = __builtin_elementwise_maximum(a_, b_); e[54] = __builtin_elementwise_minimum(a_, b_); }
    { const float a_ = e[53], b_ = e[55]; e[53] = __builtin_elementwise_maximum(a_, b_); e[55] = __builtin_elementwise_minimum(a_, b_); }
    { const float a_ = e[58], b_ = e[56]; e[58] = __builtin_elementwise_maximum(a_, b_); e[56] = __builtin_elementwise_minimum(a_, b_); }
    { const float a_ = e[59], b_ = e[57]; e[59] = __builtin_elementwise_maximum(a_, b_); e[57] = __builtin_elementwise_minimum(a_, b_); }
    { const float a_ = e[62], b_ = e[60]; e[62] = __builtin_elementwise_maximum(a_, b_); e[60] = __builtin_elementwise_minimum(a_, b_); }
    { const float a_ = e[63], b_ = e[61]; e[63] = __builtin_elementwise_maximum(a_, b_); e[61] = __builtin_elementwise_minimum(a_, b_); }
    { const float a_ = e[48], b_ = e[49]; e[48] = __builtin_elementwise_maximum(a_, b_); e[49] = __builtin_elementwise_minimum(a_, b_); }
    { const float a_ = e[50], b_ = e[51]; e[50] = __builtin_elementwise_maximum(a_, b_); e[51] = __builtin_elementwise_minimum(a_, b_); }
    { const float a_ = e[52], b_ = e[53]; e[52] = __builtin_elementwise_maximum(a_, b_); e[53] = __builtin_elementwise_minimum(a_, b_); }
    { const float a_ = e[54], b_ = e[55]; e[54] = __builtin_elementwise_maximum(a_, b_); e[55] = __builtin_elementwise_minimum(a_, b_); }
    { const float a_ = e[57], b_ = e[56]; e[57] = __builtin_elementwise_maximum(a_, b_); e[56] = __builtin_elementwise_minimum(a_, b_); }
    { const float a_ = e[59], b_ = e[58]; e[59] = __builtin_elementwise_maximum(a_, b_); e[58] = __builtin_elementwise_minimum(a_, b_); }
    { const float a_ = e[61], b_ = e[60]; e[61] = __builtin_elementwise_maximum(a_, b_); e[60] = __builtin_elementwise_minimum(a_, b_); }
    { const float a_ = e[63], b_ = e[62]; e[63] = __builtin_elementwise_maximum(a_, b_); e[62] = __builtin_elementwise_minimum(a_, b_); }
    { const float a_ = e[48], b_ = e[56]; e[48] = __builtin_elementwise_maximum(a_, b_); e[56] = __builtin_elementwise_minimum(a_, b_); }
    { const float a_ = e[49], b_ = e[57]; e[49] = __builtin_elementwise_maximum(a_, b_); e[57] = __builtin_elementwise_minimum(a_, b_); }
    { const float a_ = e[50], b_ = e[58]; e[50] = __builtin_elementwise_maximum(a_, b_); e[58] = __builtin_elementwise_minimum(a_, b_); }
    { const float a_ = e[51], b_ = e[59]; e[51] = __builtin_elementwise_maximum(a_, b_); e[59] = __builtin_elementwise_minimum(a_, b_); }
    { const float a_ = e[52], b_ = e[60]; e[52] = __builtin_elementwise_maximum(a_, b_); e[60] = __builtin_elementwise_minimum(a_, b_); }
    { const float a_ = e[53], b_ = e[61]; e[53] = __builtin_elementwise_maximum(a_, b_); e[61] = __builtin_elementwise_minimum(a_, b_); }
    { const float a_ = e[54], b_ = e[62]; e[54] = __builtin_elementwise_maximum(a_, b_); e[62] = __builtin_elementwise_minimum(a_, b_); }
    { const float a_ = e[55], b_ = e[63]; e[55] = __builtin_elementwise_maximum(a_, b_); e[63] = __builtin_elementwise_minimum(a_, b_); }
    { const float a_ = e[48], b_ = e[52]; e[48] = __builtin_elementwise_maximum(a_, b_); e[52] = __builtin_elementwise_minimum(a_, b_); }
    { const float a_ = e[49], b_ = e[53]; e[49] = __builtin_elementwise_maximum(a_, b_); e[53] = __builtin_elementwise_minimum(a_, b_); }
    { const float a_ = e[50], b_ = e[54]; e[50] = __builtin_elementwise_maximum(a_, b_); e[54] = __builtin_elementwise_minimum(a_, b_); }
    { const float a_ = e[51], b_ = e[55]; e[51] = __builtin_elementwise_maximum(a_, b_); e[55] = __builtin_elementwise_minimum(a_, b_); }
    { const float a_ = e[56], b_ = e[60]; e[56] = __builtin_elementwise_maximum(a_, b_); e[60] = __builtin_elementwise_minimum(a_, b_); }
    { const float a_ = e[57], b_ = e[61]; e[57] = __builtin_elementwise_maximum(a_, b_); e[61] = __builtin_elementwise_minimum(a_, b_); }
    { const float a_ = e[58], b_ = e[62]; e[58] = __builtin_elementwise_maximum(a_, b_); e[62] = __builtin_elementwise_minimum(a_, b_); }
    { const float a_ = e[59], b_ = e[63]; e[59] = __builtin_elementwise_maximum(a_, b_); e[63] = __builtin_elementwise_minimum(a_, b_); }
    { const float a_ = e[48], b_ = e[50]; e[48] = __builtin_elementwise_maximum(a_, b_); e[50] = __builtin_elementwise_minimum(a_, b_); }
    { const float a_ = e[49], b_ = e[51]; e[49] = __builtin_elementwise_maximum(a_, b_); e[51] = __builtin_elementwise_minimum(a_, b_); }
    { const float a_ = e[52], b_ = e[54]; e[52] = __builtin_elementwise_maximum(a_, b_); e[54] = __builtin_elementwise_minimum(a_, b_); }
    { const float a_ = e[53], b_ = e[55]; e[53] = __builtin_elementwise_maximum(a_, b_); e[55] = __builtin_elementwise_minimum(a_, b_); }
    { const float a_ = e[56], b_ = e[58]; e[56] = __builtin_elementwise_maximum(a_, b_); e[58] = __builtin_elementwise_minimum(a_, b_); }
    { const float a_ = e[57], b_ = e[59]; e[57] = __builtin_elementwise_maximum(a_, b_); e[59] = __builtin_elementwise_minimum(a_, b_); }
    { const float a_ = e[60], b_ = e[62]; e[60] = __builtin_elementwise_maximum(a_, b_); e[62] = __builtin_elementwise_minimum(a_, b_); }
    { const float a_ = e[61], b_ = e[63]; e[61] = __builtin_elementwise_maximum(a_, b_); e[63] = __builtin_elementwise_minimum(a_, b_); }
    { const float a_ = e[48], b_ = e[49]; e[48] = __builtin_elementwise_maximum(a_, b_); e[49] = __builtin_elementwise_minimum(a_, b_); }
    { const float a_ = e[50], b_ = e[51]; e[50] = __builtin_elementwise_maximum(a_, b_); e[51] = __builtin_elementwise_minimum(a_, b_); }
    { const float a_ = e[52], b_ = e[53]; e[52] = __builtin_elementwise_maximum(a_, b_); e[53] = __builtin_elementwise_minimum(a_, b_); }
    { const float a_ = e[54], b_ = e[55]; e[54] = __builtin_elementwise_maximum(a_, b_); e[55] = __builtin_elementwise_minimum(a_, b_); }
    { const float a_ = e[56], b_ = e[57]; e[56] = __builtin_elementwise_maximum(a_, b_); e[57] = __builtin_elementwise_minimum(a_, b_); }
    { const float a_ = e[58], b_ = e[59]; e[58] = __builtin_elementwise_maximum(a_, b_); e[59] = __builtin_elementwise_minimum(a_, b_); }
    { const float a_ = e[60], b_ = e[61]; e[60] = __builtin_elementwise_maximum(a_, b_); e[61] = __builtin_elementwise_minimum(a_, b_); }
    { const float a_ = e[62], b_ = e[63]; e[62] = __builtin_elementwise_maximum(a_, b_); e[63] = __builtin_elementwise_minimum(a_, b_); }
    float t0[16], t1[16];
    t0[0] = __builtin_elementwise_maximum(e[0], e[31]); t1[0] = __builtin_elementwise_maximum(e[32], e[63]);
    t0[1] = __builtin_elementwise_maximum(e[1], e[30]); t1[1] = __builtin_elementwise_maximum(e[33], e[62]);
    t0[2] = __builtin_elementwise_maximum(e[2], e[29]); t1[2] = __builtin_elementwise_maximum(e[34], e[61]);
    t0[3] = __builtin_elementwise_maximum(e[3], e[28]); t1[3] = __builtin_elementwise_maximum(e[35], e[60]);
    t0[4] = __builtin_elementwise_maximum(e[4], e[27]); t1[4] = __builtin_elementwise_maximum(e[36], e[59]);
    t0[5] = __builtin_elementwise_maximum(e[5], e[26]); t1[5] = __builtin_elementwise_maximum(e[37], e[58]);
    t0[6] = __builtin_elementwise_maximum(e[6], e[25]); t1[6] = __builtin_elementwise_maximum(e[38], e[57]);
    t0[7] = __builtin_elementwise_maximum(e[7], e[24]); t1[7] = __builtin_elementwise_maximum(e[39], e[56]);
    t0[8] = __builtin_elementwise_maximum(e[8], e[23]); t1[8] = __builtin_elementwise_maximum(e[40], e[55]);
    t0[9] = __builtin_elementwise_maximum(e[9], e[22]); t1[9] = __builtin_elementwise_maximum(e[41], e[54]);
    t0[10] = __builtin_elementwise_maximum(e[10], e[21]); t1[10] = __builtin_elementwise_maximum(e[42], e[53]);
    t0[11] = __builtin_elementwise_maximum(e[11], e[20]); t1[11] = __builtin_elementwise_maximum(e[43], e[52]);
    t0[12] = __builtin_elementwise_maximum(e[12], e[19]); t1[12] = __builtin_elementwise_maximum(e[44], e[51]);
    t0[13] = __builtin_elementwise_maximum(e[13], e[18]); t1[13] = __builtin_elementwise_maximum(e[45], e[50]);
    t0[14] = __builtin_elementwise_maximum(e[14], e[17]); t1[14] = __builtin_elementwise_maximum(e[46], e[49]);
    t0[15] = __builtin_elementwise_maximum(e[15], e[16]); t1[15] = __builtin_elementwise_maximum(e[47], e[48]);
    { const float a_ = t0[0], b_ = t0[8]; t0[0] = __builtin_elementwise_maximum(a_, b_); t0[8] = __builtin_elementwise_minimum(a_, b_); }
    { const float a_ = t0[1], b_ = t0[9]; t0[1] = __builtin_elementwise_maximum(a_, b_); t0[9] = __builtin_elementwise_minimum(a_, b_); }
    { const float a_ = t0[2], b_ = t0[10]; t0[2] = __builtin_elementwise_maximum(a_, b_); t0[10] = __builtin_elementwise_minimum(a_, b_); }
    { const float a_ = t0[3], b_ = t0[11]; t0[3] = __builtin_elementwise_maximum(a_, b_); t0[11] = __builtin_elementwise_minimum(a_, b_); }
    { const float a_ = t0[4], b_ = t0[12]; t0[4] = __builtin_elementwise_maximum(a_, b_); t0[12] = __builtin_elementwise_minimum(a_, b_); }
    { const float a_ = t0[5], b_ = t0[13]; t0[5] = __builtin_elementwise_maximum(a_, b_); t0[13] = __builtin_elementwise_minimum(a_, b_); }
    { const float a_ = t0[6], b_ = t0[14]; t0[6] = __builtin_elementwise_maximum(a_, b_); t0[14] = __builtin_elementwise_minimum(a_, b_); }
    { const float a_ = t0[7], b_ = t0[15]; t0[7] = __builtin_elementwise_maximum(a_, b_); t0[15] = __builtin_elementwise_minimum(a_, b_); }
    { const float a_ = t0[0], b_ = t0[4]; t0[0] = __builtin_elementwise_maximum(a_, b_); t0[4] = __builtin_elementwise_minimum(a_, b_); }
    { const float a_ = t0[1], b_ = t0[5]; t0[1] = __builtin_elementwise_maximum(a_, b_); t0[5] = __builtin_elementwise_minimum(a_, b_); }
    { const float a_ = t0[2], b_ = t0[6]; t0[2] = __builtin_elementwise_maximum(a_, b_); t0[6] = __builtin_elementwise_minimum(a_, b_); }
    { const float a_ = t0[3], b_ = t0[7]; t0[3] = __builtin_elementwise_maximum(a_, b_); t0[7] = __builtin_elementwise_minimum(a_, b_); }
    { const float a_ = t0[8], b_ = t0[12]; t0[8] = __builtin_elementwise_maximum(a_, b_); t0[12] = __builtin_elementwise_minimum(a_, b_); }
    { const float a_ = t0[9], b_ = t0[13]; t0[9] = __builtin_elementwise_maximum(a_, b_); t0[13] = __builtin_elementwise_minimum(a_, b_); }
    { const float a_ = t0[10], b_ = t0[14]; t0[10] = __builtin_elementwise_maximum(a_, b_); t0[14] = __builtin_elementwise_minimum(a_, b_); }
    { const float a_ = t0[11], b_ = t0[15]; t0[11] = __builtin_elementwise_maximum(a_, b_); t0[15] = __builtin_elementwise_minimum(a_, b_); }
    { const float a_ = t0[0], b_ = t0[2]; t0[0] = __builtin_elementwise_maximum(a_, b_); t0[2] = __builtin_elementwise_minimum(a_, b_); }
    { const float a_ = t0[1], b_ = t0[3]; t0[1] = __builtin_elementwise_maximum(a_, b_); t0[3] = __builtin_elementwise_minimum(a_, b_); }
    { const float a_ = t0[4], b_ = t0[6]; t0[4] = __builtin_elementwise_maximum(a_, b_); t0[6] = __builtin_elementwise_minimum(a_, b_); }
    { const float a_ = t0[5], b_ = t0[7]; t0[5] = __builtin_elementwise_maximum(a_, b_); t0[7] = __builtin_elementwise_minimum(a_, b_); }
    { const float a_ = t0[8], b_ = t0[10]; t0[8] = __builtin_elementwise_maximum(a_, b_); t0[10] = __builtin_elementwise_minimum(a_, b_); }
    { const float a_ = t0[9], b_ = t0[11]; t0[9] = __builtin_elementwise_maximum(a_, b_); t0[11] = __builtin_elementwise_minimum(a_, b_); }
    { const float a_ = t0[12], b_ = t0[14]; t0[12] = __builtin_elementwise_maximum(a_, b_); t0[14] = __builtin_elementwise_minimum(a_, b_); }
    { const float a_ = t0[13], b_ = t0[15]; t0[13] = __builtin_elementwise_maximum(a_, b_); t0[15] = __builtin_elementwise_minimum(a_, b_); }
    { const float a_ = t0[0], b_ = t0[1]; t0[0] = __builtin_elementwise_maximum(a_, b_); t0[1] = __builtin_elementwise_minimum(a_, b_); }
    { const float a_ = t0[2], b_ = t0[3]; t0[2] = __builtin_elementwise_maximum(a_, b_); t0[3] = __builtin_elementwise_minimum(a_, b_); }
    { const float a_ = t0[4], b_ = t0[5]; t0[4] = __builtin_elementwise_maximum(a_, b_); t0[5] = __builtin_elementwise_minimum(a_, b_); }
    { const float a_ = t0[6], b_ = t0[7]; t0[6] = __builtin_elementwise_maximum(a_, b_); t0[7] = __builtin_elementwise_minimum(a_, b_); }
    { const float a_ = t0[8], b_ = t0[9]; t0[8] = __builtin_elementwise_maximum(a_, b_); t0[9] = __builtin_elementwise_minimum(a_, b_); }
    { const float a_ = t0[10], b_ = t0[11]; t0[10] = __builtin_elementwise_maximum(a_, b_); t0[11] = __builtin_elementwise_minimum(a_, b_); }
    { const float a_ = t0[12], b_ = t0[13]; t0[12] = __builtin_elementwise_maximum(a_, b_); t0[13] = __builtin_elementwise_minimum(a_, b_); }
    { const float a_ = t0[14], b_ = t0[15]; t0[14] = __builtin_elementwise_maximum(a_, b_); t0[15] = __builtin_elementwise_minimum(a_, b_); }
    { const float a_ = t1[0], b_ = t1[8]; t1[0] = __builtin_elementwise_maximum(a_, b_); t1[8] = __builtin_elementwise_minimum(a_, b_); }
    { const float a_ = t1[1], b_ = t1[9]; t1[1] = __builtin_elementwise_maximum(a_, b_); t1[9] = __builtin_elementwise_minimum(a_, b_); }
    { const float a_ = t1[2], b_ = t1[10]; t1[2] = __builtin_elementwise_maximum(a_, b_); t1[10] = __builtin_elementwise_minimum(a_, b_); }
    { const float a_ = t1[3], b_ = t1[11]; t1[3] = __builtin_elementwise_maximum(a_, b_); t1[11] = __builtin_elementwise_minimum(a_, b_); }
    { const float a_ = t1[4], b_ = t1[12]; t1[4] = __builtin_elementwise_maximum(a_, b_); t1[12] = __builtin_elementwise_minimum(a_, b_); }
    { const float a_ = t1[5], b_ = t1[13]; t1[5] = __builtin_elementwise_maximum(a_, b_); t1[13] = __builtin_elementwise_minimum(a_, b_); }
    { const float a_ = t1[6], b_ = t1[14]; t1[6] = __builtin_elementwise_maximum(a_, b_); t1[14] = __builtin_elementwise_minimum(a_, b_); }
    { const float a_ = t1[7], b_ = t1[15]; t1[7] = __builtin_elementwise_maximum(a_, b_); t1[15] = __builtin_elementwise_minimum(a_, b_); }
    { const float a_ = t1[0], b_ = t1[4]; t1[0] = __builtin_elementwise_maximum(a_, b_); t1[4] = __builtin_elementwise_minimum(a_, b_); }
    { const float a_ = t1[1], b_ = t1[5]; t1[1] = __builtin_elementwise_maximum(a_, b_); t1[5] = __builtin_elementwise_minimum(a_, b_); }
    { const float a_ = t1[2], b_ = t1[6]; t1[2] = __builtin_elementwise_maximum(a_, b_); t1[6] = __builtin_elementwise_minimum(a_, b_); }
    { const float a_ = t1[3], b_ = t1[7]; t1[3] = __builtin_elementwise_maximum(a_, b_); t1[7] = __builtin_elementwise_minimum(a_, b_); }
    { const float a_ = t1[8], b_ = t1[12]; t1[8] = __builtin_elementwise_maximum(a_, b_); t1[12] = __builtin_elementwise_minimum(a_, b_); }
    { const float a_ = t1[9], b_ = t1[13]; t1[9] = __builtin_elementwise_maximum(a_, b_); t1[13] = __builtin_elementwise_minimum(a_, b_); }
    { const float a_ = t1[10], b_ = t1[14]; t1[10] = __builtin_elementwise_maximum(a_, b_); t1[14] = __builtin_elementwise_minimum(a_, b_); }
    { const float a_ = t1[11], b_ = t1[15]; t1[11] = __builtin_elementwise_maximum(a_, b_); t1[15] = __builtin_elementwise_minimum(a_, b_); }
    { const float a_ = t1[0], b_ = t1[2]; t1[0] = __builtin_elementwise_maximum(a_, b_); t1[2] = __builtin_elementwise_minimum(a_, b_); }
    { const float a_ = t1[1], b_ = t1[3]; t1[1] = __builtin_elementwise_maximum(a_, b_); t1[3] = __builtin_elementwise_minimum(a_, b_); }
    { const float a_ = t1[4], b_ = t1[6]; t1[4] = __builtin_elementwise_maximum(a_, b_); t1[6] = __builtin_elementwise_minimum(a_, b_); }
    { const float a_ = t1[5], b_ = t1[7]; t1[5] = __builtin_elementwise_maximum(a_, b_); t1[7] = __builtin_elementwise_minimum(a_, b_); }
    { const float a_ = t1[8], b_ = t1[10]; t1[8] = __builtin_elementwise_maximum(a_, b_); t1[10] = __builtin_elementwise_minimum(a_, b_); }
    { const float a_ = t1[9], b_ = t1[11]; t1[9] = __builtin_elementwise_maximum(a_, b_); t1[11] = __builtin_elementwise_minimum(a_, b_); }
    { const float a_ = t1[12], b_ = t1[14]; t1[12] = __builtin_elementwise_maximum(a_, b_); t1[14] = __builtin_elementwise_minimum(a_, b_); }
    { const float a_ = t1[13], b_ = t1[15]; t1[13] = __builtin_elementwise_maximum(a_, b_); t1[15] = __builtin_elementwise_minimum(a_, b_); }
    { const float a_ = t1[0], b_ = t1[1]; t1[0] = __builtin_elementwise_maximum(a_, b_); t1[1] = __builtin_elementwise_minimum(a_, b_); }
    { const float a_ = t1[2], b_ = t1[3]; t1[2] = __builtin_elementwise_maximum(a_, b_); t1[3] = __builtin_elementwise_minimum(a_, b_); }
    { const float a_ = t1[4], b_ = t1[5]; t1[4] = __builtin_elementwise_maximum(a_, b_); t1[5] = __builtin_elementwise_minimum(a_, b_); }
    { const float a_ = t1[6], b_ = t1[7]; t1[6] = __builtin_elementwise_maximum(a_, b_); t1[7] = __builtin_elementwise_minimum(a_, b_); }
    { const float a_ = t1[8], b_ = t1[9]; t1[8] = __builtin_elementwise_maximum(a_, b_); t1[9] = __builtin_elementwise_minimum(a_, b_); }
    { const float a_ = t1[10], b_ = t1[11]; t1[10] = __builtin_elementwise_maximum(a_, b_); t1[11] = __builtin_elementwise_minimum(a_, b_); }
    { const float a_ = t1[12], b_ = t1[13]; t1[12] = __builtin_elementwise_maximum(a_, b_); t1[13] = __builtin_elementwise_minimum(a_, b_); }
    { const float a_ = t1[14], b_ = t1[15]; t1[14] = __builtin_elementwise_maximum(a_, b_); t1[15] = __builtin_elementwise_minimum(a_, b_); }
    float u[16];
    u[0] = __builtin_elementwise_maximum(t0[0], t1[15]);
    u[1] = __builtin_elementwise_maximum(t0[1], t1[14]);
    u[2] = __builtin_elementwise_maximum(t0[2], t1[13]);
    u[3] = __builtin_elementwise_maximum(t0[3], t1[12]);
    u[4] = __builtin_elementwise_maximum(t0[4], t1[11]);
    u[5] = __builtin_elementwise_maximum(t0[5], t1[10]);
    u[6] = __builtin_elementwise_maximum(t0[6], t1[9]);
    u[7] = __builtin_elementwise_maximum(t0[7], t1[8]);
    u[8] = __builtin_elementwise_maximum(t0[8], t1[7]);
    u[9] = __builtin_elementwise_maximum(t0[9], t1[6]);
    u[10] = __builtin_elementwise_maximum(t0[10], t1[5]);
    u[11] = __builtin_elementwise_maximum(t0[11], t1[4]);
    u[12] = __builtin_elementwise_maximum(t0[12], t1[3]);
    u[13] = __builtin_elementwise_maximum(t0[13], t1[2]);
    u[14] = __builtin_elementwise_maximum(t0[14], t1[1]);
    u[15] = __builtin_elementwise_maximum(t0[15], t1[0]);
    { const float a_ = u[0], b_ = u[8]; u[0] = __builtin_elementwise_maximum(a_, b_); u[8] = __builtin_elementwise_minimum(a_, b_); }
    { const float a_ = u[1], b_ = u[9]; u[1] = __builtin_elementwise_maximum(a_, b_); u[9] = __builtin_elementwise_minimum(a_, b_); }
    { const float a_ = u[2], b_ = u[10]; u[2] = __builtin_elementwise_maximum(a_, b_); u[10] = __builtin_elementwise_minimum(a_, b_); }
    { const float a_ = u[3], b_ = u[11]; u[3] = __builtin_elementwise_maximum(a_, b_); u[11] = __builtin_elementwise_minimum(a_, b_); }
    { const float a_ = u[4], b_ = u[12]; u[4] = __builtin_elementwise_maximum(a_, b_); u[12] = __builtin_elementwise_minimum(a_, b_); }
    { const float a_ = u[5], b_ = u[13]; u[5] = __builtin_elementwise_maximum(a_, b_); u[13] = __builtin_elementwise_minimum(a_, b_); }
    { const float a_ = u[6], b_ = u[14]; u[6] = __builtin_elementwise_maximum(a_, b_); u[14] = __builtin_elementwise_minimum(a_, b_); }
    { const float a_ = u[7], b_ = u[15]; u[7] = __builtin_elementwise_maximum(a_, b_); u[15] = __builtin_elementwise_minimum(a_, b_); }
    { const float a_ = u[0], b_ = u[4]; u[0] = __builtin_elementwise_maximum(a_, b_); u[4] = __builtin_elementwise_minimum(a_, b_); }
    { const float a_ = u[1], b_ = u[5]; u[1] = __builtin_elementwise_maximum(a_, b_); u[5] = __builtin_elementwise_minimum(a_, b_); }
    { const float a_ = u[2], b_ = u[6]; u[2] = __builtin_elementwise_maximum(a_, b_); u[6] = __builtin_elementwise_minimum(a_, b_); }
    { const float a_ = u[3], b_ = u[7]; u[3] = __builtin_elementwise_maximum(a_, b_); u[7] = __builtin_elementwise_minimum(a_, b_); }
    { const float a_ = u[8], b_ = u[12]; u[8] = __builtin_elementwise_maximum(a_, b_); u[12] = __builtin_elementwise_minimum(a_, b_); }
    { const float a_ = u[9], b_ = u[13]; u[9] = __builtin_elementwise_maximum(a_, b_); u[13] = __builtin_elementwise_minimum(a_, b_); }
    { const float a_ = u[10], b_ = u[14]; u[10] = __builtin_elementwise_maximum(a_, b_); u[14] = __builtin_elementwise_minimum(a_, b_); }
    { const float a_ = u[11], b_ = u[15]; u[11] = __builtin_elementwise_maximum(a_, b_); u[15] = __builtin_elementwise_minimum(a_, b_); }
    { const float a_ = u[0], b_ = u[2]; u[0] = __builtin_elementwise_maximum(a_, b_); u[2] = __builtin_elementwise_minimum(a_, b_); }
    { const float a_ = u[1], b_ = u[3]; u[1] = __builtin_elementwise_maximum(a_, b_); u[3] = __builtin_elementwise_minimum(a_, b_); }
    { const float a_ = u[4], b_ = u[6]; u[4] = __builtin_elementwise_maximum(a_, b_); u[6] = __builtin_elementwise_minimum(a_, b_); }
    { const float a_ = u[5], b_ = u[7]; u[5] = __builtin_elementwise_maximum(a_, b_); u[7] = __builtin_elementwise_minimum(a_, b_); }
    { const float a_ = u[8], b_ = u[10]; u[8] = __builtin_elementwise_maximum(a_, b_); u[10] = __builtin_elementwise_minimum(a_, b_); }
    { const float a_ = u[9], b_ = u[11]; u[9] = __builtin_elementwise_maximum(a_, b_); u[11] = __builtin_elementwise_minimum(a_, b_); }
    { const float a_ = u[12], b_ = u[14]; u[12] = __builtin_elementwise_maximum(a_, b_); u[14] = __builtin_elementwise_minimum(a_, b_); }
    { const float a_ = u[13], b_ = u[15]; u[13] = __builtin_elementwise_maximum(a_, b_); u[15] = __builtin_elementwise_minimum(a_, b_); }
    { const float a_ = u[0], b_ = u[1]; u[0] = __builtin_elementwise_maximum(a_, b_); u[1] = __builtin_elementwise_minimum(a_, b_); }
    { const float a_ = u[2], b_ = u[3]; u[2] = __builtin_elementwise_maximum(a_, b_); u[3] = __builtin_elementwise_minimum(a_, b_); }
    { const float a_ = u[4], b_ = u[5]; u[4] = __builtin_elementwise_maximum(a_, b_); u[5] = __builtin_elementwise_minimum(a_, b_); }
    { const float a_ = u[6], b_ = u[7]; u[6] = __builtin_elementwise_maximum(a_, b_); u[7] = __builtin_elementwise_minimum(a_, b_); }
    { const float a_ = u[8], b_ = u[9]; u[8] = __builtin_elementwise_maximum(a_, b_); u[9] = __builtin_elementwise_minimum(a_, b_); }
    { const float a_ = u[10], b_ = u[11]; u[10] = __builtin_elementwise_maximum(a_, b_); u[11] = __builtin_elementwise_minimum(a_, b_); }
    { const float a_ = u[12], b_ = u[13]; u[12] = __builtin_elementwise_maximum(a_, b_); u[13] = __builtin_elementwise_minimum(a_, b_); }
    { const float a_ = u[14], b_ = u[15]; u[14] = __builtin_elementwise_maximum(a_, b_); u[15] = __builtin_elementwise_minimum(a_, b_); }
    float w[16];
    { auto r_ = __builtin_amdgcn_permlane32_swap(__float_as_uint(u[15]), __float_as_uint(u[15]), false, false); w[0] = __builtin_elementwise_maximum(u[0], __uint_as_float(hi ? r_[0] : r_[1])); }
    { auto r_ = __builtin_amdgcn_permlane32_swap(__float_as_uint(u[14]), __float_as_uint(u[14]), false, false); w[1] = __builtin_elementwise_maximum(u[1], __uint_as_float(hi ? r_[0] : r_[1])); }
    { auto r_ = __builtin_amdgcn_permlane32_swap(__float_as_uint(u[13]), __float_as_uint(u[13]), false, false); w[2] = __builtin_elementwise_maximum(u[2], __uint_as_float(hi ? r_[0] : r_[1])); }
    { auto r_ = __builtin_amdgcn_permlane32_swap(__float_as_uint(u[12]), __float_as_uint(u[12]), false, false); w[3] = __builtin_elementwise_maximum(u[3], __uint_as_float(hi ? r_[0] : r_[1])); }
    { auto r_ = __builtin_amdgcn_permlane32_swap(__float_as_uint(u[11]), __float_as_uint(u[11]), false, false); w[4] = __builtin_elementwise_maximum(u[4], __uint_as_float(hi ? r_[0] : r_[1])); }
    { auto r_ = __builtin_amdgcn_permlane32_swap(__float_as_uint(u[10]), __float_as_uint(u[10]), false, false); w[5] = __builtin_elementwise_maximum(u[5], __uint_as_float(hi ? r_[0] : r_[1])); }
    { auto r_ = __builtin_amdgcn_permlane32_swap(__float_as_uint(u[9]), __float_as_uint(u[9]), false, false); w[6] = __builtin_elementwise_maximum(u[6], __uint_as_float(hi ? r_[0] : r_[1])); }
    { auto r_ = __builtin_amdgcn_permlane32_swap(__float_as_uint(u[8]), __float_as_uint(u[8]), false, false); w[7] = __builtin_elementwise_maximum(u[7], __uint_as_float(hi ? r_[0] : r_[1])); }
    { auto r_ = __builtin_amdgcn_permlane32_swap(__float_as_uint(u[7]), __float_as_uint(u[7]), false, false); w[8] = __builtin_elementwise_maximum(u[8], __uint_as_float(hi ? r_[0] : r_[1])); }
    { auto r_ = __builtin_amdgcn_permlane32_swap(__float_as_uint(u[6]), __float_as_uint(u[6]), false, false); w[9] = __builtin_elementwise_maximum(u[9], __uint_as_float(hi ? r_[0] : r_[1])); }
    { auto r_ = __builtin_amdgcn_permlane32_swap(__float_as_uint(u[5]), __float_as_uint(u[5]), false, false); w[10] = __builtin_elementwise_maximum(u[10], __uint_as_float(hi ? r_[0] : r_[1])); }
    { auto r_ = __builtin_amdgcn_permlane32_swap(__float_as_uint(u[4]), __float_as_uint(u[4]), false, false); w[11] = __builtin_elementwise_maximum(u[11], __uint_as_float(hi ? r_[0] : r_[1])); }
    { auto r_ = __builtin_amdgcn_permlane32_swap(__float_as_uint(u[3]), __float_as_uint(u[3]), false, false); w[12] = __builtin_elementwise_maximum(u[12], __uint_as_float(hi ? r_[0] : r_[1])); }
    { auto r_ = __builtin_amdgcn_permlane32_swap(__float_as_uint(u[2]), __float_as_uint(u[2]), false, false); w[13] = __builtin_elementwise_maximum(u[13], __uint_as_float(hi ? r_[0] : r_[1])); }
    { auto r_ = __builtin_amdgcn_permlane32_swap(__float_as_uint(u[1]), __float_as_uint(u[1]), false, false); w[14] = __builtin_elementwise_maximum(u[14], __uint_as_float(hi ? r_[0] : r_[1])); }
    { auto r_ = __builtin_amdgcn_permlane32_swap(__float_as_uint(u[0]), __float_as_uint(u[0]), false, false); w[15] = __builtin_elementwise_maximum(u[15], __uint_as_float(hi ? r_[0] : r_[1])); }
    { const float a_ = w[0], b_ = w[8]; w[0] = __builtin_elementwise_maximum(a_, b_); w[8] = __builtin_elementwise_minimum(a_, b_); }
    { const float a_ = w[1], b_ = w[9]; w[1] = __builtin_elementwise_maximum(a_, b_); w[9] = __builtin_elementwise_minimum(a_, b_); }
    { const float a_ = w[2], b_ = w[10]; w[2] = __builtin_elementwise_maximum(a_, b_); w[10] = __builtin_elementwise_minimum(a_, b_); }
    { const float a_ = w[3], b_ = w[11]; w[3] = __builtin_elementwise_maximum(a_, b_); w[11] = __builtin_elementwise_minimum(a_, b_); }
    { const float a_ = w[4], b_ = w[12]; w[4] = __builtin_elementwise_maximum(a_, b_); w[12] = __builtin_elementwise_minimum(a_, b_); }
    { const float a_ = w[5], b_ = w[13]; w[5] = __builtin_elementwise_maximum(a_, b_); w[13] = __builtin_elementwise_minimum(a_, b_); }
    { const float a_ = w[6], b_ = w[14]; w[6] = __builtin_elementwise_maximum(a_, b_); w[14] = __builtin_elementwise_minimum(a_, b_); }
    { const float a_ = w[7], b_ = w[15]; w[7] = __builtin_elementwise_maximum(a_, b_); w[15] = __builtin_elementwise_minimum(a_, b_); }
    { const float a_ = w[0], b_ = w[4]; w[0] = __builtin_elementwise_maximum(a_, b_); w[4] = __builtin_elementwise_minimum(a_, b_); }
    { const float a_ = w[1], b_ = w[5]; w[1] = __builtin_elementwise_maximum(a_, b_); w[5] = __builtin_elementwise_minimum(a_, b_); }
    { const float a_ = w[2], b_ = w[6]; w[2] = __builtin_elementwise_maximum(a_, b_); w[6] = __builtin_elementwise_minimum(a_, b_); }
    { const float a_ = w[3], b_ = w[7]; w[3] = __builtin_elementwise_maximum(a_, b_); w[7] = __builtin_elementwise_minimum(a_, b_); }
    { const float a_ = w[8], b_ = w[12]; w[8] = __builtin_elementwise_maximum(a_, b_); w[12] = __builtin_elementwise_minimum(a_, b_); }
    { const float a_ = w[9], b_ = w[13]; w[9] = __builtin_elementwise_maximum(a_, b_); w[13] = __builtin_elementwise_minimum(a_, b_); }
    { const float a_ = w[10], b_ = w[14]; w[10] = __builtin_elementwise_maximum(a_, b_); w[14] = __builtin_elementwise_minimum(a_, b_); }
    { const float a_ = w[11], b_ = w[15]; w[11] = __builtin_elementwise_maximum(a_, b_); w[15] = __builtin_elementwise_minimum(a_, b_); }
    { const float a_ = w[0], b_ = w[2]; w[0] = __builtin_elementwise_maximum(a_, b_); w[2] = __builtin_elementwise_minimum(a_, b_); }
    { const float a_ = w[1], b_ = w[3]; w[1] = __builtin_elementwise_maximum(a_, b_); w[3] = __builtin_elementwise_minimum(a_, b_); }
    { const float a_ = w[4], b_ = w[6]; w[4] = __builtin_elementwise_maximum(a_, b_); w[6] = __builtin_elementwise_minimum(a_, b_); }
    { const float a_ = w[5], b_ = w[7]; w[5] = __builtin_elementwise_maximum(a_, b_); w[7] = __builtin_elementwise_minimum(a_, b_); }
    { const float a_ = w[8], b_ = w[10]; w[8] = __builtin_elementwise_maximum(a_, b_); w[10] = __builtin_elementwise_minimum(a_, b_); }
    { const float a_ = w[9], b_ = w[11]; w[9] = __builtin_elementwise_maximum(a_, b_); w[11] = __builtin_elementwise_minimum(a_, b_); }
    { const float a_ = w[12], b_ = w[14]; w[12] = __builtin_elementwise_maximum(a_, b_); w[14] = __builtin_elementwise_minimum(a_, b_); }
    { const float a_ = w[13], b_ = w[15]; w[13] = __builtin_elementwise_maximum(a_, b_); w[15] = __builtin_elementwise_minimum(a_, b_); }
    { const float a_ = w[0], b_ = w[1]; w[0] = __builtin_elementwise_maximum(a_, b_); w[1] = __builtin_elementwise_minimum(a_, b_); }
    { const float a_ = w[2], b_ = w[3]; w[2] = __builtin_elementwise_maximum(a_, b_); w[3] = __builtin_elementwise_minimum(a_, b_); }
    { const float a_ = w[4], b_ = w[5]; w[4] = __builtin_elementwise_maximum(a_, b_); w[5] = __builtin_elementwise_minimum(a_, b_); }
    { const float a_ = w[6], b_ = w[7]; w[6] = __builtin_elementwise_maximum(a_, b_); w[7] = __builtin_elementwise_minimum(a_, b_); }
    { const float a_ = w[8], b_ = w[9]; w[8] = __builtin_elementwise_maximum(a_, b_); w[9] = __builtin_elementwise_minimum(a_, b_); }
    { const float a_ = w[10], b_ = w[11]; w[10] = __builtin_elementwise_maximum(a_, b_); w[11] = __builtin_elementwise_minimum(a_, b_); }
    { const float a_ = w[12], b_ = w[13]; w[12] = __builtin_elementwise_maximum(a_, b_); w[13] = __builtin_elementwise_minimum(a_, b_); }
    { const float a_ = w[14], b_ = w[15]; w[14] = __builtin_elementwise_maximum(a_, b_); w[15] = __builtin_elementwise_minimum(a_, b_); }
    if (hi == 0) {
#pragma unroll
        for (int it = 0; it < 16; ++it) { const unsigned k_ = __float_as_uint(w[it]); vout[it * 32 + r32] = __uint_as_float(k_ & 0xffffff80u); iout[it * 32 + r32] = (int)(k_ & 127u); }
    }
}
__device__ __forceinline__ void peer_retrieve(const bf16* KEYB, const bf16* PQ, LAS char* wbase, int t0, int lane0) {
    LAS int* elist = (LAS int*)wbase; LAS float* glist = (LAS float*)(wbase + 2048); LAS float* vtab = (LAS float*)(wbase + 4608); LAS int* itab = (LAS int*)(wbase + 4608 + 4096);
        {
            int lv = lane0; asm volatile("" : "+v"(lv));
            const int r32 = lv & 31, hi = lv >> 5;
            const int tt = r32 >> 3, hd = r32 & 7;
#pragma unroll 1
            for (int side = 0; side < 2; ++side) {
                bf16x8 qf[8];
#pragma unroll
                for (int ks = 0; ks < 8; ++ks) qf[ks] = *(const bf16x8*)(PQ + (size_t)(t0 + tt) * DM + hd * 256 + side * 128 + 16 * ks + 8 * hi);
                f32x16 acc[4];
                bf16x8 ka[8], kn[8];
#pragma unroll
                for (int ks = 0; ks < 8; ++ks) ka[ks] = *(const bf16x8*)(KEYB + (size_t)(side * 128 + r32) * 128 + ks * 16 + hi * 8);
#pragma unroll
                for (int b = 0; b < 4; ++b) {
#pragma unroll
                    for (int r = 0; r < 16; ++r) acc[b][r] = 0.f;
                    if (b < 3) {
#pragma unroll
                        for (int ks = 0; ks < 8; ++ks) kn[ks] = *(const bf16x8*)(KEYB + (size_t)(side * 128 + 32 * (b + 1) + r32) * 128 + ks * 16 + hi * 8); }
                    __builtin_amdgcn_sched_barrier(0);
#pragma unroll
                    for (int ks = 0; ks < 8; ++ks) acc[b] = MFMA32(ka[ks], qf[ks], acc[b]);
                    __builtin_amdgcn_sched_barrier(0);
                    if (b < 3) {
#pragma unroll
                        for (int ks = 0; ks < 8; ++ks) ka[ks] = kn[ks]; }
                }
                top16_of_128(acc, vtab + side * 512, itab + side * 512, r32, hi);
            }
            asm volatile("s_waitcnt lgkmcnt(0)" ::: "memory"); __builtin_amdgcn_wave_barrier();
            float cs[25]; int ce[25];
    cs[0] = hi ? (vtab[0 + r32] + vtab[544 + r32]) : (vtab[0 + r32] + vtab[512 + r32]); ce[0] = hi ? (itab[0 + r32] * 128 + itab[544 + r32]) : (itab[0 + r32] * 128 + itab[512 + r32]);
    cs[1] = hi ? (vtab[0 + r32] + vtab[608 + r32]) : (vtab[0 + r32] + vtab[576 + r32]); ce[1] = hi ? (itab[0 + r32] * 128 + itab[608 + r32]) : (itab[0 + r32] * 128 + itab[576 + r32]);
    cs[2] = hi ? (vtab[0 + r32] + vtab[672 + r32]) : (vtab[0 + r32] + vtab[640 + r32]); ce[2] = hi ? (itab[0 + r32] * 128 + itab[672 + r32]) : (itab[0 + r32] * 128 + itab[640 + r32]);
    cs[3] = hi ? (vtab[0 + r32] + vtab[736 + r32]) : (vtab[0 + r32] + vtab[704 + r32]); ce[3] = hi ? (itab[0 + r32] * 128 + itab[736 + r32]) : (itab[0 + r32] * 128 + itab[704 + r32]);
    cs[4] = hi ? (vtab[0 + r32] + vtab[800 + r32]) : (vtab[0 + r32] + vtab[768 + r32]); ce[4] = hi ? (itab[0 + r32] * 128 + itab[800 + r32]) : (itab[0 + r32] * 128 + itab[768 + r32]);
    cs[5] = hi ? (vtab[0 + r32] + vtab[864 + r32]) : (vtab[0 + r32] + vtab[832 + r32]); ce[5] = hi ? (itab[0 + r32] * 128 + itab[864 + r32]) : (itab[0 + r32] * 128 + itab[832 + r32]);
    cs[6] = hi ? (vtab[0 + r32] + vtab[928 + r32]) : (vtab[0 + r32] + vtab[896 + r32]); ce[6] = hi ? (itab[0 + r32] * 128 + itab[928 + r32]) : (itab[0 + r32] * 128 + itab[896 + r32]);
    cs[7] = hi ? (vtab[0 + r32] + vtab[992 + r32]) : (vtab[0 + r32] + vtab[960 + r32]); ce[7] = hi ? (itab[0 + r32] * 128 + itab[992 + r32]) : (itab[0 + r32] * 128 + itab[960 + r32]);
    cs[8] = hi ? (vtab[32 + r32] + vtab[544 + r32]) : (vtab[32 + r32] + vtab[512 + r32]); ce[8] = hi ? (itab[32 + r32] * 128 + itab[544 + r32]) : (itab[32 + r32] * 128 + itab[512 + r32]);
    cs[9] = hi ? (vtab[32 + r32] + vtab[608 + r32]) : (vtab[32 + r32] + vtab[576 + r32]); ce[9] = hi ? (itab[32 + r32] * 128 + itab[608 + r32]) : (itab[32 + r32] * 128 + itab[576 + r32]);
    cs[10] = hi ? (vtab[32 + r32] + vtab[672 + r32]) : (vtab[32 + r32] + vtab[640 + r32]); ce[10] = hi ? (itab[32 + r32] * 128 + itab[672 + r32]) : (itab[32 + r32] * 128 + itab[640 + r32]);
    cs[11] = hi ? (vtab[32 + r32] + vtab[736 + r32]) : (vtab[32 + r32] + vtab[704 + r32]); ce[11] = hi ? (itab[32 + r32] * 128 + itab[736 + r32]) : (itab[32 + r32] * 128 + itab[704 + r32]);
    cs[12] = hi ? (vtab[64 + r32] + vtab[544 + r32]) : (vtab[64 + r32] + vtab[512 + r32]); ce[12] = hi ? (itab[64 + r32] * 128 + itab[544 + r32]) : (itab[64 + r32] * 128 + itab[512 + r32]);
    cs[13] = hi ? (vtab[64 + r32] + vtab[608 + r32]) : (vtab[64 + r32] + vtab[576 + r32]); ce[13] = hi ? (itab[64 + r32] * 128 + itab[608 + r32]) : (itab[64 + r32] * 128 + itab[576 + r32]);
    cs[14] = hi ? (vtab[96 + r32] + vtab[512 + r32]) : (vtab[64 + r32] + vtab[640 + r32]); ce[14] = hi ? (itab[96 + r32] * 128 + itab[512 + r32]) : (itab[64 + r32] * 128 + itab[640 + r32]);
    cs[15] = hi ? (vtab[96 + r32] + vtab[576 + r32]) : (vtab[96 + r32] + vtab[544 + r32]); ce[15] = hi ? (itab[96 + r32] * 128 + itab[576 + r32]) : (itab[96 + r32] * 128 + itab[544 + r32]);
    cs[16] = hi ? (vtab[128 + r32] + vtab[512 + r32]) : (vtab[96 + r32] + vtab[608 + r32]); ce[16] = hi ? (itab[128 + r32] * 128 + itab[512 + r32]) : (itab[96 + r32] * 128 + itab[608 + r32]);
    cs[17] = hi ? (vtab[128 + r32] + vtab[576 + r32]) : (vtab[128 + r32] + vtab[544 + r32]); ce[17] = hi ? (itab[128 + r32] * 128 + itab[576 + r32]) : (itab[128 + r32] * 128 + itab[544 + r32]);
    cs[18] = hi ? (vtab[160 + r32] + vtab[544 + r32]) : (vtab[160 + r32] + vtab[512 + r32]); ce[18] = hi ? (itab[160 + r32] * 128 + itab[544 + r32]) : (itab[160 + r32] * 128 + itab[512 + r32]);
    cs[19] = hi ? (vtab[192 + r32] + vtab[544 + r32]) : (vtab[192 + r32] + vtab[512 + r32]); ce[19] = hi ? (itab[192 + r32] * 128 + itab[544 + r32]) : (itab[192 + r32] * 128 + itab[512 + r32]);
    cs[20] = hi ? (vtab[224 + r32] + vtab[544 + r32]) : (vtab[224 + r32] + vtab[512 + r32]); ce[20] = hi ? (itab[224 + r32] * 128 + itab[544 + r32]) : (itab[224 + r32] * 128 + itab[512 + r32]);
    cs[21] = hi ? (vtab[288 + r32] + vtab[512 + r32]) : (vtab[256 + r32] + vtab[512 + r32]); ce[21] = hi ? (itab[288 + r32] * 128 + itab[512 + r32]) : (itab[256 + r32] * 128 + itab[512 + r32]);
    cs[22] = hi ? (vtab[352 + r32] + vtab[512 + r32]) : (vtab[320 + r32] + vtab[512 + r32]); ce[22] = hi ? (itab[352 + r32] * 128 + itab[512 + r32]) : (itab[320 + r32] * 128 + itab[512 + r32]);
    cs[23] = hi ? (vtab[416 + r32] + vtab[512 + r32]) : (vtab[384 + r32] + vtab[512 + r32]); ce[23] = hi ? (itab[416 + r32] * 128 + itab[512 + r32]) : (itab[384 + r32] * 128 + itab[512 + r32]);
    cs[24] = hi ? (vtab[480 + r32] + vtab[512 + r32]) : (vtab[448 + r32] + vtab[512 + r32]); ce[24] = hi ? (itab[480 + r32] * 128 + itab[512 + r32]) : (itab[448 + r32] * 128 + itab[512 + r32]);
            float sum = 0.f, top = 0.f;
#pragma unroll 1
            for (int it = 0; it < 16; ++it) {
                float lm = cs[0];
#pragma unroll
                for (int j = 1; j < 25; ++j) lm = __builtin_elementwise_maximum(lm, cs[j]);
                float pm; { auto r_ = __builtin_amdgcn_permlane32_swap(__float_as_uint(lm), __float_as_uint(lm), false, false); pm = __uint_as_float(hi ? r_[0] : r_[1]); } const float gm = __builtin_elementwise_maximum(lm, pm);
                const bool mine = (lm == gm) && !(pm == gm && hi == 1);
                int me = -1; bool found = false;
#pragma unroll
                for (int j = 0; j < 25; ++j) { const bool hit = mine && !found && cs[j] == gm; if (hit) { cs[j] = -INFINITY; me = ce[j]; found = true; } }
                if (it == 0) top = gm;
                const float p = __expf(gm - top); sum += p;
                if (mine) { elist[tt * 128 + hd * 16 + it] = me; glist[tt * 128 + hd * 16 + it] = p; }
            }
            asm volatile("s_waitcnt lgkmcnt(0)" ::: "memory"); __builtin_amdgcn_wave_barrier();
            const float isum = 1.f / sum;
            if (hi == 0) {
#pragma unroll
                for (int k = 0; k < 16; ++k) glist[tt * 128 + hd * 16 + k] *= isum;
            }
            asm volatile("s_waitcnt lgkmcnt(0)" ::: "memory"); __builtin_amdgcn_wave_barrier();
        }
}
__device__ __forceinline__ void quant_row(const float* src, unsigned char* dstbase, int rr, float* scale, int lane, bool uns) {
    f32x4 v[2][4]; float amax = 0.f;
#pragma unroll
    for (int c = 0; c < 2; ++c)
#pragma unroll
        for (int k = 0; k < 4; ++k) { v[c][k] = *(const f32x4*)(src + 1024 * c + 16 * lane + 4 * k); amax = __builtin_elementwise_maximum(amax, __builtin_elementwise_maximum(__builtin_elementwise_maximum(fabsf(v[c][k].x), fabsf(v[c][k].y)), __builtin_elementwise_maximum(fabsf(v[c][k].z), fabsf(v[c][k].w)))); }
    amax = wave_max(amax); const float s = amax > 0.f ? amax * (1.f / 127.f) : 1.f, is = 1.f / s; const int ofs = uns ? 128 : 0;
#pragma unroll
    for (int c = 0; c < 2; ++c) { u32x4 o; unsigned wv[4];
#pragma unroll
        for (int k = 0; k < 4; ++k) { const int q0 = (int)rintf(v[c][k].x * is) + ofs, q1 = (int)rintf(v[c][k].y * is) + ofs, q2 = (int)rintf(v[c][k].z * is) + ofs, q3 = (int)rintf(v[c][k].w * is) + ofs;
            wv[k] = (unsigned)(q0 & 255) | ((unsigned)(q1 & 255) << 8) | ((unsigned)(q2 & 255) << 16) | ((unsigned)(q3 & 255) << 24); }
        o.x = wv[0]; o.y = wv[1]; o.z = wv[2]; o.w = wv[3];
        unsigned char* d = uns ? dstbase + (WS_VQS - WS_VQ) + (size_t)(4 * c + (lane >> 4)) * (4 * MiB) + (size_t)rr * 256 + 16 * (lane & 15) : dstbase + (size_t)rr * DM + 1024 * c + 16 * lane;
        *(u32x4*)d = o;
    }
    if (lane == 0) *scale = s;
}
__device__ __forceinline__ void cvt_f32_bf16(const float* src, bf16* dst, size_t n, size_t thr, size_t nthr) {
    for (size_t i = thr * 8; i < n; i += nthr * 8) { const f32x4 a = *(const f32x4*)(src + i), b = *(const f32x4*)(src + i + 4); u32x4 o; o.x = pk2(a.x, a.y); o.y = pk2(a.z, a.w); o.z = pk2(b.x, b.y); o.w = pk2(b.z, b.w); *(u32x4*)(dst + i) = o; }
}
constexpr size_t WS_PE = 320 * MiB, WS_PG = 324 * MiB, WS_PW = 328 * MiB, WS_XQ8 = 332 * MiB, WS_SX = 348 * MiB, WS_SSP = 349 * MiB;
#define PEER_LOADG(buf, en, g, TAB) do { _Pragma("unroll") for (int i = 0; i < 4; ++i) { const unsigned e_ = (unsigned)__builtin_amdgcn_readfirstlane((int)list[4 * (g) + i]); en[i] = e_; \
        const unsigned char* row = TAB + (size_t)(e_ & 0x3fffu) * DM + 16 * lane; buf[i][0] = *(const u32x4*)row; buf[i][1] = *(const u32x4*)(row + 1024); } __builtin_amdgcn_sched_barrier(0); } while (0)
#define PEER_SWEEP(gs, ge, LOADM, COMPM) do { const int gs_ = (gs), ge_ = (ge); \
        if (gs_ < ge_) { const int gl_ = ge_ - 1; \
            LOADM(ba, ena, gs_); LOADM(bb, enb, (gs_ + 1 < ge_ ? gs_ + 1 : gl_)); \
            for (int g = gs_; g < ge_; g += 2) { \
                COMPM(ba, ena); LOADM(ba, ena, (g + 2 < ge_ ? g + 2 : gl_)); \
                if (g + 1 < ge_) COMPM(bb, enb); LOADM(bb, enb, (g + 3 < ge_ ? g + 3 : gl_)); } } } while (0)
#define PEER_LOADU(buf, en, g) PEER_LOADG(buf, en, g, UQ)
#define PEER_COMPU(buf, en) do { int dd[4]; \
        _Pragma("unroll") for (int i = 0; i < 4; ++i) { const int tt_ = (int)((en[i] >> 21) & 3u); \
            const u32x4 x0_ = xqL[(tt_ * 2) * 64 + lane], x1_ = xqL[(tt_ * 2 + 1) * 64 + lane]; int d = 0; \
            d = __builtin_amdgcn_sdot4((int)buf[i][0].x, (int)x0_.x, d, false); d = __builtin_amdgcn_sdot4((int)buf[i][0].y, (int)x0_.y, d, false); \
            d = __builtin_amdgcn_sdot4((int)buf[i][0].z, (int)x0_.z, d, false); d = __builtin_amdgcn_sdot4((int)buf[i][0].w, (int)x0_.w, d, false); \
            d = __builtin_amdgcn_sdot4((int)buf[i][1].x, (int)x1_.x, d, false); d = __builtin_amdgcn_sdot4((int)buf[i][1].y, (int)x1_.y, d, false); \
            d = __builtin_amdgcn_sdot4((int)buf[i][1].z, (int)x1_.z, d, false); d = __builtin_amdgcn_sdot4((int)buf[i][1].w, (int)x1_.w, d, false); \
            dd[i] = d; } \
        const int b16 = (lane >> 4) & 1; \
        int ra, rb, r1; \
        { auto q_ = __builtin_amdgcn_permlane32_swap((unsigned)dd[0], (unsigned)dd[2], false, false); ra = (int)q_[0] + (int)q_[1]; } \
        { auto q_ = __builtin_amdgcn_permlane32_swap((unsigned)dd[1], (unsigned)dd[3], false, false); rb = (int)q_[0] + (int)q_[1]; } \
        { auto q_ = __builtin_amdgcn_permlane16_swap((unsigned)ra, (unsigned)rb, false, false); r1 = (int)q_[0] + (int)q_[1]; } \
        r1 += dppi<DPP_X1>(r1); r1 += dppi<DPP_X2>(r1); r1 += dppi<DPP_HMIR>(r1); r1 += dppi<DPP_MIR>(r1); \
        const int ei = 2 * hi + b16; \
        unsigned em = en[0]; em = (ei == 1) ? en[1] : em; em = (ei == 2) ? en[2] : em; em = (ei == 3) ? en[3] : em; \
        if ((lane & 15) == 0 && !((em >> 23) & 1u)) wl4[((em >> 21) & 3u) * 128 + ((em >> 14) & 127u)] = (float)r1; } while (0)
#define PEER_PD(acc, xa, xb, wh, sel) do { unsigned t_; asm volatile("v_perm_b32 %1, %3, %2, %5\n\tv_dot2c_f32_f16 %0, %4, %1" : "+v"(acc), "=&v"(t_) : "v"(xa), "v"(xb), "v"(wh), "s"(sel)); } while (0)
#define PEER_D4(A, c, j, xa, xb, wh) do { \
        PEER_PD(A[c][4 * (j) + 0], xa, xb, wh, 0x0c040c00u); PEER_PD(A[c][4 * (j) + 1], xa, xb, wh, 0x0c050c01u); \
        PEER_PD(A[c][4 * (j) + 2], xa, xb, wh, 0x0c060c02u); PEER_PD(A[c][4 * (j) + 3], xa, xb, wh, 0x0c070c03u); } while (0)
__device__ __forceinline__ void p_peer_a(const Args& P, LAS char* lds, int gw, int NGW) {
    unsigned char* ws = P.ws;
    const int tid = threadIdx.x, lane0 = tid & 63, wave = __builtin_amdgcn_readfirstlane(tid >> 6);
    const bf16* KEYB = (const bf16*)(ws + WS_KEYB); const bf16* PQ = (const bf16*)(ws + WS_PQ);
    const bf16* H2 = (const bf16*)(ws + WS_H2B); const float* R2 = (const float*)(ws + WS_R2);
    unsigned short* PE = (unsigned short*)(ws + WS_PE); float* PG = (float*)(ws + WS_PG); unsigned char* XQ = ws + WS_XQ8; float* SX = (float*)(ws + WS_SX);
    LAS char* wbase = lds + wave * 17920;
    LAS int* elist = (LAS int*)wbase; LAS float* glist = (LAS float*)(wbase + 2048);
    for (int tile = gw; tile < S_ / 4; tile += NGW) {
        const int t0 = tile * 4;
        peer_retrieve(KEYB, PQ, wbase, t0, lane0);
        int lane = lane0; asm volatile("" : "+v"(lane));
#pragma unroll
        for (int i = 0; i < 1; ++i) {
            const LAS u32x4* ep = (const LAS u32x4*)(elist + 8 * lane); const u32x4 e0 = ep[0], e1 = ep[1];
            const LAS f32x4* gp = (const LAS f32x4*)(glist + 8 * lane); const f32x4 g0 = gp[0], g1 = gp[1];
            *(u32x4*)(PE + (size_t)t0 * 128 + 8 * lane) = (u32x4){(e0.x & 0xffffu) | (e0.y << 16), (e0.z & 0xffffu) | (e0.w << 16), (e1.x & 0xffffu) | (e1.y << 16), (e1.z & 0xffffu) | (e1.w << 16)};
            *(f32x4*)(PG + (size_t)t0 * 128 + 8 * lane) = g0; *(f32x4*)(PG + (size_t)t0 * 128 + 8 * lane + 4) = g1; }
#pragma unroll 1
        for (int tt = 0; tt < 4; ++tt) { const int t = t0 + tt; const float r2 = R2[t]; const float* gf = P.in[23]; f32x4 xv[2][4]; float amax = 0.f;
#pragma unroll
            for (int c = 0; c < 2; ++c)
#pragma unroll
                for (int k2 = 0; k2 < 2; ++k2) { const size_t o = (size_t)1024 * c + 16 * lane + 8 * k2; const u32x4 hq = *(const u32x4*)(H2 + (size_t)t * DM + o);
                    const unsigned hw_[4] = {hq.x, hq.y, hq.z, hq.w};
#pragma unroll
                    for (int kk = 0; kk < 2; ++kk) { const int k = 2 * k2 + kk; const f32x4 gg = *(const f32x4*)(gf + o + 4 * kk);
                        const f32x4 h = {__uint_as_float(hw_[2 * kk] << 16), __uint_as_float(hw_[2 * kk] & 0xffff0000u), __uint_as_float(hw_[2 * kk + 1] << 16), __uint_as_float(hw_[2 * kk + 1] & 0xffff0000u)};
                        xv[c][k] = h * gg * r2; amax = __builtin_elementwise_maximum(amax, __builtin_elementwise_maximum(__builtin_elementwise_maximum(fabsf(xv[c][k].x), fabsf(xv[c][k].y)), __builtin_elementwise_maximum(fabsf(xv[c][k].z), fabsf(xv[c][k].w)))); } }
            amax = wave_max(amax); const float sxv = amax > 0.f ? amax * (1.f / 127.f) : 1.f; const float ix = 1.f / sxv;
            if (lane == 0) SX[t] = sxv;
#pragma unroll
            for (int c = 0; c < 2; ++c) { unsigned q_[4];
#pragma unroll
                for (int k = 0; k < 4; ++k) { const int q0 = (int)rintf(xv[c][k].x * ix), q1 = (int)rintf(xv[c][k].y * ix), q2 = (int)rintf(xv[c][k].z * ix), q3 = (int)rintf(xv[c][k].w * ix);
                    q_[k] = (unsigned)(q0 & 255) | ((unsigned)(q1 & 255) << 8) | ((unsigned)(q2 & 255) << 16) | ((unsigned)(q3 & 255) << 24); }
                *(u32x4*)(XQ + (size_t)t * DM + 1024 * c + 16 * lane) = (u32x4){q_[0], q_[1], q_[2], q_[3]}; } }
        asm volatile("s_waitcnt lgkmcnt(0)" ::: "memory"); __builtin_amdgcn_wave_barrier();
    }
}

__device__ __forceinline__ void p_peer_b(const Args& P, LAS char* lds) {
    unsigned char* ws = P.ws;
    const int tid = threadIdx.x, lane0 = tid & 63, wave = __builtin_amdgcn_readfirstlane(tid >> 6);
    const int x = blockIdx.x & 7, wi = (int)(blockIdx.x >> 3) * NWAVES + wave, NW = (int)(gridDim.x >> 3) * NWAVES;
    const unsigned char* UQ = ws + WS_UQ; const float* USC = (const float*)(ws + WS_USC); const float* VSC = (const float*)(ws + WS_VSC);
    const unsigned short* PE = (const unsigned short*)(ws + WS_PE); const float* PG = (const float*)(ws + WS_PG); float* PW = (float*)(ws + WS_PW);
    const unsigned char* XQ = ws + WS_XQ8; const float* SX = (const float*)(ws + WS_SX);
    LAS char* wbase = lds + wave * 17920;
    LAS unsigned* listbuf = (LAS unsigned*)wbase;
    LAS float* wl4 = (LAS float*)(wbase + 4224);
    LAS float* sxL = (LAS float*)(wbase + 6272);
    LAS u32x4* xqL = (LAS u32x4*)(wbase + 6400);
    const int NT = (S_ / 4 - wi + NW - 1) / NW;
    int lane = lane0; asm volatile("" : "+v"(lane)); const int hi = lane >> 5;
    u32x4 ev1, ev2, xrn[8]; float sxn;
#define PB_LOADEV(dst, i) do { const int tl_ = wi + ((i) < NT ? (i) : NT - 1) * NW; dst = *(const u32x4*)(PE + (size_t)tl_ * 512 + 8 * lane); } while (0)
#define PB_LOADXQ(i) do { const int t0_ = 4 * (wi + ((i) < NT ? (i) : NT - 1) * NW); sxn = SX[t0_ + (lane & 3)]; \
        _Pragma("unroll") for (int tt = 0; tt < 4; ++tt) _Pragma("unroll") for (int cc = 0; cc < 2; ++cc) xrn[tt * 2 + cc] = *(const u32x4*)(XQ + (size_t)(t0_ + tt) * DM + 1024 * cc + 16 * lane); } while (0)
#define PB_COMPACT(ev, lst, valid, TOT, GG) do { \
        unsigned ee[8]; ee[0] = ev.x & 0xffffu; ee[1] = ev.x >> 16; ee[2] = ev.y & 0xffffu; ee[3] = ev.y >> 16; ee[4] = ev.z & 0xffffu; ee[5] = ev.z >> 16; ee[6] = ev.w & 0xffffu; ee[7] = ev.w >> 16; \
        unsigned mm = 0; \
        _Pragma("unroll") for (int j = 0; j < 8; ++j) mm |= (unsigned)((((ee[j] >> 7) + ee[j]) & 7u) == (unsigned)x) << j; \
        mm = (valid) ? mm : 0u; \
        const int c = __builtin_popcount(mm); int incl = c; \
        _Pragma("unroll") for (int o = 1; o < 64; o <<= 1) { const int tv = __shfl_up(incl, o); if (lane >= o) incl += tv; } \
        TOT = __builtin_amdgcn_readlane(incl, 63); \
        { int off = incl - c; \
          _Pragma("unroll") for (int j = 0; j < 8; ++j) if ((mm >> j) & 1u) { lst[off] = ee[j] | ((unsigned)((8 * lane + j) & 127) << 14) | ((unsigned)(lane >> 4) << 21); ++off; } } \
        const int npad = (TOT == 0) ? 8 : ((-TOT) & 7); GG = (TOT + npad) >> 2; \
        if (lane < npad) lst[TOT + lane] = (1u << 23) | (unsigned)x; \
        asm volatile("s_waitcnt lgkmcnt(0)" ::: "memory"); __builtin_amdgcn_wave_barrier(); } while (0)
#define PB_LOADG(buf, en, lst, gi) do { _Pragma("unroll") for (int i = 0; i < 4; ++i) { const unsigned e_ = (unsigned)__builtin_amdgcn_readfirstlane((int)lst[4 * (gi) + i]); en[i] = e_; \
        const unsigned char* row = UQ + (size_t)(e_ & 0x3fffu) * DM + 16 * lane; buf[i][0] = *(const u32x4*)row; buf[i][1] = *(const u32x4*)(row + 1024); } __builtin_amdgcn_sched_barrier(0); } while (0)
    u32x4 ba[4][2], bb[4][2]; unsigned ena[4], enb[4];
    int tot, G;
    PB_LOADEV(ev1, 0); PB_LOADXQ(0); PB_LOADEV(ev2, 1);
    PB_COMPACT(ev1, listbuf, true, tot, G);
    PB_LOADG(ba, ena, listbuf, 0); PB_LOADG(bb, enb, listbuf, 1);
    ev1 = ev2;
#pragma unroll 1
    for (int it = 0; it < NT; ++it) {
        const int t0 = 4 * (wi + it * NW);
        LAS unsigned* cur = listbuf + (it & 1) * 528; LAS unsigned* nxt = listbuf + ((it + 1) & 1) * 528;
#pragma unroll
        for (int i = 0; i < 8; ++i) xqL[i * 64 + lane] = xrn[i];
        if (lane < 4) sxL[lane] = sxn;
        PB_LOADXQ(it + 1); PB_LOADEV(ev2, it + 2);
        __builtin_amdgcn_sched_barrier(0);
        int totn, Gn;
        PB_COMPACT(ev1, nxt, it + 1 < NT, totn, Gn);
        unsigned en_[2]; float ga_[2], us_[2], vs_[2];
#pragma unroll
        for (int q_ = 0; q_ < 2; ++q_) { const int j = lane + 64 * q_; const unsigned e_ = cur[j < tot ? j : 0]; en_[q_] = e_;
            ga_[q_] = PG[(size_t)(t0 + (int)((e_ >> 21) & 3u)) * 128 + ((e_ >> 14) & 127u)]; us_[q_] = USC[e_ & 0x3fffu]; vs_[q_] = VSC[e_ & 0x3fffu]; }
        __builtin_amdgcn_sched_barrier(0);
        for (int g = 0; g < G; g += 2) {
            PEER_COMPU(ba, ena); { const int r_ = g + 2; const bool in_ = r_ < G; LAS unsigned* l_ = in_ ? cur : nxt; const int gi_ = in_ ? r_ : r_ - G; PB_LOADG(ba, ena, l_, gi_); }
            PEER_COMPU(bb, enb); { const int r_ = g + 3; const bool in_ = r_ < G; LAS unsigned* l_ = in_ ? cur : nxt; const int gi_ = in_ ? r_ : r_ - G; PB_LOADG(bb, enb, l_, gi_); }
        }
        asm volatile("s_waitcnt lgkmcnt(0)" ::: "memory"); __builtin_amdgcn_wave_barrier();
#pragma unroll
        for (int q_ = 0; q_ < 2; ++q_) { const int j = lane + 64 * q_; const unsigned e_ = en_[q_]; const int tt = (int)((e_ >> 21) & 3u), k = (int)((e_ >> 14) & 127u);
            if (j < tot) PW[(size_t)(t0 + tt) * 128 + k] = ga_[q_] * gelu_exact(wl4[tt * 128 + k] * (us_[q_] * sxL[tt])) * vs_[q_]; }
        for (int j = lane + 128; j < tot; j += 64) { const unsigned e_ = cur[j]; const int tt = (int)((e_ >> 21) & 3u), k = (int)((e_ >> 14) & 127u);
            PW[(size_t)(t0 + tt) * 128 + k] = PG[(size_t)(t0 + tt) * 128 + k] * gelu_exact(wl4[tt * 128 + k] * (USC[e_ & 0x3fffu] * sxL[tt])) * VSC[e_ & 0x3fffu]; }
        asm volatile("s_waitcnt lgkmcnt(0)" ::: "memory"); __builtin_amdgcn_wave_barrier();
        tot = totn; G = Gn; ev1 = ev2;
    }
#undef PB_LOADEV
#undef PB_LOADXQ
#undef PB_COMPACT
#undef PB_LOADG
}

#ifndef PD_VALU2
#define PD_VALU2 0
#endif
template <unsigned EMASK> __device__ __forceinline__ void p_peer_d(const Args& P, LAS char* lds) {
    unsigned char* ws = P.ws;
    const int tid = threadIdx.x, lane0 = tid & 63, wave = __builtin_amdgcn_readfirstlane(tid >> 6);
    const int x = blockIdx.x & 7, wi = (int)(blockIdx.x >> 3) * NWAVES + wave;
    const unsigned short* PE = (const unsigned short*)(ws + WS_PE); const float* PW = (const float*)(ws + WS_PW);
    const bf16* H2 = (const bf16*)(ws + WS_H2B); float* SSP = (float*)(ws + WS_SSP);
    LAS char* wbase = lds + wave * 17920;
    LAS unsigned* lb = (LAS unsigned*)(wbase + 16384);
    int lane = lane0; asm volatile("" : "+v"(lane));
    const int g = lane >> 4, l16 = lane & 15;
    const unsigned char* VSu = ws + WS_VQS + (size_t)x * (4 * MiB);
    const unsigned l16b = 16u * (unsigned)l16;
    const int tb = wi * 32;
    float acc[1][16], accz[1][16];
#pragma unroll
    for (int j = 0; j < 16; ++j) { acc[0][j] = 0.f; accz[0][j] = 0.f; }
    unsigned short pe0, pe1; float pw0, pw1; u32x2 ph;
    u32x2 hcur; float sumw_cur, sumw_nxt;
#define PD_LOAD(n) do { const int t_ = tb + ((n) < 32 ? (n) : 31); pe0 = PE[(size_t)t_ * 128 + lane]; pe1 = PE[(size_t)t_ * 128 + 64 + lane]; pw0 = PW[(size_t)t_ * 128 + lane]; pw1 = PW[(size_t)t_ * 128 + 64 + lane]; \
        ph = *(const u32x2*)(H2 + (size_t)t_ * DM + 256 * x + 16 * l16 + 4 * g); } while (0)
#define PD_STORE(b) do { sumw_nxt = wave_sum(pw0 + pw1); const h2_t w2_ = {(_Float16)(pw0 * 256.f), (_Float16)(pw1 * 256.f)}; \
        lb[(b) * 192 + lane] = ((unsigned)pe0 & EMASK) << 8; lb[(b) * 192 + 64 + lane] = ((unsigned)pe1 & EMASK) << 8; lb[(b) * 192 + 128 + lane] = __builtin_bit_cast(unsigned, w2_); \
        asm volatile("s_waitcnt lgkmcnt(0)" ::: "memory"); __builtin_amdgcn_wave_barrier(); } while (0)
    u32x4 ra[8], rb[8]; unsigned rw[8];
#define PD_STEP(s, b, i, DO_CONSUME) do { const int ix_ = (b) * 192 + 4 * (i) + g; const unsigned oa_ = lb[ix_], ob_ = lb[ix_ + 64], wn_ = lb[ix_ + 128]; \
        if (DO_CONSUME && PD_VALU2 && EMASK != 0xffffu) { PEER_D4(accz, 0, 0, ra[s].x, rb[s].x, rw[s]); PEER_D4(accz, 0, 1, ra[s].y, rb[s].y, rw[s]); PEER_D4(accz, 0, 2, ra[s].z, rb[s].z, rw[s]); PEER_D4(accz, 0, 3, ra[s].w, rb[s].w, rw[s]); } \
        if (DO_CONSUME) { PEER_D4(acc, 0, 0, ra[s].x, rb[s].x, rw[s]); PEER_D4(acc, 0, 1, ra[s].y, rb[s].y, rw[s]); PEER_D4(acc, 0, 2, ra[s].z, rb[s].z, rw[s]); PEER_D4(acc, 0, 3, ra[s].w, rb[s].w, rw[s]); } \
        ra[s] = *(const u32x4*)(VSu + (oa_ | l16b)); rb[s] = *(const u32x4*)(VSu + (ob_ | l16b)); rw[s] = wn_; __builtin_amdgcn_sched_barrier(0); } while (0)
    PD_LOAD(0); PD_STORE(0); sumw_cur = sumw_nxt; hcur = ph;
#pragma unroll
    for (int s = 0; s < 8; ++s) PD_STEP(s, 0, s, false);
#pragma unroll 1
    for (int n = 0; n < 32; ++n) {
        const int b = n & 1;
        PD_LOAD(n + 1);
        __builtin_amdgcn_sched_barrier(0);
#pragma unroll
        for (int s = 0; s < 8; ++s) PD_STEP(s, b, 8 + s, true);
        PD_STORE(b ^ 1);
#pragma unroll
        for (int s = 0; s < 8; ++s) PD_STEP(s, b ^ 1, s, true);
        { const int t = tb + n; const float off = 128.f * sumw_cur; float u8[8], v[4];
#pragma unroll
          for (int j = 0; j < 8; ++j) { auto q_ = __builtin_amdgcn_permlane32_swap(__float_as_uint(acc[0][j]), __float_as_uint(acc[0][j + 8]), false, false); u8[j] = __uint_as_float(q_[0]) + __uint_as_float(q_[1]); acc[0][j] = 0.f; acc[0][j + 8] = 0.f; }
#pragma unroll
          for (int j = 0; j < 4; ++j) { auto q_ = __builtin_amdgcn_permlane16_swap(__float_as_uint(u8[j]), __float_as_uint(u8[j + 4]), false, false); v[j] = (__uint_as_float(q_[0]) + __uint_as_float(q_[1])) * 65536.f - off; }
          v[0] += __uint_as_float(hcur.x << 16); v[1] += __uint_as_float(hcur.x & 0xffff0000u); v[2] += __uint_as_float(hcur.y << 16); v[3] += __uint_as_float(hcur.y & 0xffff0000u);
          float ss = (v[0] * v[0] + v[1] * v[1]) + (v[2] * v[2] + v[3] * v[3]);
          ss = wave_sum(ss);
          if (lane == 0) SSP[(size_t)x * S_ + t] = ss;
          const h2_t a_ = {(_Float16)v[0], (_Float16)v[1]}, b_ = {(_Float16)v[2], (_Float16)v[3]};
          *(LAS u32x2*)(wbase + (size_t)(n * 256 + 16 * l16 + 4 * g) * 2) = (u32x2){__builtin_bit_cast(unsigned, a_), __builtin_bit_cast(unsigned, b_)};
          sumw_cur = sumw_nxt; hcur = ph; }
    }
#undef PD_LOAD
#undef PD_STORE
#undef PD_STEP
    asm volatile("s_waitcnt vmcnt(0) lgkmcnt(0)" ::: "memory"); __builtin_amdgcn_wave_barrier();
}

__device__ __forceinline__ void p_peer_e(const Args& P, LAS char* lds) {
    unsigned char* ws = P.ws;
    const int tid = threadIdx.x, lane = tid & 63, wave = __builtin_amdgcn_readfirstlane(tid >> 6);
    const int x = blockIdx.x & 7, wi = (int)(blockIdx.x >> 3) * NWAVES + wave, tb = wi * 32;
    const float* SSP = (const float*)(ws + WS_SSP);
    LAS char* wbase = lds + wave * 17920;
    float s = 0.f;
#pragma unroll
    for (int q = 0; q < 8; ++q) s += SSP[(size_t)q * S_ + tb + (lane & 31)];
    const float rrv = rsqrtf(s * (1.f / DM) + EPS);
    const f32x4 gg = *(const f32x4*)(P.in[29] + 256 * x + 4 * lane);
#pragma unroll 4
    for (int n = 0; n < 32; ++n) { const float rr = __shfl(rrv, n);
        const u32x2 hs = *(const LAS u32x2*)(wbase + (size_t)(n * 256 + 4 * lane) * 2);
        const unsigned s0_ = hs.x, s1_ = hs.y; const h2_t a_ = __builtin_bit_cast(h2_t, s0_); const h2_t b_ = __builtin_bit_cast(h2_t, s1_);
        const f32x4 ov = {(float)a_.x * rr * gg.x, (float)a_.y * rr * gg.y, (float)b_.x * rr * gg.z, (float)b_.y * rr * gg.w};
        *(f32x4*)(P.out + (size_t)(tb + n) * DM + 256 * x + 4 * lane) = ov; }
}
#undef PEER_LOADG
#undef PEER_SWEEP
#undef PEER_LOADU
#undef PEER_COMPU
#undef PEER_PD
#undef PEER_D4
constexpr int NS_KS = 144, NS_VS = 192, NS_VOFF = 64 * NS_KS, NS_BUF = NS_VOFF + 64 * NS_VS;
constexpr int NS_IMP_OFF = 2 * NS_BUF;
constexpr int NS_OACC_OFF = NS_IMP_OFF + 32768;
struct KVStage { u32x4 k, v; };
template <class TileF>
__device__ __forceinline__ void kv_tile_loop(const bf16* Kg, const bf16* Vg, int g, int kt_lo, int kt_hi, LAS char* lds, TileF f) {
    if (kt_lo >= kt_hi) return;
    int tid = threadIdx.x; asm volatile("" : "+v"(tid));
    const int kkey = tid >> 3, kc = tid & 7;
    const size_t soff = (size_t)kkey * 256 + g * 64 + kc * 8; const int kdst = kkey * NS_KS + kc * 16, vdst = NS_VOFF + kkey * NS_VS + kc * 16;
    KVStage sA, sB;
#define KV_LOAD(S, kt) do { S.k = *(const u32x4*)(Kg + (size_t)(kt) * 64 * 256 + soff); S.v = *(const u32x4*)(Vg + (size_t)(kt) * 64 * 256 + soff); } while (0)
#define KV_STORE(S, b) do { LAS char* nb_ = lds + (b) * NS_BUF; *(LAS u32x4*)(nb_ + kdst) = S.k; *(LAS u32x4*)(nb_ + vdst) = S.v; } while (0)
#define KV_ITER(kt, S, nb) do { f((kt), (const LAS char*)(lds + ((nb) ^ 1) * NS_BUF)); if ((kt) + 1 < kt_hi) KV_STORE(S, nb); if ((kt) + 3 < kt_hi) KV_LOAD(S, (kt) + 3); LDS_BARRIER(); } while (0)
    KV_LOAD(sA, kt_lo); KV_STORE(sA, 0);
    if (kt_lo + 1 < kt_hi) KV_LOAD(sB, kt_lo + 1);
    if (kt_lo + 2 < kt_hi) KV_LOAD(sA, kt_lo + 2);
    LDS_BARRIER();
    for (int kt = kt_lo; kt < kt_hi; kt += 2) { KV_ITER(kt, sB, 1); if (kt + 1 < kt_hi) KV_ITER(kt + 1, sA, 0); }
#undef KV_LOAD
#undef KV_STORE
#undef KV_ITER
}
__device__ __forceinline__ void nsa_unit(const Args& a, int g, int qt, LAS char* lds) {
    unsigned char* ws = a.ws;
    const int tid = threadIdx.x, lane = tid & 63, w = __builtin_amdgcn_readfirstlane(tid >> 6), r32 = lane & 31, hi = lane >> 5;
    const int tokl = r32 >> 2, hh = r32 & 3, t = 64 * qt + 8 * w + tokl, cur = qt;
    const bf16* NQ = (const bf16*)(ws + WS_NQ);
    const bf16* KCb = (const bf16*)(ws + WS_KC); const bf16* VCb = (const bf16*)(ws + WS_VC);
    const bf16* KSEL = (const bf16*)(ws + WS_KV6 + 2 * 4 * MiB); const bf16* VSEL = (const bf16*)(ws + WS_KV6 + 3 * 4 * MiB);
    const bf16* KWIN = (const bf16*)(ws + WS_KV6 + 4 * 4 * MiB); const bf16* VWIN = (const bf16*)(ws + WS_KV6 + 5 * 4 * MiB);
    const float* NG = (const float*)(ws + WS_NG) + (size_t)t * 48 + (g * 4 + hh) * 3;
    bf16x8 qf[4];
#pragma unroll
    for (int ks = 0; ks < 4; ++ks) qf[ks] = *(const bf16x8*)(NQ + (size_t)t * 1024 + (g * 4 + hh) * 64 + 16 * ks + 8 * hi);
    LAS float* oaccL = (LAS float*)(lds + NS_OACC_OFF) + w * 2048 + lane;
    LAS float* imp = (LAS float*)(lds + NS_IMP_OFF) + w * 1024 + tokl * 128;

    {
        const int cnt = t >= 31 ? ((t - 31) >> 4) + 1 : 0;
        int cmax = 4 * qt + 3; cmax = cmax > 511 ? 511 : cmax;
        const int ntc = (cmax + 63) >> 6;
        float mc = -INFINITY, lc = 0.f; f32x16 zero16;
#pragma unroll
        for (int r = 0; r < 16; ++r) zero16[r] = 0.f;
        kv_tile_loop(KCb, VCb, g, 0, ntc, lds, [&](int kt, const LAS char* buf) {
            f32x16 p0, p1; qk_scores<64, NS_KS>(qf, buf, lane, zero16, p0, p1);
#pragma unroll
            for (int r = 0; r < 16; ++r) { const int n = 64 * kt + crow(r, hi); if (n >= cnt) p0[r] = -INFINITY; if (n + 32 >= cnt) p1[r] = -INFINITY; }
            const float mx = tile_colmax(p0, p1); const float mnew = __builtin_elementwise_maximum(mc, mx); const float msafe = (mnew == -INFINITY) ? 0.f : mnew;
            float ps = 0.f;
#pragma unroll
            for (int r = 0; r < 16; ++r) ps += fexp2(p0[r] - msafe) + fexp2(p1[r] - msafe);
            lc = lc * fexp2(mc - msafe) + ps; mc = mnew; });
        lc = sum_x32(lc);
        const float invl = lc > 0.f ? 1.f / lc : 0.f; const float msafe = (mc == -INFINITY) ? 0.f : mc;
#pragma unroll
        for (int i = 0; i < 16; ++i) ((LAS float*)(lds + NS_IMP_OFF) + w * 1024)[lane + 64 * i] = 0.f;
        asm volatile("s_waitcnt lgkmcnt(0)" ::: "memory"); __builtin_amdgcn_wave_barrier();
        f32x16 oc[2];
#pragma unroll
        for (int d = 0; d < 2; ++d)
#pragma unroll
            for (int r = 0; r < 16; ++r) oc[d][r] = 0.f;
        kv_tile_loop(KCb, VCb, g, 0, ntc, lds, [&](int kt, const LAS char* buf) {
            f32x16 p0, p1; qk_scores<64, NS_KS>(qf, buf, lane, zero16, p0, p1);
#pragma unroll
            for (int r = 0; r < 16; ++r) { const int n = 64 * kt + crow(r, hi); p0[r] = (n >= cnt) ? 0.f : fexp2(p0[r] - msafe) * invl; p1[r] = (n + 32 >= cnt) ? 0.f : fexp2(p1[r] - msafe) * invl; }
#pragma unroll
            for (int c = 0; c < 4; ++c) {
                float s0 = (p0[4 * c] + p0[4 * c + 1]) + (p0[4 * c + 2] + p0[4 * c + 3]), s1 = (p1[4 * c] + p1[4 * c + 1]) + (p1[4 * c + 2] + p1[4 * c + 3]);
                s0 += dppf<DPP_X1>(s0); s0 += dppf<DPP_X2>(s0); s1 += dppf<DPP_X1>(s1); s1 += dppf<DPP_X2>(s1);
                if (hh == 0) { imp[16 * kt + 2 * c + hi] = s0; imp[16 * kt + 8 + 2 * c + hi] = s1; } }
            pv_accum<64, NS_VS>(oc, p0, p1, buf + NS_VOFF, lane); });
        const float gc = NG[0];
#pragma unroll
        for (int d = 0; d < 2; ++d)
#pragma unroll
            for (int r = 0; r < 16; ++r) oaccL[(16 * d + r) * 64] = gc * oc[d][r];
    }
    unsigned long long sel_lo = 0ull, sel_hi = 0ull;
    {
        asm volatile("s_waitcnt lgkmcnt(0)" ::: "memory"); __builtin_amdgcn_wave_barrier();
        const int s8 = hh + 4 * hi;
        float vals[16];
#pragma unroll
        for (int i = 0; i < 16; ++i) { const int j = s8 + 8 * i; const bool forced = (j == 0) || (j == cur) || (j == cur - 1);
            vals[i] = (j <= cur) ? imp[j] + (forced ? 100.f : 0.f) : -INFINITY; }
        unsigned lsel = 0u;
#pragma unroll 1
        for (int it = 0; it < 16; ++it) {
            float lm = vals[0];
#pragma unroll
            for (int i = 1; i < 16; ++i) lm = __builtin_elementwise_maximum(lm, vals[i]);
            float gm = __builtin_elementwise_maximum(lm, dppf<DPP_X1>(lm)); gm = __builtin_elementwise_maximum(gm, dppf<DPP_X2>(gm)); gm = max_x32(gm);
            int cand = (lm == gm && gm > -INFINITY) ? s8 : 99;
            int mn = min(cand, dppi<DPP_X1>(cand)); mn = min(mn, dppi<DPP_X2>(mn)); { auto r_ = __builtin_amdgcn_permlane32_swap((unsigned)mn, (unsigned)mn, false, false); mn = min((int)r_[0], (int)r_[1]); }
            const bool win = (s8 == mn); bool found = false;
#pragma unroll
            for (int i = 0; i < 16; ++i) { const bool hit = win && !found && vals[i] == gm; if (hit) { vals[i] = -INFINITY; lsel |= 1u << i; found = true; } }
        }
#pragma unroll
        for (int k = 0; k < 4; ++k) { unsigned wv = 0u;
#pragma unroll
            for (int i = 0; i < 4; ++i) wv |= ((lsel >> (4 * k + i)) & 1u) << (s8 + 8 * i);
            wv |= (unsigned)dppi<DPP_X1>((int)wv); wv |= (unsigned)dppi<DPP_X2>((int)wv); { auto r_ = __builtin_amdgcn_permlane32_swap(wv, wv, false, false); wv = r_[0] | r_[1]; }
            if (k == 0) sel_lo |= (unsigned long long)wv; if (k == 1) sel_lo |= (unsigned long long)wv << 32; if (k == 2) sel_hi |= (unsigned long long)wv; if (k == 3) sel_hi |= (unsigned long long)wv << 32; }
    }
    {
        Flash<64> f; flash_init(f);
        kv_tile_loop(KSEL, VSEL, g, 0, cur + 1, lds, [&](int j, const LAS char* buf) {
            const unsigned long long wsel = j < 64 ? sel_lo : sel_hi;
            const bool sel = (wsel >> (j & 63)) & 1ull;
            if (__ballot(sel) != 0ull) {
                flash_tile<64, 64, NS_KS, NS_VS, true>(f, qf, buf, buf + NS_VOFF, lane, sel, [&](f32x16& p0, f32x16& p1) {
                    if (j == cur) {
#pragma unroll
                        for (int r = 0; r < 16; ++r) { const int key = 64 * j + crow(r, hi); if (key > t) p0[r] = -INFINITY; if (key + 32 > t) p1[r] = -INFINITY; }
                    } });
            } });
        const float l = sum_x32(f.l); const float gs = NG[1] * (l > 0.f ? 1.f / l : 0.f);
#pragma unroll
        for (int d = 0; d < 2; ++d)
#pragma unroll
            for (int r = 0; r < 16; ++r) oaccL[(16 * d + r) * 64] += gs * f.o[d][r];
    }
    {
        Flash<64> f; flash_init(f);
        const int kt_lo = qt >= 8 ? qt - 8 : 0;
        kv_tile_loop(KWIN, VWIN, g, kt_lo, qt + 1, lds, [&](int kt, const LAS char* buf) {
            const bool edge = (kt == qt) || (kt + 8 == qt);
            flash_tile<64, 64, NS_KS, NS_VS, false>(f, qf, buf, buf + NS_VOFF, lane, true, [&](f32x16& p0, f32x16& p1) {
                if (edge) {
#pragma unroll
                    for (int r = 0; r < 16; ++r) { const int key = 64 * kt + crow(r, hi); if (key > t || key + 511 < t) p0[r] = -INFINITY; if (key + 32 > t || key + 32 + 511 < t) p1[r] = -INFINITY; }
                } }); });
        const float l = sum_x32(f.l); const float gw = NG[2] * (l > 0.f ? 1.f / l : 0.f);
        bf16* ONSA = (bf16*)(ws + WS_ONSA);
#pragma unroll
        for (int d = 0; d < 2; ++d)
#pragma unroll
            for (int r4 = 0; r4 < 4; r4 += 2) { u32x2 o2[2];
#pragma unroll
                for (int q = 0; q < 2; ++q) { float v[4];
#pragma unroll
                    for (int e = 0; e < 4; ++e) v[e] = oaccL[(16 * d + 4 * (r4 + q) + e) * 64] + gw * f.o[d][4 * (r4 + q) + e];
                    o2[q].x = pk2(v[0], v[1]); o2[q].y = pk2(v[2], v[3]); }
                *(u32x4*)(ONSA + (size_t)t * 1024 + (g * 4 + hh) * 64 + 32 * d + 8 * r4 + 8 * hi) = t21_pair(o2[0], o2[1]); }
    }
}
typedef float f32x4v __attribute__((ext_vector_type(4)));
__device__ __forceinline__ void compress_unit(const Args& P, int rg, LAS char* lds) {
    unsigned char* ws = P.ws;
    const int tid = threadIdx.x, lane = tid & 63, w = __builtin_amdgcn_readfirstlane(tid >> 6);
    const int which = rg & 1, g = (rg >> 1) & 3, nb = rg >> 3, n0 = 16 * nb;
    const bf16* src = (const bf16*)(ws + WS_KV6 + (size_t)which * 4 * MiB);
    const bf16* w1t = (const bf16*)(ws + WS_W1C) + (size_t)which * 128 * 2048;
    const float* cpos = (const float*)(ws + WS_CPOS) + which * 128;
    const float* w2 = which ? P.in[14] : P.in[12];
    const int i16 = lane & 15, kg = lane >> 4;
    LAS char* aL = lds + 40960;
    const int iblk = (n0 + i16 > 510) ? 510 - n0 : i16;
    u32x4 ar[5];
#pragma unroll
    for (int r = 0; r < 5; ++r) { const int idx = tid + 512 * r, tau = idx >> 3, ch = idx & 7; int ta = 16 * n0 + tau; ta = ta > S_ - 1 ? S_ - 1 : ta;
        ar[r] = *(const u32x4*)(src + (size_t)ta * 256 + g * 64 + ch * 8); }
    const bf16* brow = w1t + (size_t)(16 * w + i16) * 32 + 8 * kg;
    f32x4 w2r[4];
#pragma unroll
    for (int i = 0; i < 4; ++i) w2r[i] = *(const f32x4*)(w2 + (size_t)(i * 512 + tid) * 4);
    f32x4v acc = {0.f, 0.f, 0.f, 0.f};
    bf16x8 bwA[8], bwB[8];
#define CU_LOAD(BW, bt) do { _Pragma("unroll") for (int i = 0; i < 8; ++i) BW[i] = *(const bf16x8*)(brow + (size_t)(8 * (bt) + i) * 4096); } while (0)
#define CU_MMA(BW, bt) do { _Pragma("unroll") for (int i = 0; i < 8; ++i) { const int ks = 8 * (bt) + i, c = ks >> 1, j = iblk + (c >> 4); \
        const bf16x8 av = *(const LAS bf16x8*)(aL + ((c & 15) * 17 + j) * 128 + 16 * ((4 * (ks & 1) + kg) ^ (j & 7))); \
        acc = __builtin_amdgcn_mfma_f32_16x16x32_bf16(BW[i], av, acc, 0, 0, 0); } } while (0)
    CU_LOAD(bwA, 0);
#pragma unroll
    for (int r = 0; r < 5; ++r) { const int idx = tid + 512 * r, tau = idx >> 3, ch = idx & 7; if (idx < 272 * 8) *(LAS u32x4*)(aL + ((tau & 15) * 17 + (tau >> 4)) * 128 + 16 * (ch ^ ((tau >> 4) & 7))) = ar[r]; }
    __syncthreads();
#pragma unroll
    for (int bt = 0; bt < 8; bt += 2) {
        CU_LOAD(bwB, bt + 1); __builtin_amdgcn_sched_barrier(0); CU_MMA(bwA, bt); __builtin_amdgcn_sched_barrier(0);
        if (bt + 2 < 8) CU_LOAD(bwA, bt + 2);
        __builtin_amdgcn_sched_barrier(0); CU_MMA(bwB, bt + 1); __builtin_amdgcn_sched_barrier(0);
    }
#undef CU_LOAD
#undef CU_MMA
    LAS float* hid = (LAS float*)lds;
    LAS float* w2L = (LAS float*)(lds + 8192);
#pragma unroll
    for (int e = 0; e < 4; ++e) { const int col = 16 * w + 4 * kg + e; hid[i16 * 128 + col] = gelu_exact(acc[e] + cpos[col]); }
#pragma unroll
    for (int i = 0; i < 4; ++i) *(LAS f32x4*)(w2L + (i * 512 + tid) * 4) = w2r[i];
    __syncthreads();
    { const int nl = tid >> 5, d = (tid & 31) * 2; float o0 = 0.f, o1 = 0.f;
#pragma unroll 16
      for (int hh = 0; hh < 128; ++hh) { const float hv = hid[nl * 128 + hh]; const f32x2_t wv = *(const LAS f32x2_t*)(w2L + hh * 64 + d); o0 += hv * wv.x; o1 += hv * wv.y; }
      if (n0 + nl < 511) *(unsigned*)((bf16*)(ws + (which ? WS_VC : WS_KC)) + (size_t)(n0 + nl) * 256 + g * 64 + d) = pk2(o0, o1); }
    __syncthreads();
}

struct EpiZ {
    static constexpr bool PERM = true, AFTER_DRAIN = false, CHAIN = false; unsigned char* ws;
    template <int KIND>
    __device__ __forceinline__ void body(const pg8::f32x4 (&acc)[2][2][4][2], const pg8::Unit& u, int wr, int wc, int fr, int fq, bf16* dst, int ld, int cbase, float scale) const {
        const int pn = u.pn;
        const float* COS = (const float*)(ws + WS_COS); const float* SIN = (const float*)(ws + WS_SIN);
        const bool ropelane = ((wc & 1) == 0) && (fq < 2); const float sg = (fq == 0) ? -1.f : 1.f;
#pragma unroll
        for (int ai = 0; ai < 2; ++ai)
#pragma unroll
            for (int m = 0; m < 4; ++m) { const int row = u.pm * 256 + ai * 128 + wr * 64 + m * 16 + fr;
                f32x4 c0, c1, s0, s1;
                if constexpr (KIND == 1) { c0 = *(const f32x4*)(COS + row * 8); c1 = *(const f32x4*)(COS + row * 8 + 4); s0 = *(const f32x4*)(SIN + row * 8); s1 = *(const f32x4*)(SIN + row * 8 + 4); }
#pragma unroll
                for (int bj = 0; bj < 2; ++bj) { f32x4 v0 = acc[ai][bj][m][0], v1 = acc[ai][bj][m][1];
                    const int c8 = pn * 256 + bj * 128 + wc * 32 + 8 * fq;
                    if constexpr (KIND == 1) {
                        f32x4 o0, o1;
#define XR16(x) ([&]() { auto r_ = __builtin_amdgcn_permlane16_swap(__float_as_uint(x), __float_as_uint(x), false, false); return __uint_as_float((fq & 1) ? r_[0] : r_[1]); }())
                        o0.x = XR16(v0.x); o0.y = XR16(v0.y); o0.z = XR16(v0.z); o0.w = XR16(v0.w);
                        o1.x = XR16(v1.x); o1.y = XR16(v1.y); o1.z = XR16(v1.z); o1.w = XR16(v1.w);
#undef XR16
                        const f32x4 r0 = v0 * c0 + o0 * s0 * sg, r1 = v1 * c1 + o1 * s1 * sg;
                        v0 = ropelane ? r0 : v0; v1 = ropelane ? r1 : v1;
                    }
                    if constexpr (KIND == 3) {
                        const int c = c8 - 9728;
                        if (c < 48) { float* ng = (float*)(ws + WS_NG) + (size_t)row * 48 + c;
                            f32x4 a = {sigmoidf_(v0.x), sigmoidf_(v0.y), sigmoidf_(v0.z), sigmoidf_(v0.w)}, b = {sigmoidf_(v1.x), sigmoidf_(v1.y), sigmoidf_(v1.z), sigmoidf_(v1.w)};
                            *(f32x4*)ng = a; *(f32x4*)(ng + 4) = b; }
                    } else {
                        if constexpr (KIND == 2) { v0 = (f32x4){sigmoidf_(v0.x), sigmoidf_(v0.y), sigmoidf_(v0.z), sigmoidf_(v0.w)}; v1 = (f32x4){sigmoidf_(v1.x), sigmoidf_(v1.y), sigmoidf_(v1.z), sigmoidf_(v1.w)}; }
                        else { v0 = v0 * scale; v1 = v1 * scale; }
                        u32x4 o; o.x = pk2(v0.x, v0.y); o.y = pk2(v0.z, v0.w); o.z = pk2(v1.x, v1.y); o.w = pk2(v1.z, v1.w);
                        *(u32x4*)(dst + (size_t)row * ld + (c8 - cbase)) = o;
                    } } }
    }
    __device__ __forceinline__ void operator()(const pg8::f32x4 (&acc)[2][2][4][2], const pg8::Unit& u, int wr, int wc, int fr, int fq) const {
        const int pn = u.pn;
        bf16* dst; int ld, cbase; bool rope = false; float scale = 1.f;
        if (pn < 4) { dst = (bf16*)(ws + WS_QDA); ld = 1024; cbase = 0; rope = true; scale = QSCALE; }
        else if (pn < 8) { dst = (bf16*)(ws + WS_KDA); ld = 1024; cbase = 1024; rope = true; }
        else if (pn < 12) { dst = (bf16*)(ws + WS_VDA); ld = 1024; cbase = 2048; }
        else if (pn < 16) { dst = (bf16*)(ws + WS_NQ); ld = 1024; cbase = 3072; rope = true; scale = QSCALE; }
        else if (pn < 22) { const int j = pn - 16; dst = (bf16*)(ws + WS_KV6 + (size_t)j * 4 * MiB); ld = 256; cbase = 4096 + 256 * j; rope = (j & 1) == 0; }
        else { dst = (bf16*)(ws + WS_BG); ld = 4096; cbase = 5632; }
        if (pn == 38) body<3>(acc, u, wr, wc, fr, fq, dst, ld, cbase, scale);
        else if (pn >= 22) body<2>(acc, u, wr, wc, fr, fq, dst, ld, cbase, scale);
        else if (rope) body<1>(acc, u, wr, wc, fr, fq, dst, ld, cbase, scale);
        else body<0>(acc, u, wr, wc, fr, fq, dst, ld, cbase, scale);
    }
};

constexpr int XA_KS = 272, XA_VS = 320, XA_VOFF = 64 * XA_KS;
__device__ __forceinline__ void xattn_unit(const Args& P, int h, int qb, LAS char* lds) {
    unsigned char* ws = P.ws;
    const int tid = threadIdx.x, lane = tid & 63, w = __builtin_amdgcn_readfirstlane(tid >> 6), r32 = lane & 31, hi = lane >> 5;
    const bf16* QX = (const bf16*)(ws + WS_QX); const bf16* KVM = (const bf16*)(ws + WS_KVM); bf16* OX = (bf16*)(ws + WS_OX);
    const int q = 256 * qb + 32 * w + r32;
    bf16x8 qf[8];
#pragma unroll
    for (int ks = 0; ks < 8; ++ks) qf[ks] = *(const bf16x8*)(QX + (size_t)q * 512 + h * 128 + 16 * ks + 8 * hi);
    Flash<128> f; flash_init(f);
    u32x4 kr[2], vr[2];
#define XA_LOAD(kt) do { _Pragma("unroll") for (int i = 0; i < 2; ++i) { const int idx = tid + 512 * i, key = idx >> 4, c = idx & 15; const bf16* r = KVM + (size_t)(64 * (kt) + key) * 1024 + h * 128 + c * 8; \
        kr[i] = *(const u32x4*)r; vr[i] = *(const u32x4*)(r + 512); } } while (0)
    XA_LOAD(0);
#pragma unroll
    for (int kt = 0; kt < 4; ++kt) {
#pragma unroll
        for (int i = 0; i < 2; ++i) { const int idx = tid + 512 * i, key = idx >> 4, c = idx & 15;
            *(LAS u32x4*)(lds + key * XA_KS + c * 16) = kr[i]; *(LAS u32x4*)(lds + XA_VOFF + key * XA_VS + c * 16) = vr[i]; }
        __syncthreads();
        if (kt + 1 < 4) XA_LOAD(kt + 1);
        flash_tile<128, 128, XA_KS, XA_VS, false>(f, qf, lds, lds + XA_VOFF, lane, true, [](f32x16&, f32x16&) {});
        __syncthreads();
    }
#undef XA_LOAD
    const float l = sum_x32(f.l); const float inv = 1.f / l;
#pragma unroll
    for (int d = 0; d < 4; ++d)
#pragma unroll
        for (int r4 = 0; r4 < 4; r4 += 2) { u32x2 o2[2];
#pragma unroll
            for (int q = 0; q < 2; ++q) { o2[q].x = pk2(f.o[d][4 * (r4 + q)] * inv, f.o[d][4 * (r4 + q) + 1] * inv); o2[q].y = pk2(f.o[d][4 * (r4 + q) + 2] * inv, f.o[d][4 * (r4 + q) + 3] * inv); }
            *(u32x4*)(OX + (size_t)q * 512 + h * 128 + 32 * d + 8 * r4 + 8 * hi) = t21_pair(o2[0], o2[1]); }
}
__device__ __forceinline__ void phase0(const Args& a, LAS char* lds) {
    const int tid = threadIdx.x, lane = tid & 63, wave = __builtin_amdgcn_readfirstlane(tid >> 6); const int G = gridDim.x, bx = blockIdx.x;
    const int gw = bx * NWAVES + wave, NGW = G * NWAVES, gt = bx * 512 + tid, NGT = G * 512; unsigned char* ws = a.ws;
    LAS unsigned char* ring = (LAS unsigned char*)lds; LAS float* rtab = (LAS float*)(lds + RTAB_OFF);
    (void)lane; (void)gw; (void)NGW; (void)gt; (void)NGT; (void)ring; (void)rtab; (void)ws;
 p_prologue(a, lds, gw, NGW, gt, NGT);
        cvt_f32_bf16(a.in[25], (bf16*)(ws + WS_KEYB), 128 * 128, gt, NGT); cvt_f32_bf16(a.in[26], (bf16*)(ws + WS_KEYB) + 128 * 128, 128 * 128, gt, NGT);
}
__device__ __forceinline__ void phase1(const Args& a, LAS char* lds) {
    const int tid = threadIdx.x, lane = tid & 63, wave = __builtin_amdgcn_readfirstlane(tid >> 6); const int G = gridDim.x, bx = blockIdx.x;
    const int gw = bx * NWAVES + wave, NGW = G * NWAVES, gt = bx * 512 + tid, NGT = G * 512; unsigned char* ws = a.ws;
    LAS unsigned char* ring = (LAS unsigned char*)lds; LAS float* rtab = (LAS float*)(lds + RTAB_OFF);
    (void)lane; (void)gw; (void)NGW; (void)gt; (void)NGT; (void)ring; (void)rtab; (void)ws;

        { pg8::Gemm g{(const bf16*)(ws + WS_XN), (const bf16*)(ws + WS_W1T), S_, NZ, 2048}; pg8::StaticOrder S; S.init(S_, NZ, G, bx);
          EpiZ E{ws};
          pg8::gemm_phase<EpiZ, pg8::StaticOrder, true, true>(ring, g, S, E); }
        { pg8::Gemm g{(const bf16*)(ws + WS_MEMN), (const bf16*)(ws + WS_WXKV), MEML, 1024, 2048}; pg8::StaticOrder S; S.init(MEML, 1024, G, (bx + 4) % G);
          EpiFn8<FStoreBf16x8> E{FStoreBf16x8{(bf16*)(ws + WS_KVM), 1024}};
          pg8::gemm_phase<EpiFn8<FStoreBf16x8>, pg8::StaticOrder, false, true>(ring, g, S, E); }

}
__device__ __forceinline__ void phase2(const Args& a, LAS char* lds) {
    const int tid = threadIdx.x, lane = tid & 63, wave = __builtin_amdgcn_readfirstlane(tid >> 6); const int G = gridDim.x, bx = blockIdx.x;
    const int gw = bx * NWAVES + wave, NGW = G * NWAVES, gt = bx * 512 + tid, NGT = G * 512; unsigned char* ws = a.ws;
    LAS unsigned char* ring = (LAS unsigned char*)lds; LAS float* rtab = (LAS float*)(lds + RTAB_OFF);
    (void)lane; (void)gw; (void)NGW; (void)gt; (void)NGT; (void)ring; (void)rtab; (void)ws;

        for (int u = bx; u < 256; u += G) compress_unit(a, u, lds);
        for (int u = bx; u < 256; u += G) { const int h = u & 7, p = u >> 3; da_unit(a, h, 63 - p, lds); da_unit(a, h, p, lds); }

}
__device__ __forceinline__ void phase3(const Args& a, LAS char* lds) {
    const int tid = threadIdx.x, lane = tid & 63, wave = __builtin_amdgcn_readfirstlane(tid >> 6); const int G = gridDim.x, bx = blockIdx.x;
    const int gw = bx * NWAVES + wave, NGW = G * NWAVES, gt = bx * 512 + tid, NGT = G * 512; unsigned char* ws = a.ws;
    LAS unsigned char* ring = (LAS unsigned char*)lds; LAS float* rtab = (LAS float*)(lds + RTAB_OFF);
    (void)lane; (void)gw; (void)NGW; (void)gt; (void)NGT; (void)ring; (void)rtab; (void)ws;

        for (int u = bx; u < 256; u += G) { const int g = u & 3, p = u >> 2; nsa_unit(a, g, 127 - p, lds); nsa_unit(a, g, p, lds); }

}
__device__ __forceinline__ void phase4(const Args& a, LAS char* lds) {
    const int tid = threadIdx.x, lane = tid & 63, wave = __builtin_amdgcn_readfirstlane(tid >> 6); const int G = gridDim.x, bx = blockIdx.x;
    const int gw = bx * NWAVES + wave, NGW = G * NWAVES, gt = bx * 512 + tid, NGT = G * 512; unsigned char* ws = a.ws;
    LAS unsigned char* ring = (LAS unsigned char*)lds; LAS float* rtab = (LAS float*)(lds + RTAB_OFF);
    (void)lane; (void)gw; (void)NGW; (void)gt; (void)NGT; (void)ring; (void)rtab; (void)ws;

        { pg8::Gemm g{(const bf16*)(ws + WS_ODA), (const bf16*)(ws + WS_WBDA), S_, 2048, 1024}; g.A2 = (const bf16*)(ws + WS_ONSA); g.Bt2 = (const bf16*)(ws + WS_WBNSA);
          pg8::DualOrder S; S.init(S_, 2048, G, bx);
          EpiGateChain E{(bf16*)(ws + WS_MIX), (const bf16*)(ws + WS_BG)};
          pg8::gemm_phase<EpiGateChain, pg8::DualOrder, false, true>(ring, g, S, E); }

}
__device__ __forceinline__ void phase5(const Args& a, LAS char* lds) {
    const int tid = threadIdx.x, lane = tid & 63, wave = __builtin_amdgcn_readfirstlane(tid >> 6); const int G = gridDim.x, bx = blockIdx.x;
    const int gw = bx * NWAVES + wave, NGW = G * NWAVES, gt = bx * 512 + tid, NGT = G * 512; unsigned char* ws = a.ws;
    LAS unsigned char* ring = (LAS unsigned char*)lds; LAS float* rtab = (LAS float*)(lds + RTAB_OFF);
    (void)lane; (void)gw; (void)NGW; (void)gt; (void)NGT; (void)ring; (void)rtab; (void)ws;

        pg8::Gemm g{(const bf16*)(ws + WS_MIX), (const bf16*)(ws + WS_WOUT), S_, 2048, 2048}; pg8::StaticOrder S; S.init(S_, 2048, G, bx);
        EpiResSS<false> E{a.in[0], (bf16*)(ws + WS_H1B), (float*)(ws + WS_SS1)};
        pg8::gemm_phase<EpiResSS<false>, pg8::StaticOrder, false, true>(ring, g, S, E);

}
__device__ __forceinline__ void phase6(const Args& a, LAS char* lds) {
    const int tid = threadIdx.x, lane = tid & 63, wave = __builtin_amdgcn_readfirstlane(tid >> 6); const int G = gridDim.x, bx = blockIdx.x;
    const int gw = bx * NWAVES + wave, NGW = G * NWAVES, gt = bx * 512 + tid, NGT = G * 512; unsigned char* ws = a.ws;
    LAS unsigned char* ring = (LAS unsigned char*)lds; LAS float* rtab = (LAS float*)(lds + RTAB_OFF);
    (void)lane; (void)gw; (void)NGW; (void)gt; (void)NGT; (void)ring; (void)rtab; (void)ws;

        pg8::Gemm g{(const bf16*)(ws + WS_H1B), (const bf16*)(ws + WS_WXQ), S_, 512, 2048}; pg8::StaticOrder S; S.init(S_, 512, G, bx);
        make_rtab(S, (const float*)(ws + WS_SS1), rtab);
        EpiFn8<FRowScaleL8> E{FRowScaleL8{rtab, (bf16*)(ws + WS_QX), XSCALE, 512}};
        pg8::gemm_phase<EpiFn8<FRowScaleL8>, pg8::StaticOrder, false, true>(ring, g, S, E);
        if (bx >= 64) { const int w0 = (bx - 64) * NWAVES + wave, nw = (G - 64) * NWAVES;
            for (int r = w0; r < 2 * 16384; r += nw) { const int tb = r >= 16384, rr = r & 16383;
                quant_row(a.in[tb ? 28 : 27] + (size_t)rr * DM, ws + (tb ? WS_VQ : WS_UQ), rr, (float*)(ws + (tb ? WS_VSC : WS_USC)) + rr, lane, tb != 0); } }
}
__device__ __forceinline__ void phase7(const Args& a, LAS char* lds) {
    const int tid = threadIdx.x, lane = tid & 63, wave = __builtin_amdgcn_readfirstlane(tid >> 6); const int G = gridDim.x, bx = blockIdx.x;
    const int gw = bx * NWAVES + wave, NGW = G * NWAVES, gt = bx * 512 + tid, NGT = G * 512; unsigned char* ws = a.ws;
    LAS unsigned char* ring = (LAS unsigned char*)lds; LAS float* rtab = (LAS float*)(lds + RTAB_OFF);
    (void)lane; (void)gw; (void)NGW; (void)gt; (void)NGT; (void)ring; (void)rtab; (void)ws;

        for (int u = bx; u < 128; u += G) xattn_unit(a, u & 3, u >> 2, lds);

}
__device__ __forceinline__ void phase8(const Args& a, LAS char* lds) {
    const int tid = threadIdx.x, lane = tid & 63, wave = __builtin_amdgcn_readfirstlane(tid >> 6); const int G = gridDim.x, bx = blockIdx.x;
    const int gw = bx * NWAVES + wave, NGW = G * NWAVES, gt = bx * 512 + tid, NGT = G * 512; unsigned char* ws = a.ws;
    LAS unsigned char* ring = (LAS unsigned char*)lds; LAS float* rtab = (LAS float*)(lds + RTAB_OFF);
    (void)lane; (void)gw; (void)NGW; (void)gt; (void)NGT; (void)ring; (void)rtab; (void)ws;

        pg8::Gemm g{(const bf16*)(ws + WS_OX), (const bf16*)(ws + WS_WXO), S_, 2048, 512}; pg8::StaticOrder S; S.init(S_, 2048, G, bx);
        EpiResSS<true> E{ws + WS_H1B, (bf16*)(ws + WS_H2B), (float*)(ws + WS_SS2)};
        pg8::gemm_phase<EpiResSS<true>, pg8::StaticOrder, false, true>(ring, g, S, E);

}
__device__ __forceinline__ void phase9(const Args& a, LAS char* lds) {
    const int tid = threadIdx.x, lane = tid & 63, wave = __builtin_amdgcn_readfirstlane(tid >> 6); const int G = gridDim.x, bx = blockIdx.x;
    const int gw = bx * NWAVES + wave, NGW = G * NWAVES, gt = bx * 512 + tid, NGT = G * 512; unsigned char* ws = a.ws;
    LAS unsigned char* ring = (LAS unsigned char*)lds; LAS float* rtab = (LAS float*)(lds + RTAB_OFF);
    (void)lane; (void)gw; (void)NGW; (void)gt; (void)NGT; (void)ring; (void)rtab; (void)ws;

        pg8::Gemm g{(const bf16*)(ws + WS_H2B), (const bf16*)(ws + WS_WPQ), S_, 2048, 2048}; pg8::StaticOrder S; S.init(S_, 2048, G, bx);
        make_rtab(S, (const float*)(ws + WS_SS2), rtab);
        { pg8::Unit u; if (S.next(0, u) && tid < 256) ((float*)(ws + WS_R2))[u.pm * 256 + tid] = rtab[tid]; }
        EpiFn8<FRowScaleL8> E{FRowScaleL8{rtab, (bf16*)(ws + WS_PQ), 1.0f, 2048}};
        pg8::gemm_phase<EpiFn8<FRowScaleL8>, pg8::StaticOrder, false, true>(ring, g, S, E);

}
__device__ __forceinline__ void phase10(const Args& a, LAS char* lds) { const int wave = __builtin_amdgcn_readfirstlane(threadIdx.x >> 6); p_peer_a(a, lds, blockIdx.x * NWAVES + wave, gridDim.x * NWAVES); }
__device__ __forceinline__ void phase11(const Args& a, LAS char* lds) { p_peer_b(a, lds); }
__device__ __forceinline__ void phase12(const Args& a, LAS char* lds) {
#ifdef MK_FAKEMASK
    p_peer_d<MK_FAKEMASK>(a, lds);
#endif
    p_peer_d<0xffffu>(a, lds); }
__device__ __forceinline__ void phase13(const Args& a, LAS char* lds) { p_peer_e(a, lds); }
#ifndef MK_DOUBLE
#define MK_DOUBLE 0
#endif
#ifndef MK_SPLIT
#define MK_SPLIT 0
#endif
constexpr int NPHASE = 14;
__global__ void __launch_bounds__(NWAVES * 64, 2) mk_fwd(Args a) {
    extern __shared__ __attribute__((aligned(16))) unsigned char lds_raw[];
    LAS char* lds = (LAS char*)lds_raw;
    const int tid = threadIdx.x, lane = tid & 63, wave = __builtin_amdgcn_readfirstlane(tid >> 6);
    const int G = gridDim.x, bx = blockIdx.x;
    unsigned char* ws = a.ws;
    for (int u = tid; u < (LDS_BYTES - LDSCTL_OFF) / 4; u += NWAVES * 64) ((LAS unsigned*)(lds + LDSCTL_OFF))[u] = 0u;
    __syncthreads();
    unsigned* ctl = (unsigned*)(ws + WS_CTL);
    XcdBarrier bar; bar.bar = ctl + CW_BAR; bar.x = 0; bar.st = nullptr;
    if (!MK_SPLIT) bar = xcd_barrier_post(ctl + CW_BAR, (volatile LAS unsigned*)(lds + MISC_OFF) + 8);
    const int lo = a.ph_lo, hi = a.ph_hi;
#define IN(k) (lo <= (k) && (k) < hi)
#define SEAM(k) do { if (IN(k) && IN((k) + 1)) xcd_barrier(bar); } while (0)

    if (IN(0)) { phase0(a, lds); if (MK_DOUBLE & (1 << 0)) { xcd_barrier(bar); phase0(a, lds); } }
    SEAM(0);
    if (IN(1)) { phase1(a, lds); if (MK_DOUBLE & (1 << 1)) { xcd_barrier(bar); phase1(a, lds); } }
    SEAM(1);
    if (IN(2)) { phase2(a, lds); if (MK_DOUBLE & (1 << 2)) { xcd_barrier(bar); phase2(a, lds); } }
    SEAM(2);
    if (IN(3)) { phase3(a, lds); if (MK_DOUBLE & (1 << 3)) { xcd_barrier(bar); phase3(a, lds); } }
    SEAM(3);
    if (IN(4)) { phase4(a, lds); if (MK_DOUBLE & (1 << 4)) { xcd_barrier(bar); phase4(a, lds); } }
    SEAM(4);
    if (IN(5)) { phase5(a, lds); if (MK_DOUBLE & (1 << 5)) { xcd_barrier(bar); phase5(a, lds); } }
    SEAM(5);
    if (IN(6)) { phase6(a, lds); if (MK_DOUBLE & (1 << 6)) { xcd_barrier(bar); phase6(a, lds); } }
    SEAM(6);
    if (IN(7)) { phase7(a, lds); if (MK_DOUBLE & (1 << 7)) { xcd_barrier(bar); phase7(a, lds); } }
    SEAM(7);
    if (IN(8)) { phase8(a, lds); if (MK_DOUBLE & (1 << 8)) { xcd_barrier(bar); phase8(a, lds); } }
    SEAM(8);
    if (IN(9)) { phase9(a, lds); if (MK_DOUBLE & (1 << 9)) { xcd_barrier(bar); phase9(a, lds); } }
    SEAM(9);
    if (IN(10)) { phase10(a, lds); if (MK_DOUBLE & (1 << 10)) { xcd_barrier(bar); phase10(a, lds); } }
    SEAM(10);
    if (IN(11)) { phase11(a, lds); if (MK_DOUBLE & (1 << 11)) { xcd_barrier(bar); phase11(a, lds); } }
    SEAM(11);
    if (IN(12)) { phase12(a, lds); if (MK_DOUBLE & (1 << 12)) { xcd_barrier(bar); phase12(a, lds); } }
    SEAM(12);
    if (IN(13)) { phase13(a, lds); if (MK_DOUBLE & (1 << 13)) { xcd_barrier(bar); phase13(a, lds); } }
#undef IN
#undef SEAM
}

extern "C" void kernel_launch(void* const* d_in, const int* in_sizes, int n_in, void* d_out, int out_size, void* d_ws, size_t ws_size, hipStream_t stream) {
    static int grid = 0;
    if (grid == 0) {
        if (n_in != 30 || ws_size < WS_END || out_size != S_ * DM) { fprintf(stderr, "kernel_launch: unexpected n_in %d / ws %zu / out %d\n", n_in, ws_size, out_size); grid = -1; return; }
        int dev = 0, cus = 0, per_cu = 0;
        if (hipGetDevice(&dev) != hipSuccess || hipDeviceGetAttribute(&cus, hipDeviceAttributeMultiprocessorCount, dev) != hipSuccess) { grid = -1; return; }
        if (hipFuncSetAttribute((const void*)mk_fwd, hipFuncAttributeMaxDynamicSharedMemorySize, LDS_BYTES) != hipSuccess) { fprintf(stderr, "kernel_launch: hipFuncSetAttribute failed\n"); grid = -1; return; }
        if (hipOccupancyMaxActiveBlocksPerMultiprocessor(&per_cu, (const void*)mk_fwd, NWAVES * 64, LDS_BYTES) != hipSuccess || per_cu < 1) { fprintf(stderr, "kernel_launch: occupancy query says %d blocks per CU\n", per_cu); }
        (void)hipGetLastError();
        grid = cus;
        if (grid != 256) { fprintf(stderr, "kernel_launch: built for a 256-CU device, found %d CUs\n", cus); grid = -1; return; }
    }
    if (grid < 0) return;
    (void)hipMemsetAsync((char*)d_ws + WS_CTL, 0, 1 * MiB, stream);
    Args a; memset(&a, 0, sizeof(a));
    for (int i = 0; i < 30; ++i) a.in[i] = (const float*)d_in[i];
    a.out = (float*)d_out; a.ws = (unsigned char*)d_ws;
#if MK_SPLIT
    for (int p = 0; p < NPHASE; ++p) { a.ph_lo = p; a.ph_hi = p + 1; hipLaunchKernelGGL(mk_fwd, dim3(grid), dim3(NWAVES * 64), LDS_BYTES, stream, a); }
#else
    a.ph_lo = 0; a.ph_hi = NPHASE;
    hipLaunchKernelGGL(mk_fwd, dim3(grid), dim3(NWAVES * 64), LDS_BYTES, stream, a);
#endif
}
```
